# Optimizing an MI355X kernel written in HIP

```python
import math
import jax
import jax.numpy as jnp
from jax import lax
import numpy as np

D_MODEL = 1024
BATCH = 2
SEQ = 16384
DEPTH = 4

N_A_LAYERS = DEPTH // 2
N_B_LAYERS = DEPTH - N_A_LAYERS
EPS = 1e-6

GDN_HEADS = 6
GDN_DK = 128
GDN_DV = 128
GDN_QK_W = GDN_HEADS * GDN_DK
GDN_V_W = GDN_HEADS * GDN_DV
CONV_K = 4
CHUNK = 64

SWA_HEADS = 12
SWA_KV_HEADS = 2
SWA_DH = 64
SWA_GROUP = SWA_HEADS // SWA_KV_HEADS
SWA_Q_W = SWA_HEADS * SWA_DH
KV_W = SWA_KV_HEADS * SWA_DH
WINDOW = 128
SWA_BLOCK = 128
ROPE_THETA = 500000.0
ROT_DIM = SWA_DH // 4

MEM_LEN = 256
MEM_HEADS = 4
MEM_DH = 64
MEM_W = MEM_HEADS * MEM_DH

D_MIX = GDN_V_W + MEM_W
GDN_IN = 2 * GDN_QK_W + 2 * GDN_V_W + 2 * GDN_HEADS + MEM_W
SWA_IN = SWA_Q_W + MEM_W
D_FF = -(-8 * D_MODEL // (3 * 256)) * 256

kernel_name = "yoco_gdn_swa_sink_memory_trunk"


def rms_norm(x, g):
    xf = x.astype(jnp.float32)
    y = xf * lax.rsqrt(jnp.mean(xf * xf, axis=-1, keepdims=True) + EPS)
    return (y * g.astype(jnp.float32)).astype(x.dtype)


def l2_normalize(x):
    xf = x.astype(jnp.float32)
    return xf * lax.rsqrt(jnp.sum(xf * xf, axis=-1, keepdims=True) + EPS)


def rope_tables(positions):
    inv = ROPE_THETA ** (-jnp.arange(0, ROT_DIM, 2, dtype=jnp.float32) / ROT_DIM)
    ang = positions.astype(jnp.float32)[..., None] * inv
    return jnp.cos(ang), jnp.sin(ang)


def apply_partial_rope(x, cos, sin):
    half = ROT_DIM // 2
    xf = x.astype(jnp.float32)
    x1, x2 = xf[..., :half], xf[..., half:ROT_DIM]
    c, s = cos[:, :, None, :], sin[:, :, None, :]
    out = jnp.concatenate([x1 * c - x2 * s, x2 * c + x1 * s, xf[..., ROT_DIM:]], axis=-1)
    return out.astype(x.dtype)


def causal_depthwise_conv(x, w):
    c = x.shape[-1]
    return lax.conv_general_dilated(
        x, w[:, None, :].astype(x.dtype), window_strides=(1,), padding=[(CONV_K - 1, 0)],
        dimension_numbers=("NWC", "WIO", "NWC"), feature_group_count=c)


def swiglu(h, w_gate_up, w_down):
    gu = h @ w_gate_up
    return (jax.nn.silu(gu[..., :D_FF]) * gu[..., D_FF:]) @ w_down


def gated_delta_rule_chunked(q, k, v, g, beta):
    b_sz, s_len, n_h, dk = q.shape
    dv = v.shape[-1]
    n_ch = s_len // CHUNK

    def chunks(t):
        t = t.reshape((b_sz, n_ch, CHUNK, n_h) + t.shape[3:])
        return jnp.moveaxis(t, 3, 1)

    q = chunks(q) * (dk ** -0.5)
    k = chunks(k)
    v = chunks(v)
    beta = chunks(beta)
    gc = jnp.cumsum(chunks(g), axis=-1)
    tril = jnp.tril(jnp.ones((CHUNK, CHUNK), dtype=bool))
    strict = jnp.tril(jnp.ones((CHUNK, CHUNK), dtype=bool), -1)
    decay = jnp.exp(jnp.where(tril, gc[..., :, None] - gc[..., None, :], -jnp.inf))
    kb = k * beta[..., None]
    lower = jnp.where(strict, jnp.einsum("bhncd,bhnkd->bhnck", kb, k) * decay, 0.0)
    rhs = jnp.concatenate([v * beta[..., None], kb * jnp.exp(gc)[..., None]], axis=-1)
    sol = lax.linalg.triangular_solve(lower, rhs, left_side=True, lower=True, unit_diagonal=True)
    u, w = sol[..., :dv], sol[..., dv:]
    intra = jnp.einsum("bhncd,bhnkd->bhnck", q, k) * decay
    q_g = q * jnp.exp(gc)[..., None]
    k_g = k * jnp.exp(gc[..., -1:] - gc)[..., None]
    g_last = jnp.exp(gc[..., -1])
    xs = tuple(jnp.moveaxis(t, 2, 0) for t in (u, w, intra, q_g, k_g, g_last))

    def step(state, inp):
        u_n, w_n, a_n, qg_n, kg_n, gl_n = inp
        v_new = u_n - jnp.einsum("bhck,bhkv->bhcv", w_n, state)
        o_n = jnp.einsum("bhck,bhkv->bhcv", qg_n, state) + jnp.einsum("bhcs,bhsv->bhcv", a_n, v_new)
        state = state * gl_n[..., None, None] + jnp.einsum("bhck,bhcv->bhkv", kg_n, v_new)
        return state, o_n

    s0 = jnp.zeros((b_sz, n_h, dk, dv), jnp.float32)
    _, o = lax.scan(step, s0, xs)
    return jnp.transpose(o, (1, 0, 3, 2, 4)).reshape(b_sz, s_len, n_h, dv)


def gated_deltanet_mixer(h, w_in, conv_w, a_log, dt_bias, norm_g):
    b_sz, s_len, _ = h.shape
    proj = h @ w_in
    o1 = 2 * GDN_QK_W + GDN_V_W
    qkv = jax.nn.silu(causal_depthwise_conv(proj[..., :o1], conv_w))
    z = proj[..., o1:o1 + GDN_V_W]
    o2 = o1 + GDN_V_W
    b_logit = proj[..., o2:o2 + GDN_HEADS].astype(jnp.float32)
    a_logit = proj[..., o2 + GDN_HEADS:o2 + 2 * GDN_HEADS].astype(jnp.float32)
    mem_q = proj[..., o2 + 2 * GDN_HEADS:]
    q = l2_normalize(qkv[..., :GDN_QK_W].reshape(b_sz, s_len, GDN_HEADS, GDN_DK))
    k = l2_normalize(qkv[..., GDN_QK_W:2 * GDN_QK_W].reshape(b_sz, s_len, GDN_HEADS, GDN_DK))
    v = qkv[..., 2 * GDN_QK_W:].reshape(b_sz, s_len, GDN_HEADS, GDN_DV).astype(jnp.float32)
    beta = jax.nn.sigmoid(b_logit)
    g = -jnp.exp(a_log.astype(jnp.float32)) * jax.nn.softplus(a_logit + dt_bias.astype(jnp.float32))
    o = gated_delta_rule_chunked(q, k, v, g, beta)
    o = rms_norm(o, norm_g) * jax.nn.silu(z.reshape(b_sz, s_len, GDN_HEADS, GDN_DV).astype(jnp.float32))
    return o.reshape(b_sz, s_len, GDN_V_W).astype(h.dtype), mem_q


def sliding_window_attention(q, k, v, sinks):
    b_sz, s_len = q.shape[:2]
    nb = s_len // SWA_BLOCK
    qb = q.reshape(b_sz, nb, SWA_BLOCK, SWA_KV_HEADS, SWA_GROUP, SWA_DH)
    kb = k.reshape(b_sz, nb, SWA_BLOCK, SWA_KV_HEADS, SWA_DH)
    vb = v.reshape(b_sz, nb, SWA_BLOCK, SWA_KV_HEADS, SWA_DH)
    pad = jnp.zeros_like(kb[:, :1])
    kw = jnp.concatenate([jnp.concatenate([pad, kb[:, :-1]], axis=1), kb], axis=2)
    vw = jnp.concatenate([jnp.concatenate([pad, vb[:, :-1]], axis=1), vb], axis=2)
    s = jnp.einsum("bnqhgd,bnkhd->bnhgqk", qb, kw).astype(jnp.float32) * (SWA_DH ** -0.5)
    qi = jnp.arange(SWA_BLOCK)[:, None] + SWA_BLOCK
    ki = jnp.arange(2 * SWA_BLOCK)[None, :]
    diff = qi - ki
    band = (diff >= 0) & (diff < WINDOW)
    has_prev = jnp.arange(nb) > 0
    mask = band[None] & (has_prev[:, None, None] | (ki >= SWA_BLOCK)[None])
    s = jnp.where(mask[None, :, None, None], s, -jnp.inf)
    sink = sinks.astype(jnp.float32).reshape(SWA_KV_HEADS, SWA_GROUP)[None, None, :, :, None, None]
    m = jnp.maximum(jnp.max(s, axis=-1, keepdims=True), sink)
    p = jnp.exp(s - m)
    p = (p / (jnp.sum(p, axis=-1, keepdims=True) + jnp.exp(sink - m))).astype(v.dtype)
    o = jnp.einsum("bnhgqk,bnkhd->bnqhgd", p, vw)
    return o.reshape(b_sz, s_len, SWA_Q_W)


def memory_attention(q, mem_k, mem_v):
    s = jnp.einsum("bshd,bmhd->bhsm", q, mem_k).astype(jnp.float32) * (MEM_DH ** -0.5)
    p = jax.nn.softmax(s, axis=-1).astype(q.dtype)
    o = jnp.einsum("bhsm,bmhd->bshd", p, mem_v)
    return o.reshape(q.shape[0], q.shape[1], MEM_W)


def setup_inputs(seed: int = 0) -> dict:
    key = jax.random.key(seed)
    ks = jax.random.split(key, 24)
    f32 = jnp.float32

    def dense(k, shape, fan_in):
        return jax.random.normal(k, shape, f32) * (fan_in ** -0.5)

    def gain(k, shape):
        return 1.0 + 0.02 * jax.random.normal(k, shape, f32)

    x = jax.random.normal(ks[0], (BATCH, SEQ, D_MODEL), f32)
    mem = jax.random.normal(ks[1], (BATCH, MEM_LEN, D_MODEL), f32)
    positions = (jnp.arange(SEQ, dtype=jnp.int32)[None, :]
                 + jax.random.randint(ks[2], (BATCH, 1), 0, 4096, dtype=jnp.int32))
    dt0 = jnp.exp(jax.random.uniform(ks[15], (N_A_LAYERS, GDN_HEADS), f32,
                                     math.log(1e-3), math.log(1e-1)))
    return {
        "x": x,
        "mem": mem,
        "positions": positions,
        "ln_mix": gain(ks[3], (DEPTH, D_MODEL)),
        "ln_ffn": gain(ks[4], (DEPTH, D_MODEL)),
        "ln_mem": gain(ks[5], (D_MODEL,)),
        "w_mem_kv": dense(ks[6], (DEPTH, D_MODEL, 2 * MEM_W), D_MODEL),
        "w_out": dense(ks[7], (DEPTH, D_MIX, D_MODEL), D_MIX),
        "w_gate_up": dense(ks[8], (DEPTH, D_MODEL, 2 * D_FF), D_MODEL),
        "w_down": dense(ks[9], (DEPTH, D_FF, D_MODEL), D_FF),
        "gdn_w_in": dense(ks[10], (N_A_LAYERS, D_MODEL, GDN_IN), D_MODEL),
        "gdn_conv": dense(ks[11], (N_A_LAYERS, CONV_K, 2 * GDN_QK_W + GDN_V_W), CONV_K),
        "gdn_A_log": jnp.log(jax.random.uniform(ks[12], (N_A_LAYERS, GDN_HEADS), f32, 1.0, 16.0)),
        "gdn_dt_bias": dt0 + jnp.log(-jnp.expm1(-dt0)),
        "gdn_norm": gain(ks[13], (N_A_LAYERS, GDN_DV)),
        "swa_w_q": dense(ks[14], (N_B_LAYERS, D_MODEL, SWA_IN), D_MODEL),
        "swa_sinks": 0.5 * jax.random.normal(ks[16], (N_B_LAYERS, SWA_HEADS), f32),
        "ln_kv": gain(ks[17], (D_MODEL,)),
        "w_kv": dense(ks[18], (D_MODEL, 2 * KV_W), D_MODEL),
        "ln_final": gain(ks[19], (D_MODEL,)),
    }


def reference(x, mem, positions, ln_mix, ln_ffn, ln_mem, w_mem_kv, w_out, w_gate_up, w_down,
              gdn_w_in, gdn_conv, gdn_A_log, gdn_dt_bias, gdn_norm,
              swa_w_q, swa_sinks, ln_kv, w_kv, ln_final):
    b_sz, s_len, _ = x.shape
    cos, sin = rope_tables(positions)
    mem_n = rms_norm(mem, ln_mem)
    shared_k = None
    shared_v = None
    for layer in range(DEPTH):
        h = rms_norm(x, ln_mix[layer])
        mkv = mem_n @ w_mem_kv[layer]
        mem_k = mkv[..., :MEM_W].reshape(b_sz, MEM_LEN, MEM_HEADS, MEM_DH)
        mem_v = mkv[..., MEM_W:].reshape(b_sz, MEM_LEN, MEM_HEADS, MEM_DH)
        if layer < N_A_LAYERS:
            a = layer
            mix_out, mem_q = gated_deltanet_mixer(h, gdn_w_in[a], gdn_conv[a], gdn_A_log[a],
                                                  gdn_dt_bias[a], gdn_norm[a])
        else:
            bl = layer - N_A_LAYERS
            proj = h @ swa_w_q[bl]
            q = apply_partial_rope(proj[..., :SWA_Q_W].reshape(b_sz, s_len, SWA_HEADS, SWA_DH), cos, sin)
            mix_out = sliding_window_attention(q, shared_k, shared_v, swa_sinks[bl])
            mem_q = proj[..., SWA_Q_W:]
        mem_o = memory_attention(mem_q.reshape(b_sz, s_len, MEM_HEADS, MEM_DH), mem_k, mem_v)
        x = x + jnp.concatenate([mix_out.astype(x.dtype), mem_o.astype(x.dtype)], axis=-1) @ w_out[layer]
        x = x + swiglu(rms_norm(x, ln_ffn[layer]), w_gate_up[layer], w_down[layer])
        if layer == N_A_LAYERS - 1:
            kv = rms_norm(x, ln_kv) @ w_kv
            shared_k = apply_partial_rope(kv[..., :KV_W].reshape(b_sz, s_len, SWA_KV_HEADS, SWA_DH), cos, sin)
            shared_v = kv[..., KV_W:].reshape(b_sz, s_len, SWA_KV_HEADS, SWA_DH)
    return rms_norm(x, ln_final)
```

```cpp
#include <hip/hip_runtime.h>
#include <hip/hip_cooperative_groups.h>
#include <cstdio>
#include <cstdint>
#include <cmath>
namespace cg = cooperative_groups;
__device__ __forceinline__ int tidx() { int t = threadIdx.x; asm volatile("" : "+v"(t)); return t; }
__device__ __forceinline__ int bidx() { int b = blockIdx.x; asm volatile("" : "+s"(b)); return b; }
namespace pg8 {
#define PG8_LAS __attribute__((address_space(3)))
typedef unsigned short bf16_t;
typedef short bf16x8 __attribute__((ext_vector_type(8)));
typedef float f32x4 __attribute__((ext_vector_type(4)));
typedef unsigned u32x4 __attribute__((ext_vector_type(4)));
constexpr int BM = 256, BK = 64, HALF = 128, HTB = HALF * BK * 2  , STAGE_BYTES = 8 * HTB, NXCD = 8, WGM = 8;

__host__ __device__ __forceinline__ int lds_byte(int r, int c) { const int st = (r >> 4) * 2 + (c >> 5), rr = r & 15, cc = c & 31, ob = rr * 64 + cc * 2; return st * 1024 + (ob ^ (((ob >> 9) & 1) << 5)); }
__host__ __device__ __forceinline__ void stage_rc(int b, int& R, int& C) { const int st = b / 1024, sb = b % 1024, swz = sb ^ (((sb >> 9) & 1) << 5); R = (st >> 1) * 16 + swz / 64; C = (st & 1) * 32 + (swz % 64) / 2; }
__host__ __device__ __forceinline__ int perm32(int rho) { const int n = rho >> 4, i = rho & 15; return 8 * (i >> 2) + 4 * n + (i & 3); }

struct Unit { int pm, pn; };
struct Gemm { const bf16_t* A; const bf16_t* Bt; int M, N, K; };

struct StaticOrder {
    int nM, nN, nwg, G, c;
    __host__ __device__ void init(int M, int N, int G_, int c_) { nM = M / BM; nN = N / BM; nwg = nM * nN; G = G_; c = c_; }
    __host__ __device__ bool next(int i, Unit& u) const {
        const long L = (long)i * G + c; if (L >= nwg) return false;
        int wgid = (int)L; { const int q = nwg / NXCD, r = nwg % NXCD, xcd = wgid % NXCD, off = wgid / NXCD; wgid = (xcd < r ? xcd * (q + 1) : r * (q + 1) + (xcd - r) * q) + off; }
        const int nig = WGM * nN, gid = wgid / nig, fm = gid * WGM, gsz = (nM - fm) < WGM ? (nM - fm) : WGM;
        u.pm = fm + ((wgid % nig) % gsz); u.pn = (wgid % nig) / gsz; return true;
    }
    __device__ __forceinline__ void a_ready(const Unit&) const {}
    __device__ __forceinline__ void done(const Unit&) const {}
};
template <class Epi, class Sched, bool ALIGN_EPI = false, bool SP2 = false>
__device__ __forceinline__ void gemm_phase(PG8_LAS unsigned char* lds, const Gemm g, const Sched& S, const Epi& E) {
    const int tid = tidx(), wid = __builtin_amdgcn_readfirstlane(tid >> 6), lane = tid & 63, wr = wid >> 2, wc = wid & 3, fr = lane & 15, fq = lane >> 4;
    const int K = g.K, nt = K / BK;
    unsigned voffA[2], voffB[2];
#pragma unroll
    for (int i = 0; i < 2; ++i) { int R, C; stage_rc(tid * 16 + i * 8192, R, C); const int Rb = Epi::PERM ? ((R & ~31) + perm32(R & 31)) : R;
        voffA[i] = (unsigned)(R * K + C) * 2u; voffB[i] = (unsigned)(Rb * K + C) * 2u; }
    const size_t kstep = (size_t)(BK * 2);
    const size_t hstep = (size_t)HALF * K * 2;
    const size_t tstep = 2 * hstep;
    const unsigned ldsw = (unsigned)wid * 1024u;
    const int aoff = lds_byte(wr * 64 + fr, fq * 8), boff = lds_byte(wc * 32 + fr, fq * 8);
#define PG8_SA(b, h) (((b) * 2 + (h)) * HTB)
#define PG8_SB(b, h) ((4 + (b) * 2 + (h)) * HTB)
#define PG8_STAGE(bufoff, gbase, voff) do { _Pragma("unroll") for (int _i = 0; _i < 2; ++_i) \
        __builtin_amdgcn_global_load_lds((const unsigned*)((const char*)(gbase) + (voff)[_i]), (PG8_LAS unsigned*)(lds + (bufoff) + ldsw + _i * 8192), 16, 0, 0); } while (0)
#define PG8_LDA(dst, b, h) do { _Pragma("unroll") for (int m = 0; m < 4; ++m) _Pragma("unroll") for (int k = 0; k < 2; ++k) dst[m][k] = *(const PG8_LAS bf16x8*)(lds + PG8_SA(b, h) + aoff + m * 2048 + k * 1024); } while (0)
#define PG8_LDB(dst, b, h) do { _Pragma("unroll") for (int n = 0; n < 2; ++n) _Pragma("unroll") for (int k = 0; k < 2; ++k) dst[n][k] = *(const PG8_LAS bf16x8*)(lds + PG8_SB(b, h) + boff + n * 2048 + k * 1024); } while (0)
#define PG8_MMA(ai, bj, At, Bt) do { __builtin_amdgcn_s_setprio(1); _Pragma("unroll") for (int m = 0; m < 4; ++m) _Pragma("unroll") for (int n = 0; n < 2; ++n) _Pragma("unroll") for (int k = 0; k < 2; ++k) \
        acc[ai][bj][m][n] = __builtin_amdgcn_mfma_f32_16x16x32_bf16(Bt[n][k], At[m][k], acc[ai][bj][m][n], 0, 0, 0); __builtin_amdgcn_s_setprio(0); } while (0)
#define PG8_WAIT_V(n) asm volatile("s_waitcnt vmcnt(" #n ")" ::: "memory")
#define PG8_WAIT_L(n) asm volatile("s_waitcnt lgkmcnt(" #n ")" ::: "memory")
#define PG8_BAR __builtin_amdgcn_s_barrier()
#define PG8_SCHED __builtin_amdgcn_sched_barrier(0)
    Unit cur, nxt; int ui = 0;
    if (!S.next(0, cur)) return;
    f32x4 acc[2][2][4][2];
#pragma unroll
    for (int a = 0; a < 2; ++a)
#pragma unroll
        for (int b = 0; b < 2; ++b)
#pragma unroll
            for (int m = 0; m < 4; ++m)
#pragma unroll
                for (int n = 0; n < 2; ++n) acc[a][b][m][n] = (f32x4){0.f, 0.f, 0.f, 0.f};
    bf16x8 At[4][2], B0[2][2], B1[2][2];
    const char* cA = (const char*)g.A + (size_t)cur.pm * tstep; const char* cB = (const char*)g.Bt + (size_t)cur.pn * tstep;
    S.a_ready(cur);
    if constexpr (SP2) {
        PG8_STAGE(PG8_SB(0, 0), cB, voffB); PG8_STAGE(PG8_SB(0, 1), cB + hstep, voffB); PG8_STAGE(PG8_SA(0, 0), cA, voffA); PG8_STAGE(PG8_SA(0, 1), cA + hstep, voffA);
        if (wr == 1) PG8_BAR;
        PG8_WAIT_V(2); PG8_BAR;
        PG8_STAGE(PG8_SB(1, 0), cB + kstep, voffB); PG8_STAGE(PG8_SA(1, 0), cA + kstep, voffA); PG8_STAGE(PG8_SB(1, 1), cB + hstep + kstep, voffB);
        PG8_WAIT_V(6); PG8_BAR;
    } else {
        PG8_STAGE(PG8_SB(0, 0), cB, voffB); PG8_STAGE(PG8_SA(0, 0), cA, voffA); PG8_STAGE(PG8_SB(0, 1), cB + hstep, voffB); PG8_STAGE(PG8_SA(0, 1), cA + hstep, voffA);
        if (wr == 1) PG8_BAR;
        PG8_WAIT_V(4); PG8_BAR;
        PG8_STAGE(PG8_SB(1, 0), cB + kstep, voffB); PG8_STAGE(PG8_SA(1, 0), cA + kstep, voffA); PG8_STAGE(PG8_SB(1, 1), cB + hstep + kstep, voffB);
        PG8_WAIT_V(6); PG8_BAR;
    }
    for (;;) {
        const bool has_next = S.next(ui + 1, nxt);
        const char* nA = has_next ? (const char*)g.A + (size_t)nxt.pm * tstep : cA; const char* nB = has_next ? (const char*)g.Bt + (size_t)nxt.pn * tstep : cB;
        for (int t = 0; t < nt; t += 2) {
            const bool last = (t == nt - 2);
            const char* a1 = cA + (size_t)(t + 1) * kstep;
            const char* a2 = last ? nA : cA + (size_t)(t + 2) * kstep; const char* b2 = last ? nB : cB + (size_t)(t + 2) * kstep;
            const char* a3 = a2 + kstep; const char* b3 = b2 + kstep;
            if (last && has_next) S.a_ready(nxt);
            if constexpr (SP2) {
            PG8_LDB(B0, 0, 0); PG8_LDB(B1, 0, 1); PG8_SCHED; PG8_LDA(At, 0, 0); PG8_STAGE(PG8_SA(1, 1), a1 + hstep, voffA);
            PG8_WAIT_V(8); PG8_WAIT_L(0); PG8_BAR; PG8_MMA(0, 0, At, B0); PG8_MMA(0, 1, At, B1); PG8_BAR; PG8_SCHED;
            PG8_LDA(At, 0, 1); PG8_STAGE(PG8_SB(0, 0), b2, voffB); PG8_STAGE(PG8_SB(0, 1), b2 + hstep, voffB); PG8_STAGE(PG8_SA(0, 0), a2, voffA);
            PG8_WAIT_V(8); PG8_WAIT_L(0); PG8_BAR; PG8_MMA(1, 0, At, B0); PG8_MMA(1, 1, At, B1); PG8_BAR; PG8_SCHED;
            PG8_LDB(B0, 1, 0); PG8_LDB(B1, 1, 1); PG8_SCHED; PG8_LDA(At, 1, 0); PG8_STAGE(PG8_SA(0, 1), a2 + hstep, voffA);
            PG8_WAIT_V(8); PG8_WAIT_L(0); PG8_BAR; PG8_MMA(0, 0, At, B0); PG8_MMA(0, 1, At, B1); PG8_BAR; PG8_SCHED;
            PG8_LDA(At, 1, 1); PG8_STAGE(PG8_SB(1, 0), b3, voffB); PG8_STAGE(PG8_SB(1, 1), b3 + hstep, voffB); PG8_STAGE(PG8_SA(1, 0), a3, voffA);
            PG8_WAIT_V(8); PG8_WAIT_L(0); PG8_BAR; PG8_MMA(1, 0, At, B0); PG8_MMA(1, 1, At, B1); PG8_BAR; PG8_SCHED;
            } else {
            PG8_LDB(B0, 0, 0); PG8_SCHED; PG8_LDA(At, 0, 0); PG8_STAGE(PG8_SA(1, 1), a1 + hstep, voffA);
            PG8_WAIT_L(8); PG8_BAR; PG8_WAIT_L(0); PG8_MMA(0, 0, At, B0); PG8_BAR; PG8_SCHED;
            PG8_LDB(B1, 0, 1); PG8_STAGE(PG8_SB(0, 0), b2, voffB);
            PG8_BAR; PG8_WAIT_L(0); PG8_MMA(0, 1, At, B1); PG8_BAR;
            PG8_LDA(At, 0, 1); PG8_STAGE(PG8_SA(0, 0), a2, voffA);
            PG8_BAR; PG8_WAIT_L(0); PG8_MMA(1, 0, At, B0); PG8_BAR; PG8_SCHED;
            PG8_STAGE(PG8_SB(0, 1), b2 + hstep, voffB);
            PG8_WAIT_V(6); PG8_BAR; PG8_MMA(1, 1, At, B1); PG8_BAR;
            PG8_LDB(B0, 1, 0); PG8_SCHED; PG8_LDA(At, 1, 0); PG8_STAGE(PG8_SA(0, 1), a2 + hstep, voffA);
            PG8_WAIT_L(8); PG8_BAR; PG8_WAIT_L(0); PG8_MMA(0, 0, At, B0); PG8_BAR; PG8_SCHED;
            PG8_LDB(B1, 1, 1); PG8_STAGE(PG8_SB(1, 0), b3, voffB);
            PG8_BAR; PG8_WAIT_L(0); PG8_MMA(0, 1, At, B1); PG8_BAR;
            PG8_LDA(At, 1, 1); PG8_STAGE(PG8_SA(1, 0), a3, voffA);
            PG8_BAR; PG8_WAIT_L(0); PG8_MMA(1, 0, At, B0); PG8_BAR; PG8_SCHED;
            PG8_STAGE(PG8_SB(1, 1), b3 + hstep, voffB);
            PG8_WAIT_V(6); PG8_BAR; PG8_MMA(1, 1, At, B1); PG8_BAR;
            }
        }
        if constexpr (ALIGN_EPI) { if (wr == 0) PG8_BAR; }
        if constexpr (!Epi::AFTER_DRAIN) { E(acc, cur, wr, wc, fr, fq); S.done(cur); }
        if (!has_next) break;
#pragma unroll
        for (int a = 0; a < 2; ++a)
#pragma unroll
            for (int b = 0; b < 2; ++b)
#pragma unroll
                for (int m = 0; m < 4; ++m)
#pragma unroll
                    for (int n = 0; n < 2; ++n) acc[a][b][m][n] = (f32x4){0.f, 0.f, 0.f, 0.f};
        cur = nxt; cA = nA; cB = nB; ++ui;
        if constexpr (ALIGN_EPI) { if (wr == 1) PG8_BAR; }
    }
    PG8_WAIT_V(0);
    if constexpr (!ALIGN_EPI) { if (wr == 0) PG8_BAR; }
    PG8_BAR;
    if constexpr (Epi::AFTER_DRAIN) { E.fused(acc, cur, wr, wc, fr, fq, lds, wid, lane); S.done(cur); }
#undef PG8_SA
#undef PG8_SB
#undef PG8_STAGE
#undef PG8_LDA
#undef PG8_LDB
#undef PG8_MMA
#undef PG8_WAIT_V
#undef PG8_WAIT_L
#undef PG8_BAR
#undef PG8_SCHED
}
}

#define DI __device__ __forceinline__
#define LAS __attribute__((address_space(3)))
typedef unsigned short bf16_t;
typedef short bf16x8 __attribute__((ext_vector_type(8)));
typedef float f32x4 __attribute__((ext_vector_type(4)));
typedef unsigned u32x4 __attribute__((ext_vector_type(4)));
typedef unsigned u32x2 __attribute__((ext_vector_type(2)));

constexpr int NT = 512;
constexpr int MT = 32768, SEQ = 16384, DMODEL = 1024, DFF = 2816;
constexpr int NITEM = 3072;
constexpr size_t MiB = 1u << 20;
constexpr size_t WS_CS = 1 * MiB;
constexpr size_t WS_AB = 3 * MiB;
constexpr size_t WS_MEMN = 5 * MiB;
constexpr size_t WS_MKV = 6 * MiB;
constexpr size_t WS_WMKV = 8 * MiB;
constexpr size_t WS_WKV = 12 * MiB;
constexpr size_t WS_GL = 13 * MiB;
constexpr size_t WS_KV = 14 * MiB;
constexpr size_t WS_WA0 = 30 * MiB;
constexpr size_t WSLOT = 26 * MiB;
constexpr size_t WO_IN = 0, WO_OUT = 7 * MiB, WO_GU = 9 * MiB, WO_DN = 20 * MiB;
constexpr size_t WS_P1 = 82 * MiB;
constexpr size_t WS_OT = 82 * MiB;
constexpr size_t WS_MIX = 130 * MiB;
constexpr size_t WS_ACT = 82 * MiB;
constexpr size_t WS_HKV = 82 * MiB;
constexpr size_t WS_P2 = 226 * MiB;
constexpr size_t WS_H = 290 * MiB;
constexpr size_t WS_QG = 290 * MiB;
constexpr size_t WS_KGT = 338 * MiB;
constexpr size_t WS_UT = 386 * MiB;
constexpr size_t WS_WP = 434 * MiB;
constexpr size_t WS_AI = 482 * MiB;
constexpr size_t WS_WB0 = 386 * MiB;
constexpr size_t WS_SSQ = 506 * MiB;
constexpr size_t WS_END = 508 * MiB;
constexpr int LDS_BYTES = 135168;

struct Params {
    const float* x; const float* mem; const int* pos; const float* ln_mix; const float* ln_ffn; const float* ln_mem;
    const float* w_mem_kv; const float* w_out; const float* w_gate_up; const float* w_down; const float* gdn_w_in;
    const float* gdn_conv; const float* gdn_A_log; const float* gdn_dt_bias; const float* gdn_norm; const float* swa_w_q;
    const float* swa_sinks; const float* ln_kv; const float* w_kv; const float* ln_final;
    float* out; unsigned char* ws;
    float inv[8];
};

typedef const Params& PRef;
DI unsigned f2bf(float f) { unsigned u = __float_as_uint(f); return (u + 0x7fffu + ((u >> 16) & 1u)) >> 16; }
typedef float f32x2_t __attribute__((ext_vector_type(2)));
typedef __bf16 bf16x2_t __attribute__((ext_vector_type(2)));
DI unsigned pk2(float lo, float hi) { f32x2_t v = {lo, hi}; bf16x2_t b = __builtin_convertvector(v, bf16x2_t); return __builtin_bit_cast(unsigned, b); }
DI float bflo(unsigned w) { return __uint_as_float(w << 16); }
DI float bfhi(unsigned w) { return __uint_as_float(w & 0xffff0000u); }
DI float bf2f(bf16_t b) { return __uint_as_float((unsigned)b << 16); }
DI bf16x8 pack8(f32x4 a, f32x4 b) { u32x4 p; p.x = pk2(a[0], a[1]); p.y = pk2(a[2], a[3]); p.z = pk2(b[0], b[1]); p.w = pk2(b[2], b[3]); return __builtin_bit_cast(bf16x8, p); }
DI float shx(float v, int mask) { const int ln = tidx() & 63; return __builtin_bit_cast(float, __builtin_amdgcn_ds_bpermute((ln ^ mask) << 2, __builtin_bit_cast(int, v))); }
DI float shup(float v, int d) { const int ln = tidx() & 63; return __builtin_bit_cast(float, __builtin_amdgcn_ds_bpermute((ln - d) << 2, __builtin_bit_cast(int, v))); }
DI LAS unsigned char* lnd(LAS unsigned char* q) { asm volatile("" : "+v"(q)); return q; }
#define uni(x) (x)
DI void lds_barrier() { asm volatile("s_waitcnt lgkmcnt(0)" ::: "memory"); __builtin_amdgcn_s_barrier(); asm volatile("" ::: "memory"); }
DI float wave_sum(float v) {
#pragma unroll
    for (int o = 32; o; o >>= 1) v += shx(v, o);
    return v; }
DI float siluf(float v) { return v * __builtin_amdgcn_rcpf(1.f + __expf(-v)); }
DI int tslot(int t) { return (t & ~31) + 8 * ((t & 15) >> 2) + 4 * ((t >> 4) & 1) + (t & 3); }
#define MFMA16(a, b, c) __builtin_amdgcn_mfma_f32_16x16x32_bf16((a), (b), (c), 0, 0, 0)

struct Epi {
    static constexpr bool PERM = true, AFTER_DRAIN = false;
    int mode; int ldc; bf16_t* o0; bf16_t* o1; float* f0; const float* base; const float* cs; float* ssq;
    DI void st8(bf16_t* p, f32x4 v0, f32x4 v1) const { u32x4 w; w.x = pk2(v0[0], v0[1]); w.y = pk2(v0[2], v0[3]); w.z = pk2(v1[0], v1[1]); w.w = pk2(v1[2], v1[3]); *(u32x4*)p = w; }
    DI void rope(f32x4& v0, f32x4& v1, int row, int col) const {
        if ((col & 63) < 16) { const f32x4 c = *(const f32x4*)(cs + (size_t)row * 16 + ((col & 63) >> 1)), s = *(const f32x4*)(cs + (size_t)row * 16 + 8 + ((col & 63) >> 1));
            const f32x4 a = v0 * c - v1 * s, b = v1 * c + v0 * s; v0 = a; v1 = b; }
    }
    DI void operator()(const f32x4 (&acc)[2][2][4][2], const pg8::Unit& u, int wr, int wc, int fr, int fq) const {
        const int row0 = u.pm * 256 + wr * 64 + fr;
        float rsv[2][4];
#pragma unroll
        for (int ai = 0; ai < 2; ++ai)
#pragma unroll
            for (int m = 0; m < 4; ++m) rsv[ai][m] = 1.f;
        if (mode != 0 && mode != 4) {
#pragma unroll
            for (int ai = 0; ai < 2; ++ai)
#pragma unroll
                for (int mp = 0; mp < 2; ++mp) {
                    f32x4 t[2][4];
#pragma unroll
                    for (int m = 0; m < 2; ++m) { const f32x4* sp = (const f32x4*)(ssq + (size_t)(row0 + ai * 128 + (2 * mp + m) * 16) * 16); t[m][0] = sp[0]; t[m][1] = sp[1]; t[m][2] = sp[2]; t[m][3] = sp[3]; }
#pragma unroll
                    for (int m = 0; m < 2; ++m) { const f32x4 c = (t[m][0] + t[m][1]) + (t[m][2] + t[m][3]); rsv[ai][2 * mp + m] = rsqrtf(((c[0] + c[1]) + (c[2] + c[3])) * (1.f / 1024.f) + 1e-6f); }
                }
        }
#pragma unroll
        for (int aim = 0; aim < 4; ++aim) { const int ai = aim >> 1, mp = aim & 1;
            f32x4 bs[2][2][2];
            if (mode == 4) {
#pragma unroll
                for (int m = 0; m < 2; ++m)
#pragma unroll
                    for (int bj = 0; bj < 2; ++bj) { const float* bp = base + (size_t)(row0 + ai * 128 + (2 * mp + m) * 16) * 1024 + u.pn * 256 + bj * 128 + wc * 32 + 8 * fq; bs[m][bj][0] = *(const f32x4*)bp; bs[m][bj][1] = *(const f32x4*)(bp + 4); }
            }
#pragma unroll
            for (int m = 2 * mp; m < 2 * mp + 2; ++m) {
                const int row = row0 + ai * 128 + m * 16;
                const float rs = rsv[ai][m]; float ssacc = 0.f;
#pragma unroll
                for (int bj = 0; bj < 2; ++bj) {
                    const int col = u.pn * 256 + bj * 128 + wc * 32 + 8 * fq;
                    f32x4 v0 = acc[ai][bj][m][0] * rs, v1 = acc[ai][bj][m][1] * rs;
                    if (mode == 0) { st8(o0 + (size_t)row * ldc + col, v0, v1); }
                    else if (mode == 1) {
                        if (col < 2304) st8(o0 + (size_t)row * 2304 + col, v0, v1);
                        else if (col < 3328) { if (col >= 3072) { v0 = v0 * 0.125f; v1 = v1 * 0.125f; } st8(o1 + (size_t)row * 1024 + (col - 2304), v0, v1); }
                        else if (col == 3328) { *(f32x4*)(f0 + (size_t)row * 16) = v0; *(f32x4*)(f0 + (size_t)row * 16 + 4) = v1; }
                        else if (col == 3336) { *(f32x4*)(f0 + (size_t)row * 16 + 8) = v0; }
                    }
                    else if (mode == 2) { v0 = v0 * 0.125f; v1 = v1 * 0.125f; if (col < 768) rope(v0, v1, row, col); st8(o0 + (size_t)row * 1024 + col, v0, v1); }
                    else if (mode == 3) { if (col < 128) rope(v0, v1, row, col); st8(o0 + (size_t)row * 256 + col, v0, v1); }
                    else if (mode == 4) { float* op = f0 + (size_t)row * 1024 + col;
                        const f32x4 x0 = bs[m & 1][bj][0] + v0, x1 = bs[m & 1][bj][1] + v1; *(f32x4*)op = x0; *(f32x4*)(op + 4) = x1;
                        st8(o0 + (size_t)row * 1024 + col, x0, x1);
                        ssacc += (x0[0] * x0[0] + x0[1] * x0[1]) + (x0[2] * x0[2] + x0[3] * x0[3]) + (x1[0] * x1[0] + x1[1] * x1[1]) + (x1[2] * x1[2] + x1[3] * x1[3]); }
                    else { u32x2 w; w.x = pk2(siluf(v0[0]) * v1[0], siluf(v0[1]) * v1[1]); w.y = pk2(siluf(v0[2]) * v1[2], siluf(v0[3]) * v1[3]);
                        *(u32x2*)(o0 + (size_t)row * DFF + (col >> 1)) = w; }
                }
                if (mode == 4) { ssacc += shx(ssacc, 16); ssacc += shx(ssacc, 32); if (fq == 0) ssq[(size_t)row * 16 + u.pn * 4 + wc] = ssacc; }
            }
        }
    }
};

DI void run_gemm(LAS unsigned char* lds, const bf16_t* A, const bf16_t* Bt, int M, int N, int K, const Epi& E) {
    pg8::Gemm g{A, Bt, M, N, K}; pg8::StaticOrder S; const int G = gridDim.x, bx = bidx();
    S.init(M, N, G, (G % 8 == 0) ? (bx % 8) * (G / 8) + bx / 8 : bx);
    pg8::gemm_phase<Epi, pg8::StaticOrder, true, true>(lds, g, S, E);
    __syncthreads();
}

DI int wmap(int mode, int n, int N) {
    if (mode == 0) return n < N ? n : -1;
    if (mode == 1) return n < 3072 ? n : (n < 3328 ? 3084 + (n - 3072) : (n < 3340 ? 3072 + (n - 3328) : -1));
    if (mode == 2) { const int g8 = n >> 3, w = n & 7; return w < 4 ? g8 * 4 + w : DFF + g8 * 4 + (w - 4); }
    const int lim = (N == 1024) ? 768 : 128;
    if (n < lim) { const int p = n & 63; if (p < 16) { const int q = p >> 3, jj = p & 7; return (n & ~63) + (jj < 4 ? 4 * q + jj : 8 + 4 * q + (jj - 4)); } }
    return n;
}
DI void wconv(LAS unsigned char* lds, const float* __restrict__ W, int K, int N, bf16_t* Wt, int Nout, int mode, const float* gk = nullptr, int first = -1, int stride = 0) {
    LAS float* tile = (LAS float*)lds; const int tid = tidx(), ntk = K / 64, ntn = Nout / 64;
    if (first < 0) { first = bidx(); stride = gridDim.x; }
    for (int t = first; t < ntk * ntn; t += stride) {
        const int tk = t % ntk, tn = t / ntk, k0 = tk * 64, n0 = tn * 64;
        const int j = tid & 63, kk = tid >> 6; const int c = wmap(mode, n0 + j, N);
#pragma unroll
        for (int i = 0; i < 8; ++i) { const int k = i * 8 + kk; tile[k * 65 + j] = c >= 0 ? W[(size_t)(k0 + k) * N + c] * (gk ? gk[k0 + k] : 1.f) : 0.f; }
        lds_barrier();
        const int nn = tid >> 3, k8 = (tid & 7) * 8; u32x4 o;
        o.x = pk2(tile[(k8 + 0) * 65 + nn], tile[(k8 + 1) * 65 + nn]); o.y = pk2(tile[(k8 + 2) * 65 + nn], tile[(k8 + 3) * 65 + nn]);
        o.z = pk2(tile[(k8 + 4) * 65 + nn], tile[(k8 + 5) * 65 + nn]); o.w = pk2(tile[(k8 + 6) * 65 + nn], tile[(k8 + 7) * 65 + nn]);
        *(u32x4*)(Wt + (size_t)(n0 + nn) * K + k0 + k8) = o;
        lds_barrier();
    }
}
DI void conv_layer_weights(LAS unsigned char* lds, PRef p, int layer, unsigned char* slot, int first = -1, int stride = 0, int mask = 15) {
    if (mask & 1) {
        if (layer < 2) wconv(lds, uni(p.gdn_w_in) + (size_t)layer * 1024 * 3340, 1024, 3340, (bf16_t*)(slot + WO_IN), 3584, 1, uni(p.ln_mix) + layer * 1024, first, stride);
        else wconv(lds, uni(p.swa_w_q) + (size_t)(layer - 2) * 1024 * 1024, 1024, 1024, (bf16_t*)(slot + WO_IN), 1024, 3, uni(p.ln_mix) + layer * 1024, first, stride);
    }
    if (mask & 2) wconv(lds, uni(p.w_out) + (size_t)layer * 1024 * 1024, 1024, 1024, (bf16_t*)(slot + WO_OUT), 1024, 0, nullptr, first, stride);
    if (mask & 4) wconv(lds, uni(p.w_gate_up) + (size_t)layer * 1024 * 5632, 1024, 5632, (bf16_t*)(slot + WO_GU), 5632, 2, uni(p.ln_ffn) + layer * 1024, first, stride);
    if (mask & 8) wconv(lds, uni(p.w_down) + (size_t)layer * DFF * 1024, DFF, 1024, (bf16_t*)(slot + WO_DN), 1024, 0, nullptr, first, stride);
}
DI void norm_rows(const float* x, const float* __restrict__ g, bf16_t* out, int rows) {
    const int lane = tidx() & 63, gw = bidx() * 8 + (tidx() >> 6), nw = gridDim.x * 8;
    for (int r = gw; r < rows; r += nw) {
        const f32x4* xr = (const f32x4*)(x + (size_t)r * 1024); f32x4 v[4]; float ss = 0.f;
#pragma unroll
        for (int i = 0; i < 4; ++i) { v[i] = xr[lane + 64 * i]; ss += v[i][0] * v[i][0] + v[i][1] * v[i][1] + v[i][2] * v[i][2] + v[i][3] * v[i][3]; }
        ss = wave_sum(ss); const float rs = rsqrtf(ss * (1.f / 1024.f) + 1e-6f);
#pragma unroll
        for (int i = 0; i < 4; ++i) { const f32x4 gg = ((const f32x4*)g)[lane + 64 * i]; u32x2 o; o.x = pk2(v[i][0] * rs * gg[0], v[i][1] * rs * gg[1]); o.y = pk2(v[i][2] * rs * gg[2], v[i][3] * rs * gg[3]);
            *(u32x2*)(out + (size_t)r * 1024 + (lane + 64 * i) * 4) = o; }
    }
}
DI void xb_rows(const float* x, bf16_t* out, float* ssq, int rows) {
    const int lane = tidx() & 63, gw = bidx() * 8 + (tidx() >> 6), nw = gridDim.x * 8;
    for (int r = gw; r < rows; r += nw) {
        const f32x4* xr = (const f32x4*)(x + (size_t)r * 1024); f32x4 v[4]; float ss = 0.f;
#pragma unroll
        for (int i = 0; i < 4; ++i) { v[i] = xr[lane + 64 * i]; ss += v[i][0] * v[i][0] + v[i][1] * v[i][1] + v[i][2] * v[i][2] + v[i][3] * v[i][3]; }
        ss = wave_sum(ss);
#pragma unroll
        for (int i = 0; i < 4; ++i) { u32x2 o; o.x = pk2(v[i][0], v[i][1]); o.y = pk2(v[i][2], v[i][3]); *(u32x2*)(out + (size_t)r * 1024 + (lane + 64 * i) * 4) = o; }
        if (lane < 16) ssq[(size_t)r * 16 + lane] = lane == 0 ? ss : 0.f;
    }
}
DI void final_norm(float* x, const float* __restrict__ g, int rows) {
    const int lane = tidx() & 63, gw = bidx() * 8 + (tidx() >> 6), nw = gridDim.x * 8;
    for (int r = gw; r < rows; r += nw) {
        f32x4* xr = (f32x4*)(x + (size_t)r * 1024); f32x4 v[4]; float ss = 0.f;
#pragma unroll
        for (int i = 0; i < 4; ++i) { v[i] = xr[lane + 64 * i]; ss += v[i][0] * v[i][0] + v[i][1] * v[i][1] + v[i][2] * v[i][2] + v[i][3] * v[i][3]; }
        ss = wave_sum(ss); const float rs = rsqrtf(ss * (1.f / 1024.f) + 1e-6f);
#pragma unroll
        for (int i = 0; i < 4; ++i) { const f32x4 gg = ((const f32x4*)g)[lane + 64 * i]; xr[lane + 64 * i] = v[i] * rs * gg; }
    }
}
DI void rope_table(PRef p) {
    float* cs = (float*)(uni(p.ws) + WS_CS);
    for (int idx = bidx() * NT + tidx(); idx < MT * 8; idx += gridDim.x * NT) {
        const int r = idx >> 3, i = idx & 7; const float ang = (float)uni(p.pos)[r] * p.inv[i];
        const double a = (double)ang, k = rint(a * 0.15915494309189535), rr = a - k * 6.283185307179586476925; const double r2 = rr * rr;
        double sn = 1.0 / 51090942171709440000.0, cn = 1.0 / 2432902008176640000.0;
        sn = sn * r2 - 1.0 / 121645100408832000.0; cn = cn * r2 - 1.0 / 6402373705728000.0;
        sn = sn * r2 + 1.0 / 355687428096000.0;    cn = cn * r2 + 1.0 / 20922789888000.0;
        sn = sn * r2 - 1.0 / 1307674368000.0;      cn = cn * r2 - 1.0 / 87178291200.0;
        sn = sn * r2 + 1.0 / 6227020800.0;         cn = cn * r2 + 1.0 / 479001600.0;
        sn = sn * r2 - 1.0 / 39916800.0;           cn = cn * r2 - 1.0 / 3628800.0;
        sn = sn * r2 + 1.0 / 362880.0;             cn = cn * r2 + 1.0 / 40320.0;
        sn = sn * r2 - 1.0 / 5040.0;               cn = cn * r2 - 1.0 / 720.0;
        sn = sn * r2 + 1.0 / 120.0;                cn = cn * r2 + 1.0 / 24.0;
        sn = sn * r2 - 1.0 / 6.0;                  cn = cn * r2 - 0.5;
        sn = sn * r2 + 1.0;                        cn = cn * r2 + 1.0;
        sn = sn * rr;
        cs[(size_t)r * 16 + i] = (float)cn; cs[(size_t)r * 16 + 8 + i] = (float)sn;
    }
}

DI void gdn_chunk_phase(LAS unsigned char* lds, PRef p, int a) {
    const bf16_t* P1 = (const bf16_t*)(uni(p.ws) + WS_P1); const float* ab = (const float*)(uni(p.ws) + WS_AB);
    const float* convw = uni(p.gdn_conv) + (size_t)a * 4 * 2304; const float* A_log = uni(p.gdn_A_log) + a * 6; const float* dtb = uni(p.gdn_dt_bias) + a * 6;
    bf16_t* QG = (bf16_t*)(uni(p.ws) + WS_QG); bf16_t* WP = (bf16_t*)(uni(p.ws) + WS_WP); bf16_t* KGT = (bf16_t*)(uni(p.ws) + WS_KGT); bf16_t* UT = (bf16_t*)(uni(p.ws) + WS_UT);
    bf16_t* AI = (bf16_t*)(uni(p.ws) + WS_AI); float* GL = (float*)(uni(p.ws) + WS_GL);
    LAS float* RHS = (LAS float*)lds;
    LAS unsigned char* RAW = lds;
    LAS bf16_t* Qb = (LAS bf16_t*)(lds + 65536);
    LAS bf16_t* Kb = (LAS bf16_t*)(lds + 65536 + 17408);
    LAS float* Lm = (LAS float*)(lds + 65536 + 34816);
    LAS float* CW = (LAS float*)(lds + 116736);
    LAS float* gcs = (LAS float*)(lds + 122880);
    u32x4 pr[7]; float pcw[3], pbl = 0.f, pal = 0.f, pAl = 0.f, pdt = 0.f;
#define CH_LOAD(itn) do { const int tid_ = tidx(), h_ = (itn) % 6, cn_ = (itn) / 6, n_ = cn_ & 255, t0_ = cn_ * 64; \
        _Pragma("unroll") for (int i = 0; i < 7; ++i) { const int idx = tid_ + NT * i, rr = idx / 48, pc = idx % 48, sec = pc >> 4, off = (pc & 15) * 8; \
            pr[i] = (u32x4){0u, 0u, 0u, 0u}; if (idx < 67 * 48 && (rr >= 3 || n_ > 0)) pr[i] = *(const u32x4*)(P1 + (size_t)(t0_ - 3 + rr) * 2304 + sec * 768 + h_ * 128 + off); } \
        _Pragma("unroll") for (int i = 0; i < 3; ++i) { const int idx = tid_ + NT * i, j = idx / 384, c = idx % 384, sec = c >> 7; pcw[i] = convw[j * 2304 + sec * 768 + h_ * 128 + (c & 127)]; } \
        if (tid_ < 64) { pbl = ab[(size_t)(t0_ + tid_) * 16 + h_]; pal = ab[(size_t)(t0_ + tid_) * 16 + 6 + h_]; pAl = A_log[h_]; pdt = dtb[h_]; } } while (0)
    if (bidx() < NITEM) CH_LOAD(bidx());
#pragma unroll 1
    for (int it = bidx(); it < NITEM; it += gridDim.x) {
        const int tid = tidx(), lane = tid & 63, wave = tid >> 6;
        const int h = it % 6, cn = it / 6, t0 = cn * 64;
#pragma unroll
        for (int i = 0; i < 7; ++i) { const int idx = tid + NT * i, rr = idx / 48, pc = idx % 48, sec = pc >> 4, off = (pc & 15) * 8; if (idx < 67 * 48) *(LAS u32x4*)(RAW + rr * 784 + sec * 256 + off * 2) = pr[i]; }
#pragma unroll
        for (int i = 0; i < 3; ++i) CW[tid + NT * i] = pcw[i];
        if (tid < 64) {
            const float bl = pbl, al = pal;
            const float beta = 1.f / (1.f + expf(-bl)); const float xx = al + pdt; const float sp = xx > 20.f ? xx : log1pf(expf(xx));
            float g = -expf(pAl) * sp;
#pragma unroll
            for (int o = 1; o < 64; o <<= 1) { const float y = shup(g, o); if (lane >= o) g += y; }
            const float glast = __builtin_bit_cast(float, __builtin_amdgcn_readlane(__builtin_bit_cast(int, g), 63));
            gcs[tid] = g; gcs[64 + tid] = beta; gcs[128 + tid] = expf(g); gcs[192 + tid] = expf(glast - g);
            if (tid == 63) GL[it] = expf(g);
        }
        lds_barrier();
        const int t = tid >> 3, part = tid & 7;
        float cq[16], ck[16], cv[16];
#pragma unroll
        for (int sec = 0; sec < 3; ++sec)
#pragma unroll
            for (int hf = 0; hf < 2; ++hf) {
                float acc[8];
#pragma unroll
                for (int e = 0; e < 8; ++e) acc[e] = 0.f;
#pragma unroll
                for (int j = 0; j < 4; ++j) {
                    const u32x4 rw = *(const LAS u32x4*)(RAW + (t + j) * 784 + sec * 256 + (part * 16 + hf * 8) * 2);
                    const f32x4 w0 = *(const LAS f32x4*)(CW + j * 384 + sec * 128 + part * 16 + hf * 8), w1 = *(const LAS f32x4*)(CW + j * 384 + sec * 128 + part * 16 + hf * 8 + 4);
                    acc[0] += w0[0] * bflo(rw.x); acc[1] += w0[1] * bfhi(rw.x); acc[2] += w0[2] * bflo(rw.y); acc[3] += w0[3] * bfhi(rw.y);
                    acc[4] += w1[0] * bflo(rw.z); acc[5] += w1[1] * bfhi(rw.z); acc[6] += w1[2] * bflo(rw.w); acc[7] += w1[3] * bfhi(rw.w);
                }
#pragma unroll
                for (int e = 0; e < 8; ++e) { const float s = siluf(acc[e]); if (sec == 0) cq[hf * 8 + e] = s; else if (sec == 1) ck[hf * 8 + e] = s; else cv[hf * 8 + e] = s; }
            }
        float ssq = 0.f, ssk = 0.f;
#pragma unroll
        for (int e = 0; e < 16; ++e) { ssq += cq[e] * cq[e]; ssk += ck[e] * ck[e]; }
        ssq += shx(ssq, 1); ssq += shx(ssq, 2); ssq += shx(ssq, 4);
        ssk += shx(ssk, 1); ssk += shx(ssk, 2); ssk += shx(ssk, 4);
        const float rq = rsqrtf(ssq + 1e-6f) * 0.08838834764831845f, rk = rsqrtf(ssk + 1e-6f);
        const float gct = gcs[t], bt = gcs[64 + t], egt = gcs[128 + t], gclast = gcs[63];
        lds_barrier();
        {
#pragma unroll
            for (int e = 0; e < 16; ++e) { cq[e] *= rq; ck[e] *= rk; }
            u32x4 w;
            w.x = pk2(cq[0], cq[1]); w.y = pk2(cq[2], cq[3]); w.z = pk2(cq[4], cq[5]); w.w = pk2(cq[6], cq[7]); *(LAS u32x4*)(Qb + t * 136 + part * 16) = w;
            w.x = pk2(cq[8], cq[9]); w.y = pk2(cq[10], cq[11]); w.z = pk2(cq[12], cq[13]); w.w = pk2(cq[14], cq[15]); *(LAS u32x4*)(Qb + t * 136 + part * 16 + 8) = w;
            w.x = pk2(ck[0], ck[1]); w.y = pk2(ck[2], ck[3]); w.z = pk2(ck[4], ck[5]); w.w = pk2(ck[6], ck[7]); *(LAS u32x4*)(Kb + t * 136 + part * 16) = w;
            w.x = pk2(ck[8], ck[9]); w.y = pk2(ck[10], ck[11]); w.z = pk2(ck[12], ck[13]); w.w = pk2(ck[14], ck[15]); *(LAS u32x4*)(Kb + t * 136 + part * 16 + 8) = w;
            const float kbe = bt * egt;
#pragma unroll
            for (int e4 = 0; e4 < 4; ++e4) {
                *(LAS f32x4*)(RHS + t * 256 + part * 16 + e4 * 4) = (f32x4){cv[e4 * 4] * bt, cv[e4 * 4 + 1] * bt, cv[e4 * 4 + 2] * bt, cv[e4 * 4 + 3] * bt};
                *(LAS f32x4*)(RHS + t * 256 + 128 + part * 16 + e4 * 4) = (f32x4){ck[e4 * 4] * kbe, ck[e4 * 4 + 1] * kbe, ck[e4 * 4 + 2] * kbe, ck[e4 * 4 + 3] * kbe};
            }
            bf16_t* qgp = QG + (size_t)(t0 + t) * 768 + h * 128 + 32 * (part >> 1) + 4 * (part & 1);
#pragma unroll
            for (int q4 = 0; q4 < 4; ++q4) { u32x2 o; o.x = pk2(cq[q4 * 4] * egt, cq[q4 * 4 + 1] * egt); o.y = pk2(cq[q4 * 4 + 2] * egt, cq[q4 * 4 + 3] * egt); *(u32x2*)(qgp + 8 * q4) = o; }
        }
        lds_barrier();
        {
#pragma unroll
            for (int i = 0; i < 2; ++i) {
                const int pid = tid + NT * i, d = pid >> 3, s8 = pid & 7, tb = 32 * (s8 >> 2) + 4 * (s8 & 3); float v[8];
#pragma unroll
                for (int e = 0; e < 8; ++e) { const int tk = tb + 16 * (e >> 2) + (e & 3); v[e] = bf2f(Kb[tk * 136 + d]) * gcs[192 + tk]; }
                u32x4 w; w.x = pk2(v[0], v[1]); w.y = pk2(v[2], v[3]); w.z = pk2(v[4], v[5]); w.w = pk2(v[6], v[7]);
                *(u32x4*)(KGT + (size_t)it * 8192 + d * 64 + 8 * s8) = w;
            }
            const int mat = wave >> 2, mi = wave & 3, r16 = lane & 15, q = lane >> 4;
            const LAS bf16_t* Ab = Kb + (16 * mi + r16) * 136 + 8 * q;
            bf16x8 af[4];
#pragma unroll
            for (int ks = 0; ks < 4; ++ks) af[ks] = *(const LAS bf16x8*)(Ab + 32 * ks);
            if (mat == 0) {
#pragma unroll
                for (int ni = 0; ni < 4; ++ni) if (ni <= mi) {
                    const LAS bf16_t* Bb = Kb + (16 * ni + r16) * 136 + 8 * q; f32x4 acc = {0.f, 0.f, 0.f, 0.f};
#pragma unroll
                    for (int ks = 0; ks < 4; ++ks) acc = MFMA16(af[ks], *(const LAS bf16x8*)(Bb + 32 * ks), acc);
                    const int kc = 16 * ni + r16; const float gk = gcs[kc];
                    f32x4 lv4;
#pragma unroll
                    for (int j = 0; j < 4; ++j) { const int c = 16 * mi + 4 * q + j; lv4[j] = (c > kc) ? gcs[64 + c] * acc[j] * __expf(fminf(gcs[c] - gk, 0.f)) : 0.f; }
                    *(LAS f32x4*)(Lm + kc * 64 + 16 * mi + 4 * q) = lv4;
                }
            } else {
#pragma unroll
                for (int ni = 0; ni < 4; ++ni) {
                    f32x4 acc = {0.f, 0.f, 0.f, 0.f}; const int c = 16 * ni + r16;
                    if (ni >= mi) {
                        const LAS bf16_t* Bb = Qb + (16 * ni + r16) * 136 + 8 * q;
#pragma unroll
                        for (int ks = 0; ks < 4; ++ks) acc = MFMA16(af[ks], *(const LAS bf16x8*)(Bb + 32 * ks), acc);
                        const float gcc = gcs[c];
#pragma unroll
                        for (int j = 0; j < 4; ++j) { const int kc = 16 * mi + 4 * q + j; acc[j] = (c >= kc) ? acc[j] * __expf(fminf(gcc - gcs[kc], 0.f)) : 0.f; }
                    }
                    u32x2 w; w.x = pk2(acc[0], acc[1]); w.y = pk2(acc[2], acc[3]);
                    *(u32x2*)(AI + (size_t)it * 4096 + c * 64 + 32 * (mi >> 1) + 8 * q + 4 * (mi & 1)) = w;
                }
            }
        }
        lds_barrier();
        { const int itn = (it + (int)gridDim.x < NITEM) ? it + (int)gridDim.x : it; CH_LOAD(itn); }
        if (tid < 256) {
            const LAS float* Lz = Lm + __builtin_amdgcn_mbcnt_lo(0u, 0u);
            float r[64];
#pragma unroll
            for (int i = 0; i < 64; ++i) r[i] = RHS[i * 256 + tid];
            f32x4 ha[8], hb[8];
#define LOADH(buf, j, hf) do { _Pragma("unroll") for (int g = ((((j) + 1) >> 2) > (hf) * 8 ? (((j) + 1) >> 2) : (hf) * 8); g < (hf) * 8 + 8; ++g) buf[g - (hf) * 8] = *(const LAS f32x4*)(Lz + (j) * 64 + 4 * g); } while (0)
#define APPLYH(buf, j, hf) do { const float xj = r[j]; _Pragma("unroll") for (int i = ((j) + 1 > (hf) * 32 ? (j) + 1 : (hf) * 32); i < (hf) * 32 + 32; ++i) r[i] -= buf[(i >> 2) - (hf) * 8][i & 3] * xj; } while (0)
            LOADH(ha, 0, 0);
#pragma unroll
            for (int j = 0; j < 63; ++j) {
                LOADH(hb, j, 1);
                APPLYH(ha, j, 0);
                LOADH(ha, j + 1, 0);
                APPLYH(hb, j, 1);
            }
#undef LOADH
#undef APPLYH
#pragma unroll
            for (int i = 0; i < 64; ++i) RHS[i * 256 + tid] = r[i];
        }
        lds_barrier();
        {
            const int dv = tid >> 2, tq = tid & 3; u32x4 w0, w1; float e[16];
#pragma unroll
            for (int i = 0; i < 16; ++i) e[i] = RHS[(tq * 16 + i) * 256 + dv];
            w0.x = pk2(e[0], e[1]); w0.y = pk2(e[2], e[3]); w0.z = pk2(e[4], e[5]); w0.w = pk2(e[6], e[7]);
            w1.x = pk2(e[8], e[9]); w1.y = pk2(e[10], e[11]); w1.z = pk2(e[12], e[13]); w1.w = pk2(e[14], e[15]);
            bf16_t* up = UT + (size_t)it * 8192 + dv * 64 + tq * 16; *(u32x4*)up = w0; *(u32x4*)(up + 8) = w1;
            bf16_t* wp = WP + (size_t)(t0 + t) * 768 + h * 128 + 32 * (part >> 1) + 4 * (part & 1);
#pragma unroll
            for (int q4 = 0; q4 < 4; ++q4) { const f32x4 xv = *(const LAS f32x4*)(RHS + t * 256 + 128 + part * 16 + q4 * 4); u32x2 o; o.x = pk2(xv[0], xv[1]); o.y = pk2(xv[2], xv[3]); *(u32x2*)(wp + 8 * q4) = o; }
        }
        lds_barrier();
    }
#undef CH_LOAD
}

constexpr int SCAN_NBLK = 96, SCAN_BUF = 62464;
DI void scan_step(const LAS unsigned char* cur, f32x4 (&S)[8], const u32x2 (&uu)[4], float gl, bf16_t* op, int r16, int q) {
    bf16x8 Sb[4];
#pragma unroll
    for (int ks = 0; ks < 4; ++ks) Sb[ks] = pack8(S[2 * ks], S[2 * ks + 1]);
    const LAS unsigned char* bw = cur + r16 * 272 + 16 * q;
    const LAS unsigned char* ba = cur + 34816 + r16 * 144 + 16 * q;
#define FADDR(i) ((i) < 16 ? bw + ((i) % 4) * (16 * 272) + ((i) / 4) * 64 : (i) < 32 ? bw + 17408 + (((i) - 16) % 4) * (16 * 272) + (((i) - 16) / 4) * 64 : \
                  (i) < 40 ? ba + (((i) - 32) % 4) * (16 * 144) + (((i) - 32) / 4) * 64 : ba + 9216 + (((i) - 40) % 8) * (16 * 144) + (((i) - 40) / 8) * 64)
    constexpr int RING = 16; bf16x8 fr[RING]; f32x4 a1[4], o[4]; bf16x8 vb[2];
#pragma unroll
    for (int i = 0; i < 4; ++i) { a1[i] = (f32x4){0.f, 0.f, 0.f, 0.f}; o[i] = (f32x4){0.f, 0.f, 0.f, 0.f}; }
    vb[0] = Sb[0]; vb[1] = Sb[0];
#pragma unroll
    for (int i = 0; i < RING; ++i) fr[i] = *(const LAS bf16x8*)FADDR(i);
#pragma unroll
    for (int i = 0; i < 56; ++i) {
        const bf16x8 f = fr[i % RING];
        if (i + RING < 56) fr[i % RING] = *(const LAS bf16x8*)FADDR(i + RING);
        if (i < 16) a1[i % 4] = MFMA16(f, Sb[i / 4], a1[i % 4]);
        else if (i < 32) o[(i - 16) % 4] = MFMA16(f, Sb[(i - 16) / 4], o[(i - 16) % 4]);
        else if (i < 40) o[(i - 32) % 4] = MFMA16(f, vb[(i - 32) / 4], o[(i - 32) % 4]);
        else { const int dt = (i - 40) % 8, k2 = (i - 40) / 8; if (k2 == 0) S[dt] = S[dt] * gl; S[dt] = MFMA16(f, vb[k2], S[dt]); }
        if (i == 15) {
            f32x4 vn[4];
#pragma unroll
            for (int mt = 0; mt < 4; ++mt) vn[mt] = (f32x4){bflo(uu[mt].x), bfhi(uu[mt].x), bflo(uu[mt].y), bfhi(uu[mt].y)} - a1[mt];
            vb[0] = pack8(vn[0], vn[1]); vb[1] = pack8(vn[2], vn[3]);
        }
        __builtin_amdgcn_sched_barrier(0);
    }
#undef FADDR
#pragma unroll
    for (int mt = 0; mt < 4; ++mt) { u32x2 w; w.x = pk2(o[mt][0], o[mt][1]); w.y = pk2(o[mt][2], o[mt][3]); *(u32x2*)(op + 16 * mt) = w; }
}
DI void gdn_scan_phase(LAS unsigned char* lds, PRef p) {
    if (bidx() >= SCAN_NBLK) return;
    const bf16_t* QG = (const bf16_t*)(uni(p.ws) + WS_QG); const bf16_t* WP = (const bf16_t*)(uni(p.ws) + WS_WP); const bf16_t* KGT = (const bf16_t*)(uni(p.ws) + WS_KGT);
    const bf16_t* UT = (const bf16_t*)(uni(p.ws) + WS_UT); const bf16_t* AI = (const bf16_t*)(uni(p.ws) + WS_AI); const float* GL = (const float*)(uni(p.ws) + WS_GL);
    bf16_t* OT = (bf16_t*)(uni(p.ws) + WS_OT);
    const int tid = tidx(), lane = tid & 63, wave = __builtin_amdgcn_readfirstlane(tid >> 6), r16 = lane & 15, q = lane >> 4;
    const int xcd = bidx() & 7, kx = bidx() >> 3, hg = xcd * 3 + (kx >> 2), bh = hg >> 1, b = bh / 6, h = bh % 6, dv0 = ((hg & 1) * 4 + (kx & 3)) * 16;
    const size_t it0 = (size_t)(b * 256) * 6 + h, tok0 = (size_t)(b * 256) * 64;
    if (wave == 0) {
        f32x4 S[8];
#pragma unroll
        for (int i = 0; i < 8; ++i) S[i] = (f32x4){0.f, 0.f, 0.f, 0.f};
        u32x2 ua[4], ub[4], uc[4], ud[4]; float gla, glb, glc, gld;
        const bf16_t* up = UT + it0 * 8192 + (size_t)(dv0 + r16) * 64 + 4 * q;
        bf16_t* op = OT + it0 * 8192 + (size_t)(dv0 + r16) * 64 + 4 * q;
        const float* glp = GL + it0; const int zdiv = tidx() >> 20;
#define SCAN_LOADU(u, g, nn) do { const size_t o_ = (size_t)min((nn), 255) * (6 * 8192); \
        u[0] = *(const u32x2*)(up + o_); u[1] = *(const u32x2*)(up + o_ + 16); u[2] = *(const u32x2*)(up + o_ + 32); u[3] = *(const u32x2*)(up + o_ + 48); g = glp[min((nn), 255) * 6 + zdiv]; } while (0)
        SCAN_LOADU(ua, gla, 0); SCAN_LOADU(ub, glb, 1); SCAN_LOADU(uc, glc, 2); SCAN_LOADU(ud, gld, 3);
        lds_barrier();
#pragma unroll 1
        for (int n = 0; n < 256; n += 4) {
            scan_step(lds, S, ua, gla, op + (size_t)n * (6 * 8192), r16, q);
            SCAN_LOADU(ua, gla, n + 4);
            lds_barrier();
            scan_step(lds + SCAN_BUF, S, ub, glb, op + (size_t)(n + 1) * (6 * 8192), r16, q);
            SCAN_LOADU(ub, glb, n + 5);
            lds_barrier();
            scan_step(lds, S, uc, glc, op + (size_t)(n + 2) * (6 * 8192), r16, q);
            SCAN_LOADU(uc, glc, n + 6);
            lds_barrier();
            scan_step(lds + SCAN_BUF, S, ud, gld, op + (size_t)(n + 3) * (6 * 8192), r16, q);
            SCAN_LOADU(ud, gld, n + 7);
            lds_barrier();
        }
#undef SCAN_LOADU
    } else {
        const bf16_t* src; size_t sstride; int jsrc, dst, jdst;
        if (wave <= 4) { const int t2 = (tid - 64) & 127, row = t2 >> 4, pc = t2 & 15; const bool isq = wave >= 3;
            src = (isq ? QG : WP) + (tok0 + row) * 768 + h * 128 + pc * 8; sstride = 64 * 768; jsrc = 8 * 768; dst = (isq ? 17408 : 0) + row * 272 + pc * 16; jdst = 8 * 272; }
        else if (wave == 5) { const int t2 = lane; src = AI + it0 * 4096 + t2 * 8; sstride = 6 * 4096; jsrc = 512; dst = 34816 + (t2 >> 3) * 144 + (t2 & 7) * 16; jdst = 8 * 144; }
        else { const int t2 = (tid - 384) & 127; src = KGT + it0 * 8192 + t2 * 8; sstride = 6 * 8192; jsrc = 1024; dst = 44032 + (t2 >> 3) * 144 + (t2 & 7) * 16; jdst = 16 * 144; }
        u32x4 r0[8], r1[8], r2[8], r3[8];
#define SCAN_LOAD(r, nn) do { const bf16_t* s_ = src + (size_t)min((nn), 255) * sstride; \
        _Pragma("unroll") for (int j = 0; j < 8; ++j) r[j] = *(const u32x4*)(s_ + (size_t)j * jsrc); } while (0)
#define SCAN_STORE(r, bufp) do { LAS unsigned char* b_ = (bufp) + dst; \
        _Pragma("unroll") for (int j = 0; j < 8; ++j) *(LAS u32x4*)(b_ + j * jdst) = r[j]; } while (0)
        SCAN_LOAD(r0, 0); SCAN_LOAD(r1, 1); SCAN_LOAD(r2, 2); SCAN_LOAD(r3, 3);
        SCAN_STORE(r0, lds); SCAN_LOAD(r0, 4);
        lds_barrier();
#pragma unroll 1
        for (int n = 0; n < 256; n += 4) {
            SCAN_STORE(r1, lds + SCAN_BUF); SCAN_LOAD(r1, n + 5);
            lds_barrier();
            SCAN_STORE(r2, lds); SCAN_LOAD(r2, n + 6);
            lds_barrier();
            SCAN_STORE(r3, lds + SCAN_BUF); SCAN_LOAD(r3, n + 7);
            lds_barrier();
            SCAN_STORE(r0, lds); SCAN_LOAD(r0, n + 8);
            lds_barrier();
        }
#undef SCAN_LOAD
#undef SCAN_STORE
    }
}

DI void gdn_gate_phase(LAS unsigned char* lds, PRef p, int a) {
    const bf16_t* OT = (const bf16_t*)(uni(p.ws) + WS_OT); const bf16_t* P2 = (const bf16_t*)(uni(p.ws) + WS_P2); bf16_t* MIX = (bf16_t*)(uni(p.ws) + WS_MIX);
    const float* gn = uni(p.gdn_norm) + a * 128; LAS bf16_t* T = (LAS bf16_t*)lds;
    const int tid = tidx(), t = tid >> 3, part = tid & 7;
    for (int it = bidx(); it < NITEM; it += gridDim.x) {
        const int h = it % 6, cn = it / 6, t0 = cn * 64;
#pragma unroll
        for (int i = 0; i < 2; ++i) { const int id = tid + NT * i, row = id >> 3, pc = id & 7; *(LAS u32x4*)(T + row * 72 + pc * 8) = *(const u32x4*)(OT + (size_t)it * 8192 + row * 64 + pc * 8); }
        lds_barrier();
        float o[16]; float ss = 0.f;
#pragma unroll
        for (int e = 0; e < 16; ++e) { o[e] = bf2f(T[(part * 16 + e) * 72 + t]); ss += o[e] * o[e]; }
        ss += shx(ss, 1); ss += shx(ss, 2); ss += shx(ss, 4);
        const float rs = rsqrtf(ss * (1.f / 128.f) + 1e-6f);
        const bf16_t* zp = P2 + (size_t)(t0 + t) * 1024 + h * 128 + part * 16; const u32x4 z0 = *(const u32x4*)zp, z1 = *(const u32x4*)(zp + 8);
        float z[16] = {bflo(z0.x), bfhi(z0.x), bflo(z0.y), bfhi(z0.y), bflo(z0.z), bfhi(z0.z), bflo(z0.w), bfhi(z0.w), bflo(z1.x), bfhi(z1.x), bflo(z1.y), bfhi(z1.y), bflo(z1.z), bfhi(z1.z), bflo(z1.w), bfhi(z1.w)};
        float r[16];
#pragma unroll
        for (int e = 0; e < 16; ++e) r[e] = o[e] * rs * gn[part * 16 + e] * siluf(z[e]);
        u32x4 w0, w1; w0.x = pk2(r[0], r[1]); w0.y = pk2(r[2], r[3]); w0.z = pk2(r[4], r[5]); w0.w = pk2(r[6], r[7]);
        w1.x = pk2(r[8], r[9]); w1.y = pk2(r[10], r[11]); w1.z = pk2(r[12], r[13]); w1.w = pk2(r[14], r[15]);
        bf16_t* mp = MIX + (size_t)(t0 + t) * 1024 + h * 128 + part * 16; *(u32x4*)mp = w0; *(u32x4*)(mp + 8) = w1;
        lds_barrier();
    }
}

template <int MODE> DI void attn_phase(LAS unsigned char* lds, PRef p, int layer, int first = -1, int stride = 0) {
    LAS bf16_t* Ks = (LAS bf16_t*)lds;
    LAS bf16_t* Vt = (LAS bf16_t*)(lds + 36864);
    const bf16_t* Qb = (const bf16_t*)(uni(p.ws) + WS_P2); bf16_t* MIX = (bf16_t*)(uni(p.ws) + WS_MIX);
    const bf16_t* MKV = (const bf16_t*)(uni(p.ws) + WS_MKV); const bf16_t* KV = (const bf16_t*)(uni(p.ws) + WS_KV);
    const int tid = tidx(), lane = tid & 63, wave = tid >> 6, r16 = lane & 15, q = lane >> 4;
    const int nitems = MODE == 0 ? 256 : 512;
    if (first < 0) { first = bidx(); stride = gridDim.x; }
#pragma unroll 1
    for (int it = first; it < nitems; it += stride) {
        int b, hh, tb; size_t tok0;
        if (MODE == 0) { b = it >> 7; hh = (it >> 5) & 3; tb = it & 31; tok0 = (size_t)b * SEQ + tb * 512; }
        else { b = it >> 8; hh = (it >> 7) & 1; tb = it & 127; tok0 = (size_t)b * SEQ + tb * 128; }
#pragma unroll 1
        for (int i = 0; i < 4; ++i) {
            const int id = tid + NT * i, rr = id >> 3, pc = id & 7; u32x4 kv = {0u, 0u, 0u, 0u}, vv = {0u, 0u, 0u, 0u};
            if (MODE == 0) { const bf16_t* kp = MKV + (size_t)(b * 256 + rr) * 2048 + layer * 512 + hh * 64 + pc * 8; kv = *(const u32x4*)kp; vv = *(const u32x4*)(kp + 256); }
            else if (tb > 0 || rr >= 128) { const bf16_t* kp = KV + (tok0 - 128 + rr) * 256 + hh * 64 + pc * 8; kv = *(const u32x4*)kp; vv = *(const u32x4*)(kp + 128); }
            *(LAS u32x4*)(Ks + rr * 72 + pc * 8) = kv;
            LAS bf16_t* vp = Vt + (pc * 8) * 264 + tslot(rr);
            vp[0] = (bf16_t)(vv.x & 0xffffu); vp[264] = (bf16_t)(vv.x >> 16); vp[2 * 264] = (bf16_t)(vv.y & 0xffffu); vp[3 * 264] = (bf16_t)(vv.y >> 16);
            vp[4 * 264] = (bf16_t)(vv.z & 0xffffu); vp[5 * 264] = (bf16_t)(vv.z >> 16); vp[6 * 264] = (bf16_t)(vv.w & 0xffffu); vp[7 * 264] = (bf16_t)(vv.w >> 16);
        }
        lds_barrier();
        const int npass = MODE == 0 ? 32 : 48;
#pragma unroll 1
        for (int ps = wave; ps < npass; ps += 8) {
            int rt, colbase; float sink = 0.f;
            if (MODE == 0) { rt = ps; colbase = 768 + hh * 64; }
            else { const int hq = hh * 6 + (ps >> 3); rt = ps & 7; colbase = hq * 64; sink = uni(p.swa_sinks)[(layer - 2) * 12 + hq]; }
            const size_t tok = tok0 + 16 * rt + r16;
            const bf16_t* qp = Qb + tok * 1024 + colbase + 8 * q;
            const bf16x8 qf0 = *(const bf16x8*)qp, qf1 = *(const bf16x8*)(qp + 32);
            float m = MODE == 1 ? sink : -INFINITY, l = (MODE == 1 && q == 0) ? 1.f : 0.f;
            f32x4 ot[4];
#pragma unroll
            for (int dt = 0; dt < 4; ++dt) ot[dt] = (f32x4){0.f, 0.f, 0.f, 0.f};
            int kk0 = 0, kk1 = 7;
            if (MODE == 1) { kk0 = rt >> 1; if (tb == 0 && kk0 < 4) kk0 = 4; kk1 = (16 * rt + 143) >> 5; }
#pragma unroll 1
            for (int kk = kk0; kk <= kk1; ++kk) {
                const LAS bf16_t* kr = Ks + (32 * kk + r16) * 72 + 8 * q;
                f32x4 s0 = {0.f, 0.f, 0.f, 0.f}, s1 = {0.f, 0.f, 0.f, 0.f};
                s0 = MFMA16(*(const LAS bf16x8*)kr, qf0, s0); s0 = MFMA16(*(const LAS bf16x8*)(kr + 32), qf1, s0);
                s1 = MFMA16(*(const LAS bf16x8*)(kr + 16 * 72), qf0, s1); s1 = MFMA16(*(const LAS bf16x8*)(kr + 16 * 72 + 32), qf1, s1);
                if (MODE == 1) {
#pragma unroll
                    for (int j = 0; j < 4; ++j) { const int d0 = 16 * rt + r16 + 128 - (32 * kk + 4 * q + j), d1 = d0 - 16;
                        if (d0 < 0 || d0 >= 128) s0[j] = -INFINITY; if (d1 < 0 || d1 >= 128) s1[j] = -INFINITY; }
                }
                float gm = fmaxf(fmaxf(fmaxf(s0[0], s0[1]), fmaxf(s0[2], s0[3])), fmaxf(fmaxf(s1[0], s1[1]), fmaxf(s1[2], s1[3])));
                gm = fmaxf(gm, shx(gm, 16)); gm = fmaxf(gm, shx(gm, 32));
                const float mn = fmaxf(m, gm), sc = __expf(m - mn); m = mn; l *= sc;
#pragma unroll
                for (int dt = 0; dt < 4; ++dt) ot[dt] = ot[dt] * sc;
#pragma unroll
                for (int j = 0; j < 4; ++j) { s0[j] = __expf(s0[j] - mn); s1[j] = __expf(s1[j] - mn); l += s0[j] + s1[j]; }
                const bf16x8 pb = pack8(s0, s1);
#pragma unroll
                for (int dt = 0; dt < 4; ++dt) ot[dt] = MFMA16(*(const LAS bf16x8*)(Vt + (16 * dt + r16) * 264 + 32 * kk + 8 * q), pb, ot[dt]);
            }
            l += shx(l, 16); l += shx(l, 32);
            const float inv = 1.f / l; bf16_t* op = MIX + tok * 1024 + colbase + 4 * q;
#pragma unroll
            for (int dt = 0; dt < 4; ++dt) { u32x2 w; w.x = pk2(ot[dt][0] * inv, ot[dt][1] * inv); w.y = pk2(ot[dt][2] * inv, ot[dt][3] * inv); *(u32x2*)(op + 16 * dt) = w; }
        }
        lds_barrier();
    }
}

constexpr int PARAM_OFF = 131072;
DI void grid_bar(unsigned* bar, unsigned gen) {
    __syncthreads();
    if (threadIdx.x == 0) {
        __builtin_amdgcn_fence(__ATOMIC_RELEASE, "agent");
        const unsigned g = blockIdx.x & 7u, ngrp = (gridDim.x + 7u - g) >> 3;
        const unsigned old = __hip_atomic_fetch_add(bar + 64 + 64 * g, 1u, __ATOMIC_RELAXED, __HIP_MEMORY_SCOPE_AGENT);
        if (old + 1u == gen * ngrp) __hip_atomic_fetch_add(bar, 1u, __ATOMIC_RELAXED, __HIP_MEMORY_SCOPE_AGENT);
        const unsigned target = gen * (gridDim.x < 8u ? gridDim.x : 8u);
        while (__hip_atomic_load(bar, __ATOMIC_RELAXED, __HIP_MEMORY_SCOPE_AGENT) < target) __builtin_amdgcn_s_sleep(1);
        __builtin_amdgcn_fence(__ATOMIC_ACQUIRE, "agent");
    }
    __syncthreads();
}
enum { K_P0 = 0, K_GEMM, K_CHUNK, K_SCAN, K_GATE, K_ATTN, K_NORMFFN, K_POST, K_FINAL, K_NOP };

DI void gemm_step(LAS unsigned char* lds, PRef p, int gid, int layer) {
    unsigned char* ws = uni(p.ws); unsigned char* slot = ws + WS_WA0 + (size_t)(layer & 1) * WSLOT;
    const bf16_t* A = (const bf16_t*)(ws + WS_H); const bf16_t* Bt = (const bf16_t*)(slot + WO_IN); int M = MT, N = 1024, K = 1024;
    Epi E{0, 0, nullptr, nullptr, nullptr, nullptr, (const float*)(ws + WS_CS), (float*)(ws + WS_SSQ)};
    if (gid == 0) { A = (const bf16_t*)(ws + WS_MEMN); Bt = (const bf16_t*)(ws + WS_WMKV); M = 512; N = 2048; E.mode = 0; E.ldc = 2048; E.o0 = (bf16_t*)(ws + WS_MKV); }
    else if (gid == 1) { N = 3584; E.mode = 1; E.o0 = (bf16_t*)(ws + WS_P1); E.o1 = (bf16_t*)(ws + WS_P2); E.f0 = (float*)(ws + WS_AB); }
    else if (gid == 2) { E.mode = 2; E.o0 = (bf16_t*)(ws + WS_P2); }
    else if (gid == 3) { Bt = (const bf16_t*)(ws + WS_WKV); N = 256; E.mode = 3; E.o0 = (bf16_t*)(ws + WS_KV); }
    else if (gid == 4) { A = (const bf16_t*)(ws + WS_MIX); Bt = (const bf16_t*)(slot + WO_OUT); E.mode = 4; E.f0 = uni(p.out); E.base = layer == 0 ? uni(p.x) : uni(p.out); E.o0 = (bf16_t*)(ws + WS_H); }
    else if (gid == 5) { Bt = (const bf16_t*)(slot + WO_GU); N = 5632; E.mode = 5; E.o0 = (bf16_t*)(ws + WS_ACT); }
    else { A = (const bf16_t*)(ws + WS_ACT); Bt = (const bf16_t*)(slot + WO_DN); K = DFF; E.mode = 4; E.f0 = uni(p.out); E.base = uni(p.out); E.o0 = (bf16_t*)(ws + WS_H); }
    E.o0 = uni(E.o0); E.o1 = uni(E.o1); E.f0 = uni(E.f0); E.base = uni(E.base); E.cs = uni(E.cs); E.ssq = uni(E.ssq);
    run_gemm(lds, uni(A), uni(Bt), M, N, K, E);
}

__global__ void __launch_bounds__(NT, 2) yoco_fwd(Params pin) {
    extern __shared__ __attribute__((aligned(16))) unsigned char lds_raw[];
    LAS unsigned char* lds = (LAS unsigned char*)lds_raw;
    cg::grid_group grid = cg::this_grid();
    if (blockIdx.x == 0) { ((unsigned*)pin.ws)[threadIdx.x] = 0u; ((unsigned*)pin.ws)[threadIdx.x + NT] = 0u; }
    { const unsigned* src = (const unsigned*)&pin; if (tidx() < sizeof(Params) / 4) ((LAS unsigned*)(lds + PARAM_OFF))[tidx()] = src[tidx()]; }
    __syncthreads();
#define PP pin
    {
        PRef p = PP; unsigned char* ws = uni(p.ws);
        conv_layer_weights(lds, p, 0, ws + WS_WA0, -1, 0, 3);
        wconv(lds, uni(p.w_kv), 1024, 256, (bf16_t*)(ws + WS_WKV), 256, 3, uni(p.ln_kv));
#pragma unroll 1
        for (int l = 0; l < 4; ++l) wconv(lds, uni(p.w_mem_kv) + (size_t)l * 1024 * 512, 1024, 512, (bf16_t*)(ws + WS_WMKV) + (size_t)l * 512 * 1024, 512, 0);
        rope_table(p);
        norm_rows(uni(p.mem), uni(p.ln_mem), (bf16_t*)(ws + WS_MEMN), 512);
        xb_rows(uni(p.x), (bf16_t*)(ws + WS_H), (float*)(ws + WS_SSQ), MT);
        grid.sync();
    }
    constexpr int NSTEP = 14 + 10;
#pragma unroll 1
    for (int s = 0; s < NSTEP; ++s) {
        int kind, layer, gid = 0;
        if (s < 14) { const int k = s % 7; layer = s / 7;
            kind = k == 0 ? K_GEMM : k == 1 ? K_CHUNK : k == 2 ? K_SCAN : k == 3 ? K_GATE : K_GEMM;
            gid = k == 0 ? 1 : k == 4 ? 4 : k == 5 ? 5 : 6; }
        else { const int t = s - 14, k = t % 5; layer = 2 + t / 5;
            kind = k == 1 ? K_ATTN : K_GEMM;
            gid = k == 0 ? 2 : k == 2 ? 4 : k == 3 ? 5 : 6; }
        if (kind == K_GEMM) {
            int g = (s == 0) ? 0 : gid;
            for (;;) { gemm_step(lds, PP, g, layer); if (g == 0) g = gid; else if (g == 2 && layer == 2) g = 3; else break; }
        }
        else if (kind == K_CHUNK) gdn_chunk_phase(lds, PP, layer);
        else if (kind == K_SCAN) { gdn_scan_phase(lds, PP);
            if (bidx() >= SCAN_NBLK) {
                const int f = bidx() - SCAN_NBLK, st = gridDim.x - SCAN_NBLK;
                attn_phase<0>(lds, PP, layer, f, st);
                PRef p = PP;
                if (layer == 0) { conv_layer_weights(lds, p, 0, uni(p.ws) + WS_WA0, f, st, 12); conv_layer_weights(lds, p, 1, uni(p.ws) + WS_WA0 + WSLOT, f, st); }
                else conv_layer_weights(lds, p, 2, uni(p.ws) + WS_WA0, f, st); } }
        else if (kind == K_GATE) gdn_gate_phase(lds, PP, layer);
        else { attn_phase<1>(lds, PP, layer); attn_phase<0>(lds, PP, layer);
            if (layer == 2) { PRef p = PP; conv_layer_weights(lds, p, 3, uni(p.ws) + WS_WA0 + WSLOT); } }
        grid_bar((unsigned*)pin.ws, (unsigned)(s + 1));
    }
    { PRef p = PP; final_norm(uni(p.out), uni(p.ln_final), MT); }
#undef PP
}

extern "C" void kernel_launch(void* const* d_in, const int* in_sizes, int n_in, void* d_out, int out_size, void* d_ws, size_t ws_size, hipStream_t stream) {
    static int grid = 0;
    if (grid == 0) {
        if (n_in != 20 || out_size != MT * DMODEL || ws_size < WS_END) { fprintf(stderr, "kernel_launch: unexpected shapes (n_in %d, out %d, ws %zu)\n", n_in, out_size, ws_size); grid = -1; return; }
        int dev = 0, cus = 0, per_cu = 0;
        (void)hipGetDevice(&dev); (void)hipDeviceGetAttribute(&cus, hipDeviceAttributeMultiprocessorCount, dev);
        if (hipFuncSetAttribute((const void*)yoco_fwd, hipFuncAttributeMaxDynamicSharedMemorySize, LDS_BYTES) != hipSuccess) { fprintf(stderr, "kernel_launch: hipFuncSetAttribute failed\n"); grid = -1; return; }
        (void)hipOccupancyMaxActiveBlocksPerMultiprocessor(&per_cu, (const void*)yoco_fwd, NT, LDS_BYTES);
        (void)hipGetLastError();
        if (per_cu < 1) fprintf(stderr, "kernel_launch: occupancy query says %d blocks/CU\n", per_cu);
        grid = cus > 0 ? cus : 256;
    }
    if (grid < 0) return;
    Params p{};
    p.x = (const float*)d_in[0]; p.mem = (const float*)d_in[1]; p.pos = (const int*)d_in[2]; p.ln_mix = (const float*)d_in[3]; p.ln_ffn = (const float*)d_in[4]; p.ln_mem = (const float*)d_in[5];
    p.w_mem_kv = (const float*)d_in[6]; p.w_out = (const float*)d_in[7]; p.w_gate_up = (const float*)d_in[8]; p.w_down = (const float*)d_in[9]; p.gdn_w_in = (const float*)d_in[10];
    p.gdn_conv = (const float*)d_in[11]; p.gdn_A_log = (const float*)d_in[12]; p.gdn_dt_bias = (const float*)d_in[13]; p.gdn_norm = (const float*)d_in[14]; p.swa_w_q = (const float*)d_in[15];
    p.swa_sinks = (const float*)d_in[16]; p.ln_kv = (const float*)d_in[17]; p.w_kv = (const float*)d_in[18]; p.ln_final = (const float*)d_in[19];
    p.out = (float*)d_out; p.ws = (unsigned char*)d_ws;
    for (int i = 0; i < 8; ++i) p.inv[i] = (float)pow(500000.0, -(double)(2 * i) / 16.0);
    void* args[] = {&p};
    hipError_t e = hipLaunchCooperativeKernel((const void*)yoco_fwd, dim3(grid), dim3(NT), args, LDS_BYTES, stream);
    if (e != hipSuccess) fprintf(stderr, "kernel_launch: cooperative launch failed: %s (grid %d)\n", hipGetErrorString(e), grid);
}
```

```cpp
#include <hip/hip_runtime.h>
#include <hip/hip_cooperative_groups.h>
#include <cstdio>
#include <cstdint>
#include <cmath>
namespace cg = cooperative_groups;
__device__ __forceinline__ int tidx() { int t = threadIdx.x; asm volatile("" : "+v"(t)); return t; }
__device__ __forceinline__ int bidx() { int b = blockIdx.x; asm volatile("" : "+s"(b)); return b; }
namespace pg8 {
#define PG8_LAS __attribute__((address_space(3)))
typedef unsigned short bf16_t;
typedef short bf16x8 __attribute__((ext_vector_type(8)));
typedef float f32x4 __attribute__((ext_vector_type(4)));
typedef unsigned u32x4 __attribute__((ext_vector_type(4)));
constexpr int BM = 256, BK = 64, HALF = 128, HTB = HALF * BK * 2  , STAGE_BYTES = 8 * HTB, NXCD = 8, WGM = 8;

__host__ __device__ __forceinline__ int lds_byte(int r, int c) { const int st = (r >> 4) * 2 + (c >> 5), rr = r & 15, cc = c & 31, ob = rr * 64 + cc * 2; return st * 1024 + (ob ^ (((ob >> 9) & 1) << 5)); }
__host__ __device__ __forceinline__ void stage_rc(int b, int& R, int& C) { const int st = b / 1024, sb = b % 1024, swz = sb ^ (((sb >> 9) & 1) << 5); R = (st >> 1) * 16 + swz / 64; C = (st & 1) * 32 + (swz % 64) / 2; }
__host__ __device__ __forceinline__ int perm32(int rho) { const int n = rho >> 4, i = rho & 15; return 8 * (i >> 2) + 4 * n + (i & 3); }

struct Unit { int pm, pn; };
struct Gemm { const bf16_t* A; const bf16_t* Bt; int M, N, K; };

struct StaticOrder {
    int nM, nN, nwg, G, c;
    __host__ __device__ void init(int M, int N, int G_, int c_) { nM = M / BM; nN = N / BM; nwg = nM * nN; G = G_; c = c_; }
    __host__ __device__ bool next(int i, Unit& u) const {
        const long L = (long)i * G + c; if (L >= nwg) return false;
        int wgid = (int)L; { const int q = nwg / NXCD, r = nwg % NXCD, xcd = wgid % NXCD, off = wgid / NXCD; wgid = (xcd < r ? xcd * (q + 1) : r * (q + 1) + (xcd - r) * q) + off; }
        const int nig = WGM * nN, gid = wgid / nig, fm = gid * WGM, gsz = (nM - fm) < WGM ? (nM - fm) : WGM;
        u.pm = fm + ((wgid % nig) % gsz); u.pn = (wgid % nig) / gsz; return true;
    }
    __device__ __forceinline__ void a_ready(const Unit&) const {}
    __device__ __forceinline__ void done(const Unit&) const {}
};
template <class Epi, class Sched, bool ALIGN_EPI = false, bool SP2 = false>
__device__ __forceinline__ void gemm_phase(PG8_LAS unsigned char* lds, const Gemm g, const Sched& S, const Epi& E) {
    const int tid = tidx(), wid = __builtin_amdgcn_readfirstlane(tid >> 6), lane = tid & 63, wr = wid >> 2, wc = wid & 3, fr = lane & 15, fq = lane >> 4;
    const int K = g.K, nt = K / BK;
    unsigned voffA[2], voffB[2];
#pragma unroll
    for (int i = 0; i < 2; ++i) { int R, C; stage_rc(tid * 16 + i * 8192, R, C); const int Rb = Epi::PERM ? ((R & ~31) + perm32(R & 31)) : R;
        voffA[i] = (unsigned)(R * K + C) * 2u; voffB[i] = (unsigned)(Rb * K + C) * 2u; }
    const size_t kstep = (size_t)(BK * 2);
    const size_t hstep = (size_t)HALF * K * 2;
    const size_t tstep = 2 * hstep;
    const unsigned ldsw = (unsigned)wid * 1024u;
    const int aoff = lds_byte(wr * 64 + fr, fq * 8), boff = lds_byte(wc * 32 + fr, fq * 8);
#define PG8_SA(b, h) (((b) * 2 + (h)) * HTB)
#define PG8_SB(b, h) ((4 + (b) * 2 + (h)) * HTB)
#define PG8_STAGE(bufoff, gbase, voff) do { _Pragma("unroll") for (int _i = 0; _i < 2; ++_i) \
        __builtin_amdgcn_global_load_lds((const unsigned*)((const char*)(gbase) + (voff)[_i]), (PG8_LAS unsigned*)(lds + (bufoff) + ldsw + _i * 8192), 16, 0, 0); } while (0)
#define PG8_LDA(dst, b, h) do { _Pragma("unroll") for (int m = 0; m < 4; ++m) _Pragma("unroll") for (int k = 0; k < 2; ++k) dst[m][k] = *(const PG8_LAS bf16x8*)(lds + PG8_SA(b, h) + aoff + m * 2048 + k * 1024); } while (0)
#define PG8_LDB(dst, b, h) do { _Pragma("unroll") for (int n = 0; n < 2; ++n) _Pragma("unroll") for (int k = 0; k < 2; ++k) dst[n][k] = *(const PG8_LAS bf16x8*)(lds + PG8_SB(b, h) + boff + n * 2048 + k * 1024); } while (0)
#define PG8_MMA(ai, bj, At, Bt) do { __builtin_amdgcn_s_setprio(1); _Pragma("unroll") for (int m = 0; m < 4; ++m) _Pragma("unroll") for (int n = 0; n < 2; ++n) _Pragma("unroll") for (int k = 0; k < 2; ++k) \
        acc[ai][bj][m][n] = __builtin_amdgcn_mfma_f32_16x16x32_bf16(Bt[n][k], At[m][k], acc[ai][bj][m][n], 0, 0, 0); __builtin_amdgcn_s_setprio(0); } while (0)
#define PG8_WAIT_V(n) asm volatile("s_waitcnt vmcnt(" #n ")" ::: "memory")
#define PG8_WAIT_L(n) asm volatile("s_waitcnt lgkmcnt(" #n ")" ::: "memory")
#define PG8_BAR __builtin_amdgcn_s_barrier()
#define PG8_SCHED __builtin_amdgcn_sched_barrier(0)
    Unit cur, nxt; int ui = 0;
    if (!S.next(0, cur)) return;
    f32x4 acc[2][2][4][2];
#pragma unroll
    for (int a = 0; a < 2; ++a)
#pragma unroll
        for (int b = 0; b < 2; ++b)
#pragma unroll
            for (int m = 0; m < 4; ++m)
#pragma unroll
                for (int n = 0; n < 2; ++n) acc[a][b][m][n] = (f32x4){0.f, 0.f, 0.f, 0.f};
    bf16x8 At[4][2], B0[2][2], B1[2][2];
    const char* cA = (const char*)g.A + (size_t)cur.pm * tstep; const char* cB = (const char*)g.Bt + (size_t)cur.pn * tstep;
    S.a_ready(cur);
    if constexpr (SP2) {
        PG8_STAGE(PG8_SB(0, 0), cB, voffB); PG8_STAGE(PG8_SB(0, 1), cB + hstep, voffB); PG8_STAGE(PG8_SA(0, 0), cA, voffA); PG8_STAGE(PG8_SA(0, 1), cA + hstep, voffA);
        if (wr == 1) PG8_BAR;
        PG8_WAIT_V(2); PG8_BAR;
        PG8_STAGE(PG8_SB(1, 0), cB + kstep, voffB); PG8_STAGE(PG8_SA(1, 0), cA + kstep, voffA); PG8_STAGE(PG8_SB(1, 1), cB + hstep + kstep, voffB);
        PG8_WAIT_V(6); PG8_BAR;
    } else {
        PG8_STAGE(PG8_SB(0, 0), cB, voffB); PG8_STAGE(PG8_SA(0, 0), cA, voffA); PG8_STAGE(PG8_SB(0, 1), cB + hstep, voffB); PG8_STAGE(PG8_SA(0, 1), cA + hstep, voffA);
        if (wr == 1) PG8_BAR;
        PG8_WAIT_V(4); PG8_BAR;
        PG8_STAGE(PG8_SB(1, 0), cB + kstep, voffB); PG8_STAGE(PG8_SA(1, 0), cA + kstep, voffA); PG8_STAGE(PG8_SB(1, 1), cB + hstep + kstep, voffB);
        PG8_WAIT_V(6); PG8_BAR;
    }
    for (;;) {
        const bool has_next = S.next(ui + 1, nxt);
        const char* nA = has_next ? (const char*)g.A + (size_t)nxt.pm * tstep : cA; const char* nB = has_next ? (const char*)g.Bt + (size_t)nxt.pn * tstep : cB;
        for (int t = 0; t < nt; t += 2) {
            const bool last = (t == nt - 2);
            const char* a1 = cA + (size_t)(t + 1) * kstep;
            const char* a2 = last ? nA : cA + (size_t)(t + 2) * kstep; const char* b2 = last ? nB : cB + (size_t)(t + 2) * kstep;
            const char* a3 = a2 + kstep; const char* b3 = b2 + kstep;
            if (last && has_next) S.a_ready(nxt);
            if constexpr (SP2) {
            PG8_LDB(B0, 0, 0); PG8_LDB(B1, 0, 1); PG8_SCHED; PG8_LDA(At, 0, 0); PG8_STAGE(PG8_SA(1, 1), a1 + hstep, voffA);
            PG8_WAIT_V(8); PG8_WAIT_L(0); PG8_BAR; PG8_MMA(0, 0, At, B0); PG8_MMA(0, 1, At, B1); PG8_BAR; PG8_SCHED;
            PG8_LDA(At, 0, 1); PG8_STAGE(PG8_SB(0, 0), b2, voffB); PG8_STAGE(PG8_SB(0, 1), b2 + hstep, voffB); PG8_STAGE(PG8_SA(0, 0), a2, voffA);
            PG8_WAIT_V(8); PG8_WAIT_L(0); PG8_BAR; PG8_MMA(1, 0, At, B0); PG8_MMA(1, 1, At, B1); PG8_BAR; PG8_SCHED;
            PG8_LDB(B0, 1, 0); PG8_LDB(B1, 1, 1); PG8_SCHED; PG8_LDA(At, 1, 0); PG8_STAGE(PG8_SA(0, 1), a2 + hstep, voffA);
            PG8_WAIT_V(8); PG8_WAIT_L(0); PG8_BAR; PG8_MMA(0, 0, At, B0); PG8_MMA(0, 1, At, B1); PG8_BAR; PG8_SCHED;
            PG8_LDA(At, 1, 1); PG8_STAGE(PG8_SB(1, 0), b3, voffB); PG8_STAGE(PG8_SB(1, 1), b3 + hstep, voffB); PG8_STAGE(PG8_SA(1, 0), a3, voffA);
            PG8_WAIT_V(8); PG8_WAIT_L(0); PG8_BAR; PG8_MMA(1, 0, At, B0); PG8_MMA(1, 1, At, B1); PG8_BAR; PG8_SCHED;
            } else {
            PG8_LDB(B0, 0, 0); PG8_SCHED; PG8_LDA(At, 0, 0); PG8_STAGE(PG8_SA(1, 1), a1 + hstep, voffA);
            PG8_WAIT_L(8); PG8_BAR; PG8_WAIT_L(0); PG8_MMA(0, 0, At, B0); PG8_BAR; PG8_SCHED;
            PG8_LDB(B1, 0, 1); PG8_STAGE(PG8_SB(0, 0), b2, voffB);
            PG8_BAR; PG8_WAIT_L(0); PG8_MMA(0, 1, At, B1); PG8_BAR;
            PG8_LDA(At, 0, 1); PG8_STAGE(PG8_SA(0, 0), a2, voffA);
            PG8_BAR; PG8_WAIT_L(0); PG8_MMA(1, 0, At, B0); PG8_BAR; PG8_SCHED;
            PG8_STAGE(PG8_SB(0, 1), b2 + hstep, voffB);
            PG8_WAIT_V(6); PG8_BAR; PG8_MMA(1, 1, At, B1); PG8_BAR;
            PG8_LDB(B0, 1, 0); PG8_SCHED; PG8_LDA(At, 1, 0); PG8_STAGE(PG8_SA(0, 1), a2 + hstep, voffA);
            PG8_WAIT_L(8); PG8_BAR; PG8_WAIT_L(0); PG8_MMA(0, 0, At, B0); PG8_BAR; PG8_SCHED;
            PG8_LDB(B1, 1, 1); PG8_STAGE(PG8_SB(1, 0), b3, voffB);
            PG8_BAR; PG8_WAIT_L(0); PG8_MMA(0, 1, At, B1); PG8_BAR;
            PG8_LDA(At, 1, 1); PG8_STAGE(PG8_SA(1, 0), a3, voffA);
            PG8_BAR; PG8_WAIT_L(0); PG8_MMA(1, 0, At, B0); PG8_BAR; PG8_SCHED;
            PG8_STAGE(PG8_SB(1, 1), b3 + hstep, voffB);
            PG8_WAIT_V(6); PG8_BAR; PG8_MMA(1, 1, At, B1); PG8_BAR;
            }
        }
        if constexpr (ALIGN_EPI) { if (wr == 0) PG8_BAR; }
        if constexpr (!Epi::AFTER_DRAIN) { E(acc, cur, wr, wc, fr, fq); S.done(cur); }
        if (!has_next) break;
#pragma unroll
        for (int a = 0; a < 2; ++a)
#pragma unroll
            for (int b = 0; b < 2; ++b)
#pragma unroll
                for (int m = 0; m < 4; ++m)
#pragma unroll
                    for (int n = 0; n < 2; ++n) acc[a][b][m][n] = (f32x4){0.f, 0.f, 0.f, 0.f};
        cur = nxt; cA = nA; cB = nB; ++ui;
        if constexpr (ALIGN_EPI) { if (wr == 1) PG8_BAR; }
    }
    PG8_WAIT_V(0);
    if constexpr (!ALIGN_EPI) { if (wr == 0) PG8_BAR; }
    PG8_BAR;
    if constexpr (Epi::AFTER_DRAIN) { E.fused(acc, cur, wr, wc, fr, fq, lds, wid, lane); S.done(cur); }
#undef PG8_SA
#undef PG8_SB
#undef PG8_STAGE
#undef PG8_LDA
#undef PG8_LDB
#undef PG8_MMA
#undef PG8_WAIT_V
#undef PG8_WAIT_L
#undef PG8_BAR
#undef PG8_SCHED
}
}

#define DI __device__ __forceinline__
#define LAS __attribute__((address_space(3)))
typedef unsigned short bf16_t;
typedef short bf16x8 __attribute__((ext_vector_type(8)));
typedef float f32x4 __attribute__((ext_vector_type(4)));
typedef unsigned u32x4 __attribute__((ext_vector_type(4)));
typedef unsigned u32x2 __attribute__((ext_vector_type(2)));

constexpr int NT = 512;
constexpr int MT = 32768, SEQ = 16384, DMODEL = 1024, DFF = 2816;
constexpr int NITEM = 3072;
constexpr size_t MiB = 1u << 20;
constexpr size_t WS_CS = 1 * MiB;
constexpr size_t WS_AB = 3 * MiB;
constexpr size_t WS_MEMN = 5 * MiB;
constexpr size_t WS_MKV = 6 * MiB;
constexpr size_t WS_WMKV = 8 * MiB;
constexpr size_t WS_WKV = 12 * MiB;
constexpr size_t WS_GL = 13 * MiB;
constexpr size_t WS_KV = 14 * MiB;
constexpr size_t WS_WA0 = 30 * MiB;
constexpr size_t WSLOT = 26 * MiB;
constexpr size_t WO_IN = 0, WO_OUT = 7 * MiB, WO_GU = 9 * MiB, WO_DN = 20 * MiB;
constexpr size_t WS_P1 = 82 * MiB;
constexpr size_t WS_OT = 82 * MiB;
constexpr size_t WS_MIX = 130 * MiB;
constexpr size_t WS_ACT = 82 * MiB;
constexpr size_t WS_HKV = 82 * MiB;
constexpr size_t WS_P2 = 226 * MiB;
constexpr size_t WS_H = 290 * MiB;
constexpr size_t WS_QG = 290 * MiB;
constexpr size_t WS_KGT = 338 * MiB;
constexpr size_t WS_UT = 386 * MiB;
constexpr size_t WS_WP = 434 * MiB;
constexpr size_t WS_AI = 482 * MiB;
constexpr size_t WS_WB0 = 386 * MiB;
constexpr size_t WS_SSQ = 506 * MiB;
constexpr size_t WS_END = 508 * MiB;
constexpr int LDS_BYTES = 135168;

struct Params {
    const float* x; const float* mem; const int* pos; const float* ln_mix; const float* ln_ffn; const float* ln_mem;
    const float* w_mem_kv; const float* w_out; const float* w_gate_up; const float* w_down; const float* gdn_w_in;
    const float* gdn_conv; const float* gdn_A_log; const float* gdn_dt_bias; const float* gdn_norm; const float* swa_w_q;
    const float* swa_sinks; const float* ln_kv; const float* w_kv; const float* ln_final;
    float* out; unsigned char* ws;
    float inv[8];
};

typedef const Params& PRef;
DI unsigned f2bf(float f) { unsigned u = __float_as_uint(f); return (u + 0x7fffu + ((u >> 16) & 1u)) >> 16; }
typedef float f32x2_t __attribute__((ext_vector_type(2)));
typedef __bf16 bf16x2_t __attribute__((ext_vector_type(2)));
DI unsigned pk2(float lo, float hi) { f32x2_t v = {lo, hi}; bf16x2_t b = __builtin_convertvector(v, bf16x2_t); return __builtin_bit_cast(unsigned, b); }
DI float bflo(unsigned w) { return __uint_as_float(w << 16); }
DI float bfhi(unsigned w) { return __uint_as_float(w & 0xffff0000u); }
DI float bf2f(bf16_t b) { return __uint_as_float((unsigned)b << 16); }
DI bf16x8 pack8(f32x4 a, f32x4 b) { u32x4 p; p.x = pk2(a[0], a[1]); p.y = pk2(a[2], a[3]); p.z = pk2(b[0], b[1]); p.w = pk2(b[2], b[3]); return __builtin_bit_cast(bf16x8, p); }
DI float shx(float v, int mask) { const int ln = tidx() & 63; return __builtin_bit_cast(float, __builtin_amdgcn_ds_bpermute((ln ^ mask) << 2, __builtin_bit_cast(int, v))); }
DI float shup(float v, int d) { const int ln = tidx() & 63; return __builtin_bit_cast(float, __builtin_amdgcn_ds_bpermute((ln - d) << 2, __builtin_bit_cast(int, v))); }
DI LAS unsigned char* lnd(LAS unsigned char* q) { asm volatile("" : "+v"(q)); return q; }
#define uni(x) (x)
DI void lds_barrier() { asm volatile("s_waitcnt lgkmcnt(0)" ::: "memory"); __builtin_amdgcn_s_barrier(); asm volatile("" ::: "memory"); }
DI float wave_sum(float v) {
#pragma unroll
    for (int o = 32; o; o >>= 1) v += shx(v, o);
    return v; }
DI float siluf(float v) { return v * __builtin_amdgcn_rcpf(1.f + __expf(-v)); }
DI int tslot(int t) { return (t & ~31) + 8 * ((t & 15) >> 2) + 4 * ((t >> 4) & 1) + (t & 3); }
#define MFMA16(a, b, c) __builtin_amdgcn_mfma_f32_16x16x32_bf16((a), (b), (c), 0, 0, 0)

struct Epi {
    static constexpr bool PERM = true, AFTER_DRAIN = false;
    int mode; int ldc; bf16_t* o0; bf16_t* o1; float* f0; const float* base; const float* cs; float* ssq;
    DI void st8(bf16_t* p, f32x4 v0, f32x4 v1) const { u32x4 w; w.x = pk2(v0[0], v0[1]); w.y = pk2(v0[2], v0[3]); w.z = pk2(v1[0], v1[1]); w.w = pk2(v1[2], v1[3]); *(u32x4*)p = w; }
    DI void rope(f32x4& v0, f32x4& v1, int row, int col) const {
        if ((col & 63) < 16) { const f32x4 c = *(const f32x4*)(cs + (size_t)row * 16 + ((col & 63) >> 1)), s = *(const f32x4*)(cs + (size_t)row * 16 + 8 + ((col & 63) >> 1));
            const f32x4 a = v0 * c - v1 * s, b = v1 * c + v0 * s; v0 = a; v1 = b; }
    }
    DI void operator()(const f32x4 (&acc)[2][2][4][2], const pg8::Unit& u, int wr, int wc, int fr, int fq) const {
        const int row0 = u.pm * 256 + wr * 64 + fr;
        float rsv[2][4];
#pragma unroll
        for (int ai = 0; ai < 2; ++ai)
#pragma unroll
            for (int m = 0; m < 4; ++m) rsv[ai][m] = 1.f;
        if (mode != 0 && mode != 4) {
#pragma unroll
            for (int ai = 0; ai < 2; ++ai)
#pragma unroll
                for (int mp = 0; mp < 2; ++mp) {
                    f32x4 t[2][4];
#pragma unroll
                    for (int m = 0; m < 2; ++m) { const f32x4* sp = (const f32x4*)(ssq + (size_t)(row0 + ai * 128 + (2 * mp + m) * 16) * 16); t[m][0] = sp[0]; t[m][1] = sp[1]; t[m][2] = sp[2]; t[m][3] = sp[3]; }
#pragma unroll
                    for (int m = 0; m < 2; ++m) { const f32x4 c = (t[m][0] + t[m][1]) + (t[m][2] + t[m][3]); rsv[ai][2 * mp + m] = rsqrtf(((c[0] + c[1]) + (c[2] + c[3])) * (1.f / 1024.f) + 1e-6f); }
                }
        }
#pragma unroll
        for (int aim = 0; aim < 4; ++aim) { const int ai = aim >> 1, mp = aim & 1;
            f32x4 bs[2][2][2];
            if (mode == 4) {
#pragma unroll
                for (int m = 0; m < 2; ++m)
#pragma unroll
                    for (int bj = 0; bj < 2; ++bj) { const float* bp = base + (size_t)(row0 + ai * 128 + (2 * mp + m) * 16) * 1024 + u.pn * 256 + bj * 128 + wc * 32 + 8 * fq; bs[m][bj][0] = *(const f32x4*)bp; bs[m][bj][1] = *(const f32x4*)(bp + 4); }
            }
#pragma unroll
            for (int m = 2 * mp; m < 2 * mp + 2; ++m) {
                const int row = row0 + ai * 128 + m * 16;
                const float rs = rsv[ai][m]; float ssacc = 0.f;
                if (mode == 5) {
                    const f32x4 g0 = acc[ai][0][m][0] * rs, g1 = acc[ai][0][m][1] * rs, u0 = acc[ai][1][m][0] * rs, u1 = acc[ai][1][m][1] * rs;
                    st8(o0 + (size_t)row * DFF + u.pn * 128 + wc * 32 + 8 * fq, (f32x4){siluf(g0[0]) * u0[0], siluf(g0[1]) * u0[1], siluf(g0[2]) * u0[2], siluf(g0[3]) * u0[3]},
                        (f32x4){siluf(g1[0]) * u1[0], siluf(g1[1]) * u1[1], siluf(g1[2]) * u1[2], siluf(g1[3]) * u1[3]});
                } else
#pragma unroll
                for (int bj = 0; bj < 2; ++bj) {
                    const int col = u.pn * 256 + bj * 128 + wc * 32 + 8 * fq;
                    f32x4 v0 = acc[ai][bj][m][0] * rs, v1 = acc[ai][bj][m][1] * rs;
                    if (mode == 0) { st8(o0 + (size_t)row * ldc + col, v0, v1); }
                    else if (mode == 1) {
                        if (col < 2304) st8(o0 + (size_t)row * 2304 + col, v0, v1);
                        else if (col < 3328) { if (col >= 3072) { v0 = v0 * 0.125f; v1 = v1 * 0.125f; } st8(o1 + (size_t)row * 1024 + (col - 2304), v0, v1); }
                        else if (col == 3328) { *(f32x4*)(f0 + (size_t)row * 16) = v0; *(f32x4*)(f0 + (size_t)row * 16 + 4) = v1; }
                        else if (col == 3336) { *(f32x4*)(f0 + (size_t)row * 16 + 8) = v0; }
                    }
                    else if (mode == 2) { v0 = v0 * 0.125f; v1 = v1 * 0.125f; if (col < 768) rope(v0, v1, row, col); st8(o0 + (size_t)row * 1024 + col, v0, v1); }
                    else if (mode == 3) { if (col < 128) rope(v0, v1, row, col); st8(o0 + (size_t)row * 256 + col, v0, v1); }
                    else if (mode == 4) { float* op = f0 + (size_t)row * 1024 + col;
                        const f32x4 x0 = bs[m & 1][bj][0] + v0, x1 = bs[m & 1][bj][1] + v1; *(f32x4*)op = x0; *(f32x4*)(op + 4) = x1;
                        st8(o0 + (size_t)row * 1024 + col, x0, x1);
                        ssacc += (x0[0] * x0[0] + x0[1] * x0[1]) + (x0[2] * x0[2] + x0[3] * x0[3]) + (x1[0] * x1[0] + x1[1] * x1[1]) + (x1[2] * x1[2] + x1[3] * x1[3]); }

                }
                if (mode == 4) { ssacc += shx(ssacc, 16); ssacc += shx(ssacc, 32); if (fq == 0) ssq[(size_t)row * 16 + u.pn * 4 + wc] = ssacc; }
            }
        }
    }
};

DI void run_gemm(LAS unsigned char* lds, const bf16_t* A, const bf16_t* Bt, int M, int N, int K, const Epi& E) {
    pg8::Gemm g{A, Bt, M, N, K}; pg8::StaticOrder S; const int G = gridDim.x, bx = bidx();
    S.init(M, N, G, (G % 8 == 0) ? (bx % 8) * (G / 8) + bx / 8 : bx);
    pg8::gemm_phase<Epi, pg8::StaticOrder, true, true>(lds, g, S, E);
    __syncthreads();
}

DI int wmap(int mode, int n, int N) {
    if (mode == 0) return n < N ? n : -1;
    if (mode == 1) return n < 3072 ? n : (n < 3328 ? 3084 + (n - 3072) : (n < 3340 ? 3072 + (n - 3328) : -1));
    if (mode == 2) { const int u = n >> 8, w = n & 255; return w < 128 ? u * 128 + w : DFF + u * 128 + (w - 128); }
    const int lim = (N == 1024) ? 768 : 128;
    if (n < lim) { const int p = n & 63; if (p < 16) { const int q = p >> 3, jj = p & 7; return (n & ~63) + (jj < 4 ? 4 * q + jj : 8 + 4 * q + (jj - 4)); } }
    return n;
}
DI void wconv(LAS unsigned char* lds, const float* __restrict__ W, int K, int N, bf16_t* Wt, int Nout, int mode, const float* gk = nullptr, int first = -1, int stride = 0) {
    LAS float* tile = (LAS float*)lds; const int tid = tidx(), ntk = K / 64, ntn = Nout / 64;
    if (first < 0) { first = bidx(); stride = gridDim.x; }
    for (int t = first; t < ntk * ntn; t += stride) {
        const int tk = t % ntk, tn = t / ntk, k0 = tk * 64, n0 = tn * 64;
        const int j = tid & 63, kk = tid >> 6; const int c = wmap(mode, n0 + j, N);
#pragma unroll
        for (int i = 0; i < 8; ++i) { const int k = i * 8 + kk; tile[k * 65 + j] = c >= 0 ? W[(size_t)(k0 + k) * N + c] * (gk ? gk[k0 + k] : 1.f) : 0.f; }
        lds_barrier();
        const int nn = tid >> 3, k8 = (tid & 7) * 8; u32x4 o;
        o.x = pk2(tile[(k8 + 0) * 65 + nn], tile[(k8 + 1) * 65 + nn]); o.y = pk2(tile[(k8 + 2) * 65 + nn], tile[(k8 + 3) * 65 + nn]);
        o.z = pk2(tile[(k8 + 4) * 65 + nn], tile[(k8 + 5) * 65 + nn]); o.w = pk2(tile[(k8 + 6) * 65 + nn], tile[(k8 + 7) * 65 + nn]);
        *(u32x4*)(Wt + (size_t)(n0 + nn) * K + k0 + k8) = o;
        lds_barrier();
    }
}
DI void conv_layer_weights(LAS unsigned char* lds, PRef p, int layer, unsigned char* slot, int first = -1, int stride = 0, int mask = 15) {
    if (mask & 1) {
        if (layer < 2) wconv(lds, uni(p.gdn_w_in) + (size_t)layer * 1024 * 3340, 1024, 3340, (bf16_t*)(slot + WO_IN), 3584, 1, uni(p.ln_mix) + layer * 1024, first, stride);
        else wconv(lds, uni(p.swa_w_q) + (size_t)(layer - 2) * 1024 * 1024, 1024, 1024, (bf16_t*)(slot + WO_IN), 1024, 3, uni(p.ln_mix) + layer * 1024, first, stride);
    }
    if (mask & 2) wconv(lds, uni(p.w_out) + (size_t)layer * 1024 * 1024, 1024, 1024, (bf16_t*)(slot + WO_OUT), 1024, 0, nullptr, first, stride);
    if (mask & 4) wconv(lds, uni(p.w_gate_up) + (size_t)layer * 1024 * 5632, 1024, 5632, (bf16_t*)(slot + WO_GU), 5632, 2, uni(p.ln_ffn) + layer * 1024, first, stride);
    if (mask & 8) wconv(lds, uni(p.w_down) + (size_t)layer * DFF * 1024, DFF, 1024, (bf16_t*)(slot + WO_DN), 1024, 0, nullptr, first, stride);
}
DI void norm_rows(const float* x, const float* __restrict__ g, bf16_t* out, int rows) {
    const int lane = tidx() & 63, gw = bidx() * 8 + (tidx() >> 6), nw = gridDim.x * 8;
    for (int r = gw; r < rows; r += nw) {
        const f32x4* xr = (const f32x4*)(x + (size_t)r * 1024); f32x4 v[4]; float ss = 0.f;
#pragma unroll
        for (int i = 0; i < 4; ++i) { v[i] = xr[lane + 64 * i]; ss += v[i][0] * v[i][0] + v[i][1] * v[i][1] + v[i][2] * v[i][2] + v[i][3] * v[i][3]; }
        ss = wave_sum(ss); const float rs = rsqrtf(ss * (1.f / 1024.f) + 1e-6f);
#pragma unroll
        for (int i = 0; i < 4; ++i) { const f32x4 gg = ((const f32x4*)g)[lane + 64 * i]; u32x2 o; o.x = pk2(v[i][0] * rs * gg[0], v[i][1] * rs * gg[1]); o.y = pk2(v[i][2] * rs * gg[2], v[i][3] * rs * gg[3]);
            *(u32x2*)(out + (size_t)r * 1024 + (lane + 64 * i) * 4) = o; }
    }
}
DI void xb_rows(const float* x, bf16_t* out, float* ssq, int rows) {
    const int lane = tidx() & 63, gw = bidx() * 8 + (tidx() >> 6), nw = gridDim.x * 8;
    for (int r = gw; r < rows; r += nw) {
        const f32x4* xr = (const f32x4*)(x + (size_t)r * 1024); f32x4 v[4]; float ss = 0.f;
#pragma unroll
        for (int i = 0; i < 4; ++i) { v[i] = xr[lane + 64 * i]; ss += v[i][0] * v[i][0] + v[i][1] * v[i][1] + v[i][2] * v[i][2] + v[i][3] * v[i][3]; }
        ss = wave_sum(ss);
#pragma unroll
        for (int i = 0; i < 4; ++i) { u32x2 o; o.x = pk2(v[i][0], v[i][1]); o.y = pk2(v[i][2], v[i][3]); *(u32x2*)(out + (size_t)r * 1024 + (lane + 64 * i) * 4) = o; }
        if (lane < 16) ssq[(size_t)r * 16 + lane] = lane == 0 ? ss : 0.f;
    }
}
DI void final_norm(float* x, const float* __restrict__ g, int rows) {
    const int lane = tidx() & 63, gw = bidx() * 8 + (tidx() >> 6), nw = gridDim.x * 8;
    for (int r = gw; r < rows; r += nw) {
        f32x4* xr = (f32x4*)(x + (size_t)r * 1024); f32x4 v[4]; float ss = 0.f;
#pragma unroll
        for (int i = 0; i < 4; ++i) { v[i] = xr[lane + 64 * i]; ss += v[i][0] * v[i][0] + v[i][1] * v[i][1] + v[i][2] * v[i][2] + v[i][3] * v[i][3]; }
        ss = wave_sum(ss); const float rs = rsqrtf(ss * (1.f / 1024.f) + 1e-6f);
#pragma unroll
        for (int i = 0; i < 4; ++i) { const f32x4 gg = ((const f32x4*)g)[lane + 64 * i]; xr[lane + 64 * i] = v[i] * rs * gg; }
    }
}
DI void rope_table(PRef p) {
    float* cs = (float*)(uni(p.ws) + WS_CS);
    for (int idx = bidx() * NT + tidx(); idx < MT * 8; idx += gridDim.x * NT) {
        const int r = idx >> 3, i = idx & 7; const float ang = (float)uni(p.pos)[r] * p.inv[i];
        const double a = (double)ang, k = rint(a * 0.15915494309189535), rr = a - k * 6.283185307179586476925; const double r2 = rr * rr;
        double sn = 1.0 / 51090942171709440000.0, cn = 1.0 / 2432902008176640000.0;
        sn = sn * r2 - 1.0 / 121645100408832000.0; cn = cn * r2 - 1.0 / 6402373705728000.0;
        sn = sn * r2 + 1.0 / 355687428096000.0;    cn = cn * r2 + 1.0 / 20922789888000.0;
        sn = sn * r2 - 1.0 / 1307674368000.0;      cn = cn * r2 - 1.0 / 87178291200.0;
        sn = sn * r2 + 1.0 / 6227020800.0;         cn = cn * r2 + 1.0 / 479001600.0;
        sn = sn * r2 - 1.0 / 39916800.0;           cn = cn * r2 - 1.0 / 3628800.0;
        sn = sn * r2 + 1.0 / 362880.0;             cn = cn * r2 + 1.0 / 40320.0;
        sn = sn * r2 - 1.0 / 5040.0;               cn = cn * r2 - 1.0 / 720.0;
        sn = sn * r2 + 1.0 / 120.0;                cn = cn * r2 + 1.0 / 24.0;
        sn = sn * r2 - 1.0 / 6.0;                  cn = cn * r2 - 0.5;
        sn = sn * r2 + 1.0;                        cn = cn * r2 + 1.0;
        sn = sn * rr;
        cs[(size_t)r * 16 + i] = (float)cn; cs[(size_t)r * 16 + 8 + i] = (float)sn;
    }
}

DI void gdn_chunk_phase(LAS unsigned char* lds, PRef p, int a) {
    const bf16_t* P1 = (const bf16_t*)(uni(p.ws) + WS_P1); const float* ab = (const float*)(uni(p.ws) + WS_AB);
    const float* convw = uni(p.gdn_conv) + (size_t)a * 4 * 2304; const float* A_log = uni(p.gdn_A_log) + a * 6; const float* dtb = uni(p.gdn_dt_bias) + a * 6;
    bf16_t* QG = (bf16_t*)(uni(p.ws) + WS_QG); bf16_t* WP = (bf16_t*)(uni(p.ws) + WS_WP); bf16_t* KGT = (bf16_t*)(uni(p.ws) + WS_KGT); bf16_t* UT = (bf16_t*)(uni(p.ws) + WS_UT);
    bf16_t* AI = (bf16_t*)(uni(p.ws) + WS_AI); float* GL = (float*)(uni(p.ws) + WS_GL);
    LAS float* RHS = (LAS float*)lds;
    LAS unsigned char* RAW = lds;
    LAS bf16_t* Qb = (LAS bf16_t*)(lds + 65536);
    LAS bf16_t* Kb = (LAS bf16_t*)(lds + 65536 + 17408);
    LAS float* Lm = (LAS float*)(lds + 65536 + 34816);
    LAS float* CW = (LAS float*)(lds + 116736);
    LAS float* gcs = (LAS float*)(lds + 122880);
    u32x4 pr[7]; float pcw[3], pbl = 0.f, pal = 0.f, pAl = 0.f, pdt = 0.f;
#define CH_LOAD(itn) do { const int tid_ = tidx(), h_ = (itn) % 6, cn_ = (itn) / 6, n_ = cn_ & 255, t0_ = cn_ * 64; \
        _Pragma("unroll") for (int i = 0; i < 7; ++i) { const int idx = tid_ + NT * i, rr = idx / 48, pc = idx % 48, sec = pc >> 4, off = (pc & 15) * 8; \
            pr[i] = (u32x4){0u, 0u, 0u, 0u}; if (idx < 67 * 48 && (rr >= 3 || n_ > 0)) pr[i] = *(const u32x4*)(P1 + (size_t)(t0_ - 3 + rr) * 2304 + sec * 768 + h_ * 128 + off); } \
        _Pragma("unroll") for (int i = 0; i < 3; ++i) { const int idx = tid_ + NT * i, j = idx / 384, c = idx % 384, sec = c >> 7; pcw[i] = convw[j * 2304 + sec * 768 + h_ * 128 + (c & 127)]; } \
        if (tid_ < 64) { pbl = ab[(size_t)(t0_ + tid_) * 16 + h_]; pal = ab[(size_t)(t0_ + tid_) * 16 + 6 + h_]; pAl = A_log[h_]; pdt = dtb[h_]; } } while (0)
    if (bidx() < NITEM) CH_LOAD(bidx());
#pragma unroll 1
    for (int it = bidx(); it < NITEM; it += gridDim.x) {
        const int tid = tidx(), lane = tid & 63, wave = tid >> 6;
        const int h = it % 6, cn = it / 6, t0 = cn * 64;
#pragma unroll
        for (int i = 0; i < 7; ++i) { const int idx = tid + NT * i, rr = idx / 48, pc = idx % 48, sec = pc >> 4, off = (pc & 15) * 8; if (idx < 67 * 48) *(LAS u32x4*)(RAW + rr * 784 + sec * 256 + off * 2) = pr[i]; }
#pragma unroll
        for (int i = 0; i < 3; ++i) CW[tid + NT * i] = pcw[i];
        if (tid < 64) {
            const float bl = pbl, al = pal;
            const float beta = 1.f / (1.f + expf(-bl)); const float xx = al + pdt; const float sp = xx > 20.f ? xx : log1pf(expf(xx));
            float g = -expf(pAl) * sp;
#pragma unroll
            for (int o = 1; o < 64; o <<= 1) { const float y = shup(g, o); if (lane >= o) g += y; }
            const float glast = __builtin_bit_cast(float, __builtin_amdgcn_readlane(__builtin_bit_cast(int, g), 63));
            gcs[tid] = g; gcs[64 + tid] = beta; gcs[128 + tid] = expf(g); gcs[192 + tid] = expf(glast - g);
            if (tid == 63) GL[it] = expf(g);
        }
        lds_barrier();
        const int t = tid >> 3, part = tid & 7;
        float cq[16], ck[16], cv[16];
#pragma unroll
        for (int sec = 0; sec < 3; ++sec)
#pragma unroll
            for (int hf = 0; hf < 2; ++hf) {
                float acc[8];
#pragma unroll
                for (int e = 0; e < 8; ++e) acc[e] = 0.f;
#pragma unroll
                for (int j = 0; j < 4; ++j) {
                    const u32x4 rw = *(const LAS u32x4*)(RAW + (t + j) * 784 + sec * 256 + (part * 16 + hf * 8) * 2);
                    const f32x4 w0 = *(const LAS f32x4*)(CW + j * 384 + sec * 128 + part * 16 + hf * 8), w1 = *(const LAS f32x4*)(CW + j * 384 + sec * 128 + part * 16 + hf * 8 + 4);
                    acc[0] += w0[0] * bflo(rw.x); acc[1] += w0[1] * bfhi(rw.x); acc[2] += w0[2] * bflo(rw.y); acc[3] += w0[3] * bfhi(rw.y);
                    acc[4] += w1[0] * bflo(rw.z); acc[5] += w1[1] * bfhi(rw.z); acc[6] += w1[2] * bflo(rw.w); acc[7] += w1[3] * bfhi(rw.w);
                }
#pragma unroll
                for (int e = 0; e < 8; ++e) { const float s = siluf(acc[e]); if (sec == 0) cq[hf * 8 + e] = s; else if (sec == 1) ck[hf * 8 + e] = s; else cv[hf * 8 + e] = s; }
            }
        float ssq = 0.f, ssk = 0.f;
#pragma unroll
        for (int e = 0; e < 16; ++e) { ssq += cq[e] * cq[e]; ssk += ck[e] * ck[e]; }
        ssq += shx(ssq, 1); ssq += shx(ssq, 2); ssq += shx(ssq, 4);
        ssk += shx(ssk, 1); ssk += shx(ssk, 2); ssk += shx(ssk, 4);
        const float rq = rsqrtf(ssq + 1e-6f) * 0.08838834764831845f, rk = rsqrtf(ssk + 1e-6f);
        const float gct = gcs[t], bt = gcs[64 + t], egt = gcs[128 + t], gclast = gcs[63];
        lds_barrier();
        {
#pragma unroll
            for (int e = 0; e < 16; ++e) { cq[e] *= rq; ck[e] *= rk; }
            u32x4 w;
            w.x = pk2(cq[0], cq[1]); w.y = pk2(cq[2], cq[3]); w.z = pk2(cq[4], cq[5]); w.w = pk2(cq[6], cq[7]); *(LAS u32x4*)(Qb + t * 136 + part * 16) = w;
            w.x = pk2(cq[8], cq[9]); w.y = pk2(cq[10], cq[11]); w.z = pk2(cq[12], cq[13]); w.w = pk2(cq[14], cq[15]); *(LAS u32x4*)(Qb + t * 136 + part * 16 + 8) = w;
            w.x = pk2(ck[0], ck[1]); w.y = pk2(ck[2], ck[3]); w.z = pk2(ck[4], ck[5]); w.w = pk2(ck[6], ck[7]); *(LAS u32x4*)(Kb + t * 136 + part * 16) = w;
            w.x = pk2(ck[8], ck[9]); w.y = pk2(ck[10], ck[11]); w.z = pk2(ck[12], ck[13]); w.w = pk2(ck[14], ck[15]); *(LAS u32x4*)(Kb + t * 136 + part * 16 + 8) = w;
            const float kbe = bt * egt;
#pragma unroll
            for (int e4 = 0; e4 < 4; ++e4) {
                *(LAS f32x4*)(RHS + t * 256 + part * 16 + e4 * 4) = (f32x4){cv[e4 * 4] * bt, cv[e4 * 4 + 1] * bt, cv[e4 * 4 + 2] * bt, cv[e4 * 4 + 3] * bt};
                *(LAS f32x4*)(RHS + t * 256 + 128 + part * 16 + e4 * 4) = (f32x4){ck[e4 * 4] * kbe, ck[e4 * 4 + 1] * kbe, ck[e4 * 4 + 2] * kbe, ck[e4 * 4 + 3] * kbe};
            }
            bf16_t* qgp = QG + (size_t)(t0 + t) * 768 + h * 128 + 32 * (part >> 1) + 4 * (part & 1);
#pragma unroll
            for (int q4 = 0; q4 < 4; ++q4) { u32x2 o; o.x = pk2(cq[q4 * 4] * egt, cq[q4 * 4 + 1] * egt); o.y = pk2(cq[q4 * 4 + 2] * egt, cq[q4 * 4 + 3] * egt); *(u32x2*)(qgp + 8 * q4) = o; }
        }
        lds_barrier();
        {
#pragma unroll
            for (int i = 0; i < 2; ++i) {
                const int pid = tid + NT * i, d = pid >> 3, s8 = pid & 7, tb = 32 * (s8 >> 2) + 4 * (s8 & 3); float v[8];
#pragma unroll
                for (int e = 0; e < 8; ++e) { const int tk = tb + 16 * (e >> 2) + (e & 3); v[e] = bf2f(Kb[tk * 136 + d]) * gcs[192 + tk]; }
                u32x4 w; w.x = pk2(v[0], v[1]); w.y = pk2(v[2], v[3]); w.z = pk2(v[4], v[5]); w.w = pk2(v[6], v[7]);
                *(u32x4*)(KGT + (size_t)it * 8192 + d * 64 + 8 * s8) = w;
            }
            const int mat = wave >> 2, mi = wave & 3, r16 = lane & 15, q = lane >> 4;
            const LAS bf16_t* Ab = Kb + (16 * mi + r16) * 136 + 8 * q;
            bf16x8 af[4];
#pragma unroll
            for (int ks = 0; ks < 4; ++ks) af[ks] = *(const LAS bf16x8*)(Ab + 32 * ks);
            if (mat == 0) {
#pragma unroll
                for (int ni = 0; ni < 4; ++ni) if (ni <= mi) {
                    const LAS bf16_t* Bb = Kb + (16 * ni + r16) * 136 + 8 * q; f32x4 acc = {0.f, 0.f, 0.f, 0.f};
#pragma unroll
                    for (int ks = 0; ks < 4; ++ks) acc = MFMA16(af[ks], *(const LAS bf16x8*)(Bb + 32 * ks), acc);
                    const int kc = 16 * ni + r16; const float gk = gcs[kc];
                    f32x4 lv4;
#pragma unroll
                    for (int j = 0; j < 4; ++j) { const int c = 16 * mi + 4 * q + j; lv4[j] = (c > kc) ? gcs[64 + c] * acc[j] * __expf(fminf(gcs[c] - gk, 0.f)) : 0.f; }
                    *(LAS f32x4*)(Lm + kc * 64 + 16 * mi + 4 * q) = lv4;
                }
            } else {
#pragma unroll
                for (int ni = 0; ni < 4; ++ni) {
                    f32x4 acc = {0.f, 0.f, 0.f, 0.f}; const int c = 16 * ni + r16;
                    if (ni >= mi) {
                        const LAS bf16_t* Bb = Qb + (16 * ni + r16) * 136 + 8 * q;
#pragma unroll
                        for (int ks = 0; ks < 4; ++ks) acc = MFMA16(af[ks], *(const LAS bf16x8*)(Bb + 32 * ks), acc);
                        const float gcc = gcs[c];
#pragma unroll
                        for (int j = 0; j < 4; ++j) { const int kc = 16 * mi + 4 * q + j; acc[j] = (c >= kc) ? acc[j] * __expf(fminf(gcc - gcs[kc], 0.f)) : 0.f; }
                    }
                    u32x2 w; w.x = pk2(acc[0], acc[1]); w.y = pk2(acc[2], acc[3]);
                    *(u32x2*)(AI + (size_t)it * 4096 + c * 64 + 32 * (mi >> 1) + 8 * q + 4 * (mi & 1)) = w;
                }
            }
        }
        lds_barrier();
        { const int itn = (it + (int)gridDim.x < NITEM) ? it + (int)gridDim.x : it; CH_LOAD(itn); }
        if (tid < 256) {
            const LAS float* Lz = Lm + __builtin_amdgcn_mbcnt_lo(0u, 0u);
            float r[64];
#pragma unroll
            for (int i = 0; i < 64; ++i) r[i] = RHS[i * 256 + tid];
            f32x4 ha[8], hb[8];
#define LOADH(buf, j, hf) do { _Pragma("unroll") for (int g = ((((j) + 1) >> 2) > (hf) * 8 ? (((j) + 1) >> 2) : (hf) * 8); g < (hf) * 8 + 8; ++g) buf[g - (hf) * 8] = *(const LAS f32x4*)(Lz + (j) * 64 + 4 * g); } while (0)
#define APPLYH(buf, j, hf) do { const float xj = r[j]; _Pragma("unroll") for (int i = ((j) + 1 > (hf) * 32 ? (j) + 1 : (hf) * 32); i < (hf) * 32 + 32; ++i) r[i] -= buf[(i >> 2) - (hf) * 8][i & 3] * xj; } while (0)
            LOADH(ha, 0, 0);
#pragma unroll
            for (int j = 0; j < 63; ++j) {
                LOADH(hb, j, 1);
                APPLYH(ha, j, 0);
                LOADH(ha, j + 1, 0);
                APPLYH(hb, j, 1);
            }
#undef LOADH
#undef APPLYH
#pragma unroll
            for (int i = 0; i < 64; ++i) RHS[i * 256 + tid] = r[i];
        }
        lds_barrier();
        {
            const int dv = tid >> 2, tq = tid & 3; u32x4 w0, w1; float e[16];
#pragma unroll
            for (int i = 0; i < 16; ++i) e[i] = RHS[(tq * 16 + i) * 256 + dv];
            w0.x = pk2(e[0], e[1]); w0.y = pk2(e[2], e[3]); w0.z = pk2(e[4], e[5]); w0.w = pk2(e[6], e[7]);
            w1.x = pk2(e[8], e[9]); w1.y = pk2(e[10], e[11]); w1.z = pk2(e[12], e[13]); w1.w = pk2(e[14], e[15]);
            bf16_t* up = UT + (size_t)it * 8192 + dv * 64 + tq * 16; *(u32x4*)up = w0; *(u32x4*)(up + 8) = w1;
            bf16_t* wp = WP + (size_t)(t0 + t) * 768 + h * 128 + 32 * (part >> 1) + 4 * (part & 1);
#pragma unroll
            for (int q4 = 0; q4 < 4; ++q4) { const f32x4 xv = *(const LAS f32x4*)(RHS + t * 256 + 128 + part * 16 + q4 * 4); u32x2 o; o.x = pk2(xv[0], xv[1]); o.y = pk2(xv[2], xv[3]); *(u32x2*)(wp + 8 * q4) = o; }
        }
        lds_barrier();
    }
#undef CH_LOAD
}

constexpr int SCAN_NBLK = 96, SCAN_BUF = 62464;
DI void scan_step(const LAS unsigned char* cur, f32x4 (&S)[8], const u32x2 (&uu)[4], float gl, bf16_t* op, int r16, int q) {
    bf16x8 Sb[4];
#pragma unroll
    for (int ks = 0; ks < 4; ++ks) Sb[ks] = pack8(S[2 * ks], S[2 * ks + 1]);
    const LAS unsigned char* bw = cur + r16 * 272 + 16 * q;
    const LAS unsigned char* ba = cur + 34816 + r16 * 144 + 16 * q;
#define FADDR(i) ((i) < 16 ? bw + ((i) % 4) * (16 * 272) + ((i) / 4) * 64 : (i) < 32 ? bw + 17408 + (((i) - 16) % 4) * (16 * 272) + (((i) - 16) / 4) * 64 : \
                  (i) < 40 ? ba + (((i) - 32) % 4) * (16 * 144) + (((i) - 32) / 4) * 64 : ba + 9216 + (((i) - 40) % 8) * (16 * 144) + (((i) - 40) / 8) * 64)
    constexpr int RING = 16; bf16x8 fr[RING]; f32x4 a1[4], o[4]; bf16x8 vb[2];
#pragma unroll
    for (int i = 0; i < 4; ++i) { a1[i] = (f32x4){0.f, 0.f, 0.f, 0.f}; o[i] = (f32x4){0.f, 0.f, 0.f, 0.f}; }
    vb[0] = Sb[0]; vb[1] = Sb[0];
#pragma unroll
    for (int i = 0; i < RING; ++i) fr[i] = *(const LAS bf16x8*)FADDR(i);
#pragma unroll
    for (int i = 0; i < 56; ++i) {
        const bf16x8 f = fr[i % RING];
        if (i + RING < 56) fr[i % RING] = *(const LAS bf16x8*)FADDR(i + RING);
        if (i < 16) a1[i % 4] = MFMA16(f, Sb[i / 4], a1[i % 4]);
        else if (i < 32) o[(i - 16) % 4] = MFMA16(f, Sb[(i - 16) / 4], o[(i - 16) % 4]);
        else if (i < 40) o[(i - 32) % 4] = MFMA16(f, vb[(i - 32) / 4], o[(i - 32) % 4]);
        else { const int dt = (i - 40) % 8, k2 = (i - 40) / 8; if (k2 == 0) S[dt] = S[dt] * gl; S[dt] = MFMA16(f, vb[k2], S[dt]); }
        if (i == 15) {
            f32x4 vn[4];
#pragma unroll
            for (int mt = 0; mt < 4; ++mt) vn[mt] = (f32x4){bflo(uu[mt].x), bfhi(uu[mt].x), bflo(uu[mt].y), bfhi(uu[mt].y)} - a1[mt];
            vb[0] = pack8(vn[0], vn[1]); vb[1] = pack8(vn[2], vn[3]);
        }
        __builtin_amdgcn_sched_barrier(0);
    }
#undef FADDR
#pragma unroll
    for (int mt = 0; mt < 4; ++mt) { u32x2 w; w.x = pk2(o[mt][0], o[mt][1]); w.y = pk2(o[mt][2], o[mt][3]); *(u32x2*)(op + 16 * mt) = w; }
}
DI void gdn_scan_phase(LAS unsigned char* lds, PRef p) {
    if (bidx() >= SCAN_NBLK) return;
    const bf16_t* QG = (const bf16_t*)(uni(p.ws) + WS_QG); const bf16_t* WP = (const bf16_t*)(uni(p.ws) + WS_WP); const bf16_t* KGT = (const bf16_t*)(uni(p.ws) + WS_KGT);
    const bf16_t* UT = (const bf16_t*)(uni(p.ws) + WS_UT); const bf16_t* AI = (const bf16_t*)(uni(p.ws) + WS_AI); const float* GL = (const float*)(uni(p.ws) + WS_GL);
    bf16_t* OT = (bf16_t*)(uni(p.ws) + WS_OT);
    const int tid = tidx(), lane = tid & 63, wave = __builtin_amdgcn_readfirstlane(tid >> 6), r16 = lane & 15, q = lane >> 4;
    const int xcd = bidx() & 7, kx = bidx() >> 3, hg = xcd * 3 + (kx >> 2), bh = hg >> 1, b = bh / 6, h = bh % 6, dv0 = ((hg & 1) * 4 + (kx & 3)) * 16;
    const size_t it0 = (size_t)(b * 256) * 6 + h, tok0 = (size_t)(b * 256) * 64;
    if (wave == 0) {
        f32x4 S[8];
#pragma unroll
        for (int i = 0; i < 8; ++i) S[i] = (f32x4){0.f, 0.f, 0.f, 0.f};
        u32x2 ua[4], ub[4], uc[4], ud[4]; float gla, glb, glc, gld;
        const bf16_t* up = UT + it0 * 8192 + (size_t)(dv0 + r16) * 64 + 4 * q;
        bf16_t* op = OT + it0 * 8192 + (size_t)(dv0 + r16) * 64 + 4 * q;
        const float* glp = GL + it0; const int zdiv = tidx() >> 20;
#define SCAN_LOADU(u, g, nn) do { const size_t o_ = (size_t)min((nn), 255) * (6 * 8192); \
        u[0] = *(const u32x2*)(up + o_); u[1] = *(const u32x2*)(up + o_ + 16); u[2] = *(const u32x2*)(up + o_ + 32); u[3] = *(const u32x2*)(up + o_ + 48); g = glp[min((nn), 255) * 6 + zdiv]; } while (0)
        SCAN_LOADU(ua, gla, 0); SCAN_LOADU(ub, glb, 1); SCAN_LOADU(uc, glc, 2); SCAN_LOADU(ud, gld, 3);
        lds_barrier();
#pragma unroll 1
        for (int n = 0; n < 256; n += 4) {
            scan_step(lds, S, ua, gla, op + (size_t)n * (6 * 8192), r16, q);
            SCAN_LOADU(ua, gla, n + 4);
            lds_barrier();
            scan_step(lds + SCAN_BUF, S, ub, glb, op + (size_t)(n + 1) * (6 * 8192), r16, q);
            SCAN_LOADU(ub, glb, n + 5);
            lds_barrier();
            scan_step(lds, S, uc, glc, op + (size_t)(n + 2) * (6 * 8192), r16, q);
            SCAN_LOADU(uc, glc, n + 6);
            lds_barrier();
            scan_step(lds + SCAN_BUF, S, ud, gld, op + (size_t)(n + 3) * (6 * 8192), r16, q);
            SCAN_LOADU(ud, gld, n + 7);
            lds_barrier();
        }
#undef SCAN_LOADU
    } else {
        const bf16_t* src; size_t sstride; int jsrc, dst, jdst;
        if (wave <= 4) { const int t2 = (tid - 64) & 127, row = t2 >> 4, pc = t2 & 15; const bool isq = wave >= 3;
            src = (isq ? QG : WP) + (tok0 + row) * 768 + h * 128 + pc * 8; sstride = 64 * 768; jsrc = 8 * 768; dst = (isq ? 17408 : 0) + row * 272 + pc * 16; jdst = 8 * 272; }
        else if (wave == 5) { const int t2 = lane; src = AI + it0 * 4096 + t2 * 8; sstride = 6 * 4096; jsrc = 512; dst = 34816 + (t2 >> 3) * 144 + (t2 & 7) * 16; jdst = 8 * 144; }
        else { const int t2 = (tid - 384) & 127; src = KGT + it0 * 8192 + t2 * 8; sstride = 6 * 8192; jsrc = 1024; dst = 44032 + (t2 >> 3) * 144 + (t2 & 7) * 16; jdst = 16 * 144; }
        u32x4 r0[8], r1[8], r2[8], r3[8];
#define SCAN_LOAD(r, nn) do { const bf16_t* s_ = src + (size_t)min((nn), 255) * sstride; \
        _Pragma("unroll") for (int j = 0; j < 8; ++j) r[j] = *(const u32x4*)(s_ + (size_t)j * jsrc); } while (0)
#define SCAN_STORE(r, bufp) do { LAS unsigned char* b_ = (bufp) + dst; \
        _Pragma("unroll") for (int j = 0; j < 8; ++j) *(LAS u32x4*)(b_ + j * jdst) = r[j]; } while (0)
        SCAN_LOAD(r0, 0); SCAN_LOAD(r1, 1); SCAN_LOAD(r2, 2); SCAN_LOAD(r3, 3);
        SCAN_STORE(r0, lds); SCAN_LOAD(r0, 4);
        lds_barrier();
#pragma unroll 1
        for (int n = 0; n < 256; n += 4) {
            SCAN_STORE(r1, lds + SCAN_BUF); SCAN_LOAD(r1, n + 5);
            lds_barrier();
            SCAN_STORE(r2, lds); SCAN_LOAD(r2, n + 6);
            lds_barrier();
            SCAN_STORE(r3, lds + SCAN_BUF); SCAN_LOAD(r3, n + 7);
            lds_barrier();
            SCAN_STORE(r0, lds); SCAN_LOAD(r0, n + 8);
            lds_barrier();
        }
#undef SCAN_LOAD
#undef SCAN_STORE
    }
}

DI void gdn_gate_phase(LAS unsigned char* lds, PRef p, int a) {
    const bf16_t* OT = (const bf16_t*)(uni(p.ws) + WS_OT); const bf16_t* P2 = (const bf16_t*)(uni(p.ws) + WS_P2); bf16_t* MIX = (bf16_t*)(uni(p.ws) + WS_MIX);
    const float* gn = uni(p.gdn_norm) + a * 128; LAS bf16_t* T = (LAS bf16_t*)lds;
    const int tid = tidx(), t = tid >> 3, part = tid & 7;
    for (int it = bidx(); it < NITEM; it += gridDim.x) {
        const int h = it % 6, cn = it / 6, t0 = cn * 64;
#pragma unroll
        for (int i = 0; i < 2; ++i) { const int id = tid + NT * i, row = id >> 3, pc = id & 7; *(LAS u32x4*)(T + row * 72 + pc * 8) = *(const u32x4*)(OT + (size_t)it * 8192 + row * 64 + pc * 8); }
        lds_barrier();
        float o[16]; float ss = 0.f;
#pragma unroll
        for (int e = 0; e < 16; ++e) { o[e] = bf2f(T[(part * 16 + e) * 72 + t]); ss += o[e] * o[e]; }
        ss += shx(ss, 1); ss += shx(ss, 2); ss += shx(ss, 4);
        const float rs = rsqrtf(ss * (1.f / 128.f) + 1e-6f);
        const bf16_t* zp = P2 + (size_t)(t0 + t) * 1024 + h * 128 + part * 16; const u32x4 z0 = *(const u32x4*)zp, z1 = *(const u32x4*)(zp + 8);
        float z[16] = {bflo(z0.x), bfhi(z0.x), bflo(z0.y), bfhi(z0.y), bflo(z0.z), bfhi(z0.z), bflo(z0.w), bfhi(z0.w), bflo(z1.x), bfhi(z1.x), bflo(z1.y), bfhi(z1.y), bflo(z1.z), bfhi(z1.z), bflo(z1.w), bfhi(z1.w)};
        float r[16];
#pragma unroll
        for (int e = 0; e < 16; ++e) r[e] = o[e] * rs * gn[part * 16 + e] * siluf(z[e]);
        u32x4 w0, w1; w0.x = pk2(r[0], r[1]); w0.y = pk2(r[2], r[3]); w0.z = pk2(r[4], r[5]); w0.w = pk2(r[6], r[7]);
        w1.x = pk2(r[8], r[9]); w1.y = pk2(r[10], r[11]); w1.z = pk2(r[12], r[13]); w1.w = pk2(r[14], r[15]);
        bf16_t* mp = MIX + (size_t)(t0 + t) * 1024 + h * 128 + part * 16; *(u32x4*)mp = w0; *(u32x4*)(mp + 8) = w1;
        lds_barrier();
    }
}

template <int MODE> DI void attn_phase(LAS unsigned char* lds, PRef p, int layer, int first = -1, int stride = 0) {
    LAS bf16_t* Ks = (LAS bf16_t*)lds;
    LAS bf16_t* Vt = (LAS bf16_t*)(lds + 36864);
    const bf16_t* Qb = (const bf16_t*)(uni(p.ws) + WS_P2); bf16_t* MIX = (bf16_t*)(uni(p.ws) + WS_MIX);
    const bf16_t* MKV = (const bf16_t*)(uni(p.ws) + WS_MKV); const bf16_t* KV = (const bf16_t*)(uni(p.ws) + WS_KV);
    const int tid = tidx(), lane = tid & 63, wave = tid >> 6, r16 = lane & 15, q = lane >> 4;
    const int nitems = MODE == 0 ? 256 : 512;
    if (first < 0) { first = bidx(); stride = gridDim.x; }
#pragma unroll 1
    for (int it = first; it < nitems; it += stride) {
        int b, hh, tb; size_t tok0;
        if (MODE == 0) { b = it >> 7; hh = (it >> 5) & 3; tb = it & 31; tok0 = (size_t)b * SEQ + tb * 512; }
        else { b = it >> 8; hh = (it >> 7) & 1; tb = it & 127; tok0 = (size_t)b * SEQ + tb * 128; }
#pragma unroll 1
        for (int i = 0; i < 4; ++i) {
            const int id = tid + NT * i, rr = id >> 3, pc = id & 7; u32x4 kv = {0u, 0u, 0u, 0u}, vv = {0u, 0u, 0u, 0u};
            if (MODE == 0) { const bf16_t* kp = MKV + (size_t)(b * 256 + rr) * 2048 + layer * 512 + hh * 64 + pc * 8; kv = *(const u32x4*)kp; vv = *(const u32x4*)(kp + 256); }
            else if (tb > 0 || rr >= 128) { const bf16_t* kp = KV + (tok0 - 128 + rr) * 256 + hh * 64 + pc * 8; kv = *(const u32x4*)kp; vv = *(const u32x4*)(kp + 128); }
            *(LAS u32x4*)(Ks + rr * 72 + pc * 8) = kv;
            LAS bf16_t* vp = Vt + (pc * 8) * 264 + tslot(rr);
            vp[0] = (bf16_t)(vv.x & 0xffffu); vp[264] = (bf16_t)(vv.x >> 16); vp[2 * 264] = (bf16_t)(vv.y & 0xffffu); vp[3 * 264] = (bf16_t)(vv.y >> 16);
            vp[4 * 264] = (bf16_t)(vv.z & 0xffffu); vp[5 * 264] = (bf16_t)(vv.z >> 16); vp[6 * 264] = (bf16_t)(vv.w & 0xffffu); vp[7 * 264] = (bf16_t)(vv.w >> 16);
        }
        lds_barrier();
        const int npass = MODE == 0 ? 32 : 48;
#pragma unroll 1
        for (int ps = wave; ps < npass; ps += 8) {
            int rt, colbase; float sink = 0.f;
            if (MODE == 0) { rt = ps; colbase = 768 + hh * 64; }
            else { const int hq = hh * 6 + (ps >> 3); rt = ps & 7; colbase = hq * 64; sink = uni(p.swa_sinks)[(layer - 2) * 12 + hq]; }
            const size_t tok = tok0 + 16 * rt + r16;
            const bf16_t* qp = Qb + tok * 1024 + colbase + 8 * q;
            const bf16x8 qf0 = *(const bf16x8*)qp, qf1 = *(const bf16x8*)(qp + 32);
            float m = MODE == 1 ? sink : -INFINITY, l = (MODE == 1 && q == 0) ? 1.f : 0.f;
            f32x4 ot[4];
#pragma unroll
            for (int dt = 0; dt < 4; ++dt) ot[dt] = (f32x4){0.f, 0.f, 0.f, 0.f};
            int kk0 = 0, kk1 = 7;
            if (MODE == 1) { kk0 = rt >> 1; if (tb == 0 && kk0 < 4) kk0 = 4; kk1 = (16 * rt + 143) >> 5; }
#pragma unroll 1
            for (int kk = kk0; kk <= kk1; ++kk) {
                const LAS bf16_t* kr = Ks + (32 * kk + r16) * 72 + 8 * q;
                f32x4 s0 = {0.f, 0.f, 0.f, 0.f}, s1 = {0.f, 0.f, 0.f, 0.f};
                s0 = MFMA16(*(const LAS bf16x8*)kr, qf0, s0); s0 = MFMA16(*(const LAS bf16x8*)(kr + 32), qf1, s0);
                s1 = MFMA16(*(const LAS bf16x8*)(kr + 16 * 72), qf0, s1); s1 = MFMA16(*(const LAS bf16x8*)(kr + 16 * 72 + 32), qf1, s1);
                if (MODE == 1) {
#pragma unroll
                    for (int j = 0; j < 4; ++j) { const int d0 = 16 * rt + r16 + 128 - (32 * kk + 4 * q + j), d1 = d0 - 16;
                        if (d0 < 0 || d0 >= 128) s0[j] = -INFINITY; if (d1 < 0 || d1 >= 128) s1[j] = -INFINITY; }
                }
                float gm = fmaxf(fmaxf(fmaxf(s0[0], s0[1]), fmaxf(s0[2], s0[3])), fmaxf(fmaxf(s1[0], s1[1]), fmaxf(s1[2], s1[3])));
                gm = fmaxf(gm, shx(gm, 16)); gm = fmaxf(gm, shx(gm, 32));
                const float mn = fmaxf(m, gm), sc = __expf(m - mn); m = mn; l *= sc;
#pragma unroll
                for (int dt = 0; dt < 4; ++dt) ot[dt] = ot[dt] * sc;
#pragma unroll
                for (int j = 0; j < 4; ++j) { s0[j] = __expf(s0[j] - mn); s1[j] = __expf(s1[j] - mn); l += s0[j] + s1[j]; }
                const bf16x8 pb = pack8(s0, s1);
#pragma unroll
                for (int dt = 0; dt < 4; ++dt) ot[dt] = MFMA16(*(const LAS bf16x8*)(Vt + (16 * dt + r16) * 264 + 32 * kk + 8 * q), pb, ot[dt]);
            }
            l += shx(l, 16); l += shx(l, 32);
            const float inv = 1.f / l; bf16_t* op = MIX + tok * 1024 + colbase + 4 * q;
#pragma unroll
            for (int dt = 0; dt < 4; ++dt) { u32x2 w; w.x = pk2(ot[dt][0] * inv, ot[dt][1] * inv); w.y = pk2(ot[dt][2] * inv, ot[dt][3] * inv); *(u32x2*)(op + 16 * dt) = w; }
        }
        lds_barrier();
    }
}

constexpr int PARAM_OFF = 131072;
DI void grid_bar(unsigned* bar, unsigned gen) {
    __syncthreads();
    if (threadIdx.x == 0) {
        __builtin_amdgcn_fence(__ATOMIC_RELEASE, "agent");
        const unsigned g = blockIdx.x & 7u, ngrp = (gridDim.x + 7u - g) >> 3;
        const unsigned old = __hip_atomic_fetch_add(bar + 64 + 64 * g, 1u, __ATOMIC_RELAXED, __HIP_MEMORY_SCOPE_AGENT);
        if (old + 1u == gen * ngrp) __hip_atomic_fetch_add(bar, 1u, __ATOMIC_RELAXED, __HIP_MEMORY_SCOPE_AGENT);
        const unsigned target = gen * (gridDim.x < 8u ? gridDim.x : 8u);
        while (__hip_atomic_load(bar, __ATOMIC_RELAXED, __HIP_MEMORY_SCOPE_AGENT) < target) __builtin_amdgcn_s_sleep(1);
        __builtin_amdgcn_fence(__ATOMIC_ACQUIRE, "agent");
    }
    __syncthreads();
}
enum { K_P0 = 0, K_GEMM, K_CHUNK, K_SCAN, K_GATE, K_ATTN, K_NORMFFN, K_POST, K_FINAL, K_NOP };

DI void gemm_step(LAS unsigned char* lds, PRef p, int gid, int layer) {
    unsigned char* ws = uni(p.ws); unsigned char* slot = ws + WS_WA0 + (size_t)(layer & 1) * WSLOT;
    const bf16_t* A = (const bf16_t*)(ws + WS_H); const bf16_t* Bt = (const bf16_t*)(slot + WO_IN); int M = MT, N = 1024, K = 1024;
    Epi E{0, 0, nullptr, nullptr, nullptr, nullptr, (const float*)(ws + WS_CS), (float*)(ws + WS_SSQ)};
    if (gid == 0) { A = (const bf16_t*)(ws + WS_MEMN); Bt = (const bf16_t*)(ws + WS_WMKV); M = 512; N = 2048; E.mode = 0; E.ldc = 2048; E.o0 = (bf16_t*)(ws + WS_MKV); }
    else if (gid == 1) { N = 3584; E.mode = 1; E.o0 = (bf16_t*)(ws + WS_P1); E.o1 = (bf16_t*)(ws + WS_P2); E.f0 = (float*)(ws + WS_AB); }
    else if (gid == 2) { E.mode = 2; E.o0 = (bf16_t*)(ws + WS_P2); }
    else if (gid == 3) { Bt = (const bf16_t*)(ws + WS_WKV); N = 256; E.mode = 3; E.o0 = (bf16_t*)(ws + WS_KV); }
    else if (gid == 4) { A = (const bf16_t*)(ws + WS_MIX); Bt = (const bf16_t*)(slot + WO_OUT); E.mode = 4; E.f0 = uni(p.out); E.base = layer == 0 ? uni(p.x) : uni(p.out); E.o0 = (bf16_t*)(ws + WS_H); }
    else if (gid == 5) { Bt = (const bf16_t*)(slot + WO_GU); N = 5632; E.mode = 5; E.o0 = (bf16_t*)(ws + WS_ACT); }
    else { A = (const bf16_t*)(ws + WS_ACT); Bt = (const bf16_t*)(slot + WO_DN); K = DFF; E.mode = 4; E.f0 = uni(p.out); E.base = uni(p.out); E.o0 = (bf16_t*)(ws + WS_H); }
    E.o0 = uni(E.o0); E.o1 = uni(E.o1); E.f0 = uni(E.f0); E.base = uni(E.base); E.cs = uni(E.cs); E.ssq = uni(E.ssq);
    run_gemm(lds, uni(A), uni(Bt), M, N, K, E);
}

__global__ void __launch_bounds__(NT, 2) yoco_fwd(Params pin) {
    extern __shared__ __attribute__((aligned(16))) unsigned char lds_raw[];
    LAS unsigned char* lds = (LAS unsigned char*)lds_raw;
    cg::grid_group grid = cg::this_grid();
    if (blockIdx.x == 0) { ((unsigned*)pin.ws)[threadIdx.x] = 0u; ((unsigned*)pin.ws)[threadIdx.x + NT] = 0u; }
    { const unsigned* src = (const unsigned*)&pin; if (tidx() < sizeof(Params) / 4) ((LAS unsigned*)(lds + PARAM_OFF))[tidx()] = src[tidx()]; }
    __syncthreads();
#define PP pin
    {
        PRef p = PP; unsigned char* ws = uni(p.ws);
        conv_layer_weights(lds, p, 0, ws + WS_WA0, -1, 0, 3);
        wconv(lds, uni(p.w_kv), 1024, 256, (bf16_t*)(ws + WS_WKV), 256, 3, uni(p.ln_kv));
#pragma unroll 1
        for (int l = 0; l < 4; ++l) wconv(lds, uni(p.w_mem_kv) + (size_t)l * 1024 * 512, 1024, 512, (bf16_t*)(ws + WS_WMKV) + (size_t)l * 512 * 1024, 512, 0);
        rope_table(p);
        norm_rows(uni(p.mem), uni(p.ln_mem), (bf16_t*)(ws + WS_MEMN), 512);
        xb_rows(uni(p.x), (bf16_t*)(ws + WS_H), (float*)(ws + WS_SSQ), MT);
        grid.sync();
    }
    constexpr int NSTEP = 14 + 10;
#pragma unroll 1
    for (int s = 0; s < NSTEP; ++s) {
        int kind, layer, gid = 0;
        if (s < 14) { const int k = s % 7; layer = s / 7;
            kind = k == 0 ? K_GEMM : k == 1 ? K_CHUNK : k == 2 ? K_SCAN : k == 3 ? K_GATE : K_GEMM;
            gid = k == 0 ? 1 : k == 4 ? 4 : k == 5 ? 5 : 6; }
        else { const int t = s - 14, k = t % 5; layer = 2 + t / 5;
            kind = k == 1 ? K_ATTN : K_GEMM;
            gid = k == 0 ? 2 : k == 2 ? 4 : k == 3 ? 5 : 6; }
        if (kind == K_GEMM) {
            int g = (s == 0) ? 0 : gid;
            for (;;) { gemm_step(lds, PP, g, layer); if (g == 0) g = gid; else if (g == 2 && layer == 2) g = 3; else break; }
        }
        else if (kind == K_CHUNK) gdn_chunk_phase(lds, PP, layer);
        else if (kind == K_SCAN) { gdn_scan_phase(lds, PP);
            if (bidx() >= SCAN_NBLK) {
                const int f = bidx() - SCAN_NBLK, st = gridDim.x - SCAN_NBLK;
                attn_phase<0>(lds, PP, layer, f, st);
                PRef p = PP;
                if (layer == 0) { conv_layer_weights(lds, p, 0, uni(p.ws) + WS_WA0, f, st, 12); conv_layer_weights(lds, p, 1, uni(p.ws) + WS_WA0 + WSLOT, f, st); }
                else conv_layer_weights(lds, p, 2, uni(p.ws) + WS_WA0, f, st); } }
        else if (kind == K_GATE) gdn_gate_phase(lds, PP, layer);
        else { attn_phase<1>(lds, PP, layer); attn_phase<0>(lds, PP, layer);
            if (layer == 2) { PRef p = PP; conv_layer_weights(lds, p, 3, uni(p.ws) + WS_WA0 + WSLOT); } }
        grid_bar((unsigned*)pin.ws, (unsigned)(s + 1));
    }
    { PRef p = PP; final_norm(uni(p.out), uni(p.ln_final), MT); }
#undef PP
}

extern "C" void kernel_launch(void* const* d_in, const int* in_sizes, int n_in, void* d_out, int out_size, void* d_ws, size_t ws_size, hipStream_t stream) {
    static int grid = 0;
    if (grid == 0) {
        if (n_in != 20 || out_size != MT * DMODEL || ws_size < WS_END) { fprintf(stderr, "kernel_launch: unexpected shapes (n_in %d, out %d, ws %zu)\n", n_in, out_size, ws_size); grid = -1; return; }
        int dev = 0, cus = 0, per_cu = 0;
        (void)hipGetDevice(&dev); (void)hipDeviceGetAttribute(&cus, hipDeviceAttributeMultiprocessorCount, dev);
        if (hipFuncSetAttribute((const void*)yoco_fwd, hipFuncAttributeMaxDynamicSharedMemorySize, LDS_BYTES) != hipSuccess) { fprintf(stderr, "kernel_launch: hipFuncSetAttribute failed\n"); grid = -1; return; }
        (void)hipOccupancyMaxActiveBlocksPerMultiprocessor(&per_cu, (const void*)yoco_fwd, NT, LDS_BYTES);
        (void)hipGetLastError();
        if (per_cu < 1) fprintf(stderr, "kernel_launch: occupancy query says %d blocks/CU\n", per_cu);
        grid = cus > 0 ? cus : 256;
    }
    if (grid < 0) return;
    Params p{};
    p.x = (const float*)d_in[0]; p.mem = (const float*)d_in[1]; p.pos = (const int*)d_in[2]; p.ln_mix = (const float*)d_in[3]; p.ln_ffn = (const float*)d_in[4]; p.ln_mem = (const float*)d_in[5];
    p.w_mem_kv = (const float*)d_in[6]; p.w_out = (const float*)d_in[7]; p.w_gate_up = (const float*)d_in[8]; p.w_down = (const float*)d_in[9]; p.gdn_w_in = (const float*)d_in[10];
    p.gdn_conv = (const float*)d_in[11]; p.gdn_A_log = (const float*)d_in[12]; p.gdn_dt_bias = (const float*)d_in[13]; p.gdn_norm = (const float*)d_in[14]; p.swa_w_q = (const float*)d_in[15];
    p.swa_sinks = (const float*)d_in[16]; p.ln_kv = (const float*)d_in[17]; p.w_kv = (const float*)d_in[18]; p.ln_final = (const float*)d_in[19];
    p.out = (float*)d_out; p.ws = (unsigned char*)d_ws;
    for (int i = 0; i < 8; ++i) p.inv[i] = (float)pow(500000.0, -(double)(2 * i) / 16.0);
    void* args[] = {&p};
    hipError_t e = hipLaunchCooperativeKernel((const void*)yoco_fwd, dim3(grid), dim3(NT), args, LDS_BYTES, stream);
    if (e != hipSuccess) fprintf(stderr, "kernel_launch: cooperative launch failed: %s (grid %d)\n", hipGetErrorString(e), grid);
}
```

```cpp
#include <hip/hip_runtime.h>
#include <hip/hip_cooperative_groups.h>
#include <cstdio>
#include <cstdint>
#include <cmath>
namespace cg = cooperative_groups;
__device__ __forceinline__ int tidx() { int t = threadIdx.x; asm volatile("" : "+v"(t)); return t; }
__device__ __forceinline__ int bidx() { int b = blockIdx.x; asm volatile("" : "+s"(b)); return b; }
namespace pg8 {
#define PG8_LAS __attribute__((address_space(3)))
typedef unsigned short bf16_t;
typedef short bf16x8 __attribute__((ext_vector_type(8)));
typedef float f32x4 __attribute__((ext_vector_type(4)));
typedef unsigned u32x4 __attribute__((ext_vector_type(4)));
constexpr int BM = 256, BK = 64, HALF = 128, HTB = HALF * BK * 2  , STAGE_BYTES = 8 * HTB, NXCD = 8, WGM = 8;

__host__ __device__ __forceinline__ int lds_byte(int r, int c) { const int st = (r >> 4) * 2 + (c >> 5), rr = r & 15, cc = c & 31, ob = rr * 64 + cc * 2; return st * 1024 + (ob ^ (((ob >> 9) & 1) << 5)); }
__host__ __device__ __forceinline__ void stage_rc(int b, int& R, int& C) { const int st = b / 1024, sb = b % 1024, swz = sb ^ (((sb >> 9) & 1) << 5); R = (st >> 1) * 16 + swz / 64; C = (st & 1) * 32 + (swz % 64) / 2; }
__host__ __device__ __forceinline__ int perm32(int rho) { const int n = rho >> 4, i = rho & 15; return 8 * (i >> 2) + 4 * n + (i & 3); }

struct Unit { int pm, pn; };
struct Gemm { const bf16_t* A; const bf16_t* Bt; int M, N, K; };

struct StaticOrder {
    int nM, nN, nwg, G, c;
    __host__ __device__ void init(int M, int N, int G_, int c_) { nM = M / BM; nN = N / BM; nwg = nM * nN; G = G_; c = c_; }
    __host__ __device__ bool next(int i, Unit& u) const {
        const long L = (long)i * G + c; if (L >= nwg) return false;
        int wgid = (int)L; { const int q = nwg / NXCD, r = nwg % NXCD, xcd = wgid % NXCD, off = wgid / NXCD; wgid = (xcd < r ? xcd * (q + 1) : r * (q + 1) + (xcd - r) * q) + off; }
        const int nig = WGM * nN, gid = wgid / nig, fm = gid * WGM, gsz = (nM - fm) < WGM ? (nM - fm) : WGM;
        u.pm = fm + ((wgid % nig) % gsz); u.pn = (wgid % nig) / gsz; return true;
    }
    __device__ __forceinline__ void a_ready(const Unit&) const {}
    __device__ __forceinline__ void done(const Unit&) const {}
};
template <class Epi, class Sched, bool ALIGN_EPI = false, bool SP2 = false>
__device__ __forceinline__ void gemm_phase(PG8_LAS unsigned char* lds, const Gemm g, const Sched& S, const Epi& E) {
    const int tid = tidx(), wid = __builtin_amdgcn_readfirstlane(tid >> 6), lane = tid & 63, wr = wid >> 2, wc = wid & 3, fr = lane & 15, fq = lane >> 4;
    const int K = g.K, nt = K / BK;
    unsigned voffA[2], voffB[2];
#pragma unroll
    for (int i = 0; i < 2; ++i) { int R, C; stage_rc(tid * 16 + i * 8192, R, C); const int Rb = Epi::PERM ? ((R & ~31) + perm32(R & 31)) : R;
        voffA[i] = (unsigned)(R * K + C) * 2u; voffB[i] = (unsigned)(Rb * K + C) * 2u; }
    const size_t kstep = (size_t)(BK * 2);
    const size_t hstep = (size_t)HALF * K * 2;
    const size_t tstep = 2 * hstep;
    const unsigned ldsw = (unsigned)wid * 1024u;
    const int aoff = lds_byte(wr * 64 + fr, fq * 8), boff = lds_byte(wc * 32 + fr, fq * 8);
#define PG8_SA(b, h) (((b) * 2 + (h)) * HTB)
#define PG8_SB(b, h) ((4 + (b) * 2 + (h)) * HTB)
#define PG8_STAGE(bufoff, gbase, voff) do { _Pragma("unroll") for (int _i = 0; _i < 2; ++_i) \
        __builtin_amdgcn_global_load_lds((const unsigned*)((const char*)(gbase) + (voff)[_i]), (PG8_LAS unsigned*)(lds + (bufoff) + ldsw + _i * 8192), 16, 0, 0); } while (0)
#define PG8_LDA(dst, b, h) do { _Pragma("unroll") for (int m = 0; m < 4; ++m) _Pragma("unroll") for (int k = 0; k < 2; ++k) dst[m][k] = *(const PG8_LAS bf16x8*)(lds + PG8_SA(b, h) + aoff + m * 2048 + k * 1024); } while (0)
#define PG8_LDB(dst, b, h) do { _Pragma("unroll") for (int n = 0; n < 2; ++n) _Pragma("unroll") for (int k = 0; k < 2; ++k) dst[n][k] = *(const PG8_LAS bf16x8*)(lds + PG8_SB(b, h) + boff + n * 2048 + k * 1024); } while (0)
#define PG8_MMA(ai, bj, At, Bt) do { __builtin_amdgcn_s_setprio(1); _Pragma("unroll") for (int m = 0; m < 4; ++m) _Pragma("unroll") for (int n = 0; n < 2; ++n) _Pragma("unroll") for (int k = 0; k < 2; ++k) \
        acc[ai][bj][m][n] = __builtin_amdgcn_mfma_f32_16x16x32_bf16(Bt[n][k], At[m][k], acc[ai][bj][m][n], 0, 0, 0); __builtin_amdgcn_s_setprio(0); } while (0)
#define PG8_WAIT_V(n) asm volatile("s_waitcnt vmcnt(" #n ")" ::: "memory")
#define PG8_WAIT_L(n) asm volatile("s_waitcnt lgkmcnt(" #n ")" ::: "memory")
#define PG8_BAR __builtin_amdgcn_s_barrier()
#define PG8_SCHED __builtin_amdgcn_sched_barrier(0)
    Unit cur, nxt; int ui = 0;
    if (!S.next(0, cur)) return;
    f32x4 acc[2][2][4][2];
#pragma unroll
    for (int a = 0; a < 2; ++a)
#pragma unroll
        for (int b = 0; b < 2; ++b)
#pragma unroll
            for (int m = 0; m < 4; ++m)
#pragma unroll
                for (int n = 0; n < 2; ++n) acc[a][b][m][n] = (f32x4){0.f, 0.f, 0.f, 0.f};
    bf16x8 At[4][2], B0[2][2], B1[2][2];
    const char* cA = (const char*)g.A + (size_t)cur.pm * tstep; const char* cB = (const char*)g.Bt + (size_t)cur.pn * tstep;
    S.a_ready(cur);
    if constexpr (SP2) {
        PG8_STAGE(PG8_SB(0, 0), cB, voffB); PG8_STAGE(PG8_SB(0, 1), cB + hstep, voffB); PG8_STAGE(PG8_SA(0, 0), cA, voffA); PG8_STAGE(PG8_SA(0, 1), cA + hstep, voffA);
        if (wr == 1) PG8_BAR;
        PG8_WAIT_V(2); PG8_BAR;
        PG8_STAGE(PG8_SB(1, 0), cB + kstep, voffB); PG8_STAGE(PG8_SA(1, 0), cA + kstep, voffA); PG8_STAGE(PG8_SB(1, 1), cB + hstep + kstep, voffB);
        PG8_WAIT_V(6); PG8_BAR;
    } else {
        PG8_STAGE(PG8_SB(0, 0), cB, voffB); PG8_STAGE(PG8_SA(0, 0), cA, voffA); PG8_STAGE(PG8_SB(0, 1), cB + hstep, voffB); PG8_STAGE(PG8_SA(0, 1), cA + hstep, voffA);
        if (wr == 1) PG8_BAR;
        PG8_WAIT_V(4); PG8_BAR;
        PG8_STAGE(PG8_SB(1, 0), cB + kstep, voffB); PG8_STAGE(PG8_SA(1, 0), cA + kstep, voffA); PG8_STAGE(PG8_SB(1, 1), cB + hstep + kstep, voffB);
        PG8_WAIT_V(6); PG8_BAR;
    }
    for (;;) {
        const bool has_next = S.next(ui + 1, nxt);
        const char* nA = has_next ? (const char*)g.A + (size_t)nxt.pm * tstep : cA; const char* nB = has_next ? (const char*)g.Bt + (size_t)nxt.pn * tstep : cB;
        for (int t = 0; t < nt; t += 2) {
            const bool last = (t == nt - 2);
            const char* a1 = cA + (size_t)(t + 1) * kstep;
            const char* a2 = last ? nA : cA + (size_t)(t + 2) * kstep; const char* b2 = last ? nB : cB + (size_t)(t + 2) * kstep;
            const char* a3 = a2 + kstep; const char* b3 = b2 + kstep;
            if (last && has_next) S.a_ready(nxt);
            if constexpr (SP2) {
            PG8_LDB(B0, 0, 0); PG8_LDB(B1, 0, 1); PG8_SCHED; PG8_LDA(At, 0, 0); PG8_STAGE(PG8_SA(1, 1), a1 + hstep, voffA);
            PG8_WAIT_V(8); PG8_WAIT_L(0); PG8_BAR; PG8_MMA(0, 0, At, B0); PG8_MMA(0, 1, At, B1); PG8_BAR; PG8_SCHED;
            PG8_LDA(At, 0, 1); PG8_STAGE(PG8_SB(0, 0), b2, voffB); PG8_STAGE(PG8_SB(0, 1), b2 + hstep, voffB); PG8_STAGE(PG8_SA(0, 0), a2, voffA);
            PG8_WAIT_V(8); PG8_WAIT_L(0); PG8_BAR; PG8_MMA(1, 0, At, B0); PG8_MMA(1, 1, At, B1); PG8_BAR; PG8_SCHED;
            PG8_LDB(B0, 1, 0); PG8_LDB(B1, 1, 1); PG8_SCHED; PG8_LDA(At, 1, 0); PG8_STAGE(PG8_SA(0, 1), a2 + hstep, voffA);
            PG8_WAIT_V(8); PG8_WAIT_L(0); PG8_BAR; PG8_MMA(0, 0, At, B0); PG8_MMA(0, 1, At, B1); PG8_BAR; PG8_SCHED;
            PG8_LDA(At, 1, 1); PG8_STAGE(PG8_SB(1, 0), b3, voffB); PG8_STAGE(PG8_SB(1, 1), b3 + hstep, voffB); PG8_STAGE(PG8_SA(1, 0), a3, voffA);
            PG8_WAIT_V(8); PG8_WAIT_L(0); PG8_BAR; PG8_MMA(1, 0, At, B0); PG8_MMA(1, 1, At, B1); PG8_BAR; PG8_SCHED;
            } else {
            PG8_LDB(B0, 0, 0); PG8_SCHED; PG8_LDA(At, 0, 0); PG8_STAGE(PG8_SA(1, 1), a1 + hstep, voffA);
            PG8_WAIT_L(8); PG8_BAR; PG8_WAIT_L(0); PG8_MMA(0, 0, At, B0); PG8_BAR; PG8_SCHED;
            PG8_LDB(B1, 0, 1); PG8_STAGE(PG8_SB(0, 0), b2, voffB);
            PG8_BAR; PG8_WAIT_L(0); PG8_MMA(0, 1, At, B1); PG8_BAR;
            PG8_LDA(At, 0, 1); PG8_STAGE(PG8_SA(0, 0), a2, voffA);
            PG8_BAR; PG8_WAIT_L(0); PG8_MMA(1, 0, At, B0); PG8_BAR; PG8_SCHED;
            PG8_STAGE(PG8_SB(0, 1), b2 + hstep, voffB);
            PG8_WAIT_V(6); PG8_BAR; PG8_MMA(1, 1, At, B1); PG8_BAR;
            PG8_LDB(B0, 1, 0); PG8_SCHED; PG8_LDA(At, 1, 0); PG8_STAGE(PG8_SA(0, 1), a2 + hstep, voffA);
            PG8_WAIT_L(8); PG8_BAR; PG8_WAIT_L(0); PG8_MMA(0, 0, At, B0); PG8_BAR; PG8_SCHED;
            PG8_LDB(B1, 1, 1); PG8_STAGE(PG8_SB(1, 0), b3, voffB);
            PG8_BAR; PG8_WAIT_L(0); PG8_MMA(0, 1, At, B1); PG8_BAR;
            PG8_LDA(At, 1, 1); PG8_STAGE(PG8_SA(1, 0), a3, voffA);
            PG8_BAR; PG8_WAIT_L(0); PG8_MMA(1, 0, At, B0); PG8_BAR; PG8_SCHED;
            PG8_STAGE(PG8_SB(1, 1), b3 + hstep, voffB);
            PG8_WAIT_V(6); PG8_BAR; PG8_MMA(1, 1, At, B1); PG8_BAR;
            }
        }
        if constexpr (ALIGN_EPI) { if (wr == 0) PG8_BAR; }
        if constexpr (!Epi::AFTER_DRAIN) { E(acc, cur, wr, wc, fr, fq); S.done(cur); }
        if (!has_next) break;
#pragma unroll
        for (int a = 0; a < 2; ++a)
#pragma unroll
            for (int b = 0; b < 2; ++b)
#pragma unroll
                for (int m = 0; m < 4; ++m)
#pragma unroll
                    for (int n = 0; n < 2; ++n) acc[a][b][m][n] = (f32x4){0.f, 0.f, 0.f, 0.f};
        cur = nxt; cA = nA; cB = nB; ++ui;
        if constexpr (ALIGN_EPI) { if (wr == 1) PG8_BAR; }
    }
    PG8_WAIT_V(0);
    if constexpr (!ALIGN_EPI) { if (wr == 0) PG8_BAR; }
    PG8_BAR;
    if constexpr (Epi::AFTER_DRAIN) { E.fused(acc, cur, wr, wc, fr, fq, lds, wid, lane); S.done(cur); }
#undef PG8_SA
#undef PG8_SB
#undef PG8_STAGE
#undef PG8_LDA
#undef PG8_LDB
#undef PG8_MMA
#undef PG8_WAIT_V
#undef PG8_WAIT_L
#undef PG8_BAR
#undef PG8_SCHED
}
}

#define DI __device__ __forceinline__
#define LAS __attribute__((address_space(3)))
typedef unsigned short bf16_t;
typedef short bf16x8 __attribute__((ext_vector_type(8)));
typedef float f32x4 __attribute__((ext_vector_type(4)));
typedef unsigned u32x4 __attribute__((ext_vector_type(4)));
typedef unsigned u32x2 __attribute__((ext_vector_type(2)));

constexpr int NT = 512;
constexpr int MT = 32768, SEQ = 16384, DMODEL = 1024, DFF = 2816;
constexpr int NITEM = 3072;
constexpr size_t MiB = 1u << 20;
constexpr size_t WS_CS = 1 * MiB;
constexpr size_t WS_AB = 3 * MiB;
constexpr size_t WS_MEMN = 5 * MiB;
constexpr size_t WS_MKV = 6 * MiB;
constexpr size_t WS_WMKV = 8 * MiB;
constexpr size_t WS_WKV = 12 * MiB;
constexpr size_t WS_GL = 13 * MiB;
constexpr size_t WS_KV = 14 * MiB;
constexpr size_t WS_WA0 = 30 * MiB;
constexpr size_t WSLOT = 26 * MiB;
constexpr size_t WO_IN = 0, WO_OUT = 7 * MiB, WO_GU = 9 * MiB, WO_DN = 20 * MiB;
constexpr size_t WS_P1 = 82 * MiB;
constexpr size_t WS_OT = 82 * MiB;
constexpr size_t WS_MIX = 130 * MiB;
constexpr size_t WS_ACT = 82 * MiB;
constexpr size_t WS_HKV = 82 * MiB;
constexpr size_t WS_P2 = 226 * MiB;
constexpr size_t WS_H = 290 * MiB;
constexpr size_t WS_QG = 290 * MiB;
constexpr size_t WS_KGT = 338 * MiB;
constexpr size_t WS_UT = 386 * MiB;
constexpr size_t WS_WP = 434 * MiB;
constexpr size_t WS_AI = 482 * MiB;
constexpr size_t WS_WB0 = 386 * MiB;
constexpr size_t WS_SSQ = 506 * MiB;
constexpr size_t WS_END = 508 * MiB;
constexpr int LDS_BYTES = 135168;

struct Params {
    const float* x; const float* mem; const int* pos; const float* ln_mix; const float* ln_ffn; const float* ln_mem;
    const float* w_mem_kv; const float* w_out; const float* w_gate_up; const float* w_down; const float* gdn_w_in;
    const float* gdn_conv; const float* gdn_A_log; const float* gdn_dt_bias; const float* gdn_norm; const float* swa_w_q;
    const float* swa_sinks; const float* ln_kv; const float* w_kv; const float* ln_final;
    float* out; unsigned char* ws;
    float inv[8];
};

typedef const Params& PRef;
DI unsigned f2bf(float f) { unsigned u = __float_as_uint(f); return (u + 0x7fffu + ((u >> 16) & 1u)) >> 16; }
typedef float f32x2_t __attribute__((ext_vector_type(2)));
typedef __bf16 bf16x2_t __attribute__((ext_vector_type(2)));
DI unsigned pk2(float lo, float hi) { f32x2_t v = {lo, hi}; bf16x2_t b = __builtin_convertvector(v, bf16x2_t); return __builtin_bit_cast(unsigned, b); }
DI float bflo(unsigned w) { return __uint_as_float(w << 16); }
DI float bfhi(unsigned w) { return __uint_as_float(w & 0xffff0000u); }
DI float bf2f(bf16_t b) { return __uint_as_float((unsigned)b << 16); }
DI bf16x8 pack8(f32x4 a, f32x4 b) { u32x4 p; p.x = pk2(a[0], a[1]); p.y = pk2(a[2], a[3]); p.z = pk2(b[0], b[1]); p.w = pk2(b[2], b[3]); return __builtin_bit_cast(bf16x8, p); }
DI float shx(float v, int mask) { const int ln = tidx() & 63; return __builtin_bit_cast(float, __builtin_amdgcn_ds_bpermute((ln ^ mask) << 2, __builtin_bit_cast(int, v))); }
DI float shup(float v, int d) { const int ln = tidx() & 63; return __builtin_bit_cast(float, __builtin_amdgcn_ds_bpermute((ln - d) << 2, __builtin_bit_cast(int, v))); }
DI LAS unsigned char* lnd(LAS unsigned char* q) { asm volatile("" : "+v"(q)); return q; }
#define uni(x) (x)
DI void lds_barrier() { asm volatile("s_waitcnt lgkmcnt(0)" ::: "memory"); __builtin_amdgcn_s_barrier(); asm volatile("" ::: "memory"); }
DI float wave_sum(float v) {
#pragma unroll
    for (int o = 32; o; o >>= 1) v += shx(v, o);
    return v; }
DI float siluf(float v) { return v * __builtin_amdgcn_rcpf(1.f + __expf(-v)); }
DI int tslot(int t) { return (t & ~31) + 8 * ((t & 15) >> 2) + 4 * ((t >> 4) & 1) + (t & 3); }
#define MFMA16(a, b, c) __builtin_amdgcn_mfma_f32_16x16x32_bf16((a), (b), (c), 0, 0, 0)

struct Epi {
    static constexpr bool PERM = true, AFTER_DRAIN = false;
    int mode; int ldc; bf16_t* o0; bf16_t* o1; float* f0; const float* base; const float* cs; float* ssq;
    DI void st8(bf16_t* p, f32x4 v0, f32x4 v1) const { u32x4 w; w.x = pk2(v0[0], v0[1]); w.y = pk2(v0[2], v0[3]); w.z = pk2(v1[0], v1[1]); w.w = pk2(v1[2], v1[3]); *(u32x4*)p = w; }
    DI void rope(f32x4& v0, f32x4& v1, int row, int col) const {
        if ((col & 63) < 16) { const f32x4 c = *(const f32x4*)(cs + (size_t)row * 16 + ((col & 63) >> 1)), s = *(const f32x4*)(cs + (size_t)row * 16 + 8 + ((col & 63) >> 1));
            const f32x4 a = v0 * c - v1 * s, b = v1 * c + v0 * s; v0 = a; v1 = b; }
    }
    DI void operator()(const f32x4 (&acc)[2][2][4][2], const pg8::Unit& u, int wr, int wc, int fr, int fq) const {
        const int row0 = u.pm * 256 + wr * 64 + fr;
        float rsv[2][4];
#pragma unroll
        for (int ai = 0; ai < 2; ++ai)
#pragma unroll
            for (int m = 0; m < 4; ++m) rsv[ai][m] = 1.f;
        if (mode != 0 && mode != 4) {
#pragma unroll
            for (int ai = 0; ai < 2; ++ai)
#pragma unroll
                for (int mp = 0; mp < 2; ++mp) {
                    f32x4 t[2][4];
#pragma unroll
                    for (int m = 0; m < 2; ++m) { const f32x4* sp = (const f32x4*)(ssq + (size_t)(row0 + ai * 128 + (2 * mp + m) * 16) * 16); t[m][0] = sp[0]; t[m][1] = sp[1]; t[m][2] = sp[2]; t[m][3] = sp[3]; }
#pragma unroll
                    for (int m = 0; m < 2; ++m) { const f32x4 c = (t[m][0] + t[m][1]) + (t[m][2] + t[m][3]); rsv[ai][2 * mp + m] = rsqrtf(((c[0] + c[1]) + (c[2] + c[3])) * (1.f / 1024.f) + 1e-6f); }
                }
        }
#pragma unroll
        for (int aim = 0; aim < 4; ++aim) { const int ai = aim >> 1, mp = aim & 1;
            f32x4 bs[2][2][2];
            if (mode == 4) {
#pragma unroll
                for (int m = 0; m < 2; ++m)
#pragma unroll
                    for (int bj = 0; bj < 2; ++bj) { const float* bp = base + (size_t)(row0 + ai * 128 + (2 * mp + m) * 16) * 1024 + u.pn * 256 + bj * 128 + wc * 32 + 8 * fq; bs[m][bj][0] = *(const f32x4*)bp; bs[m][bj][1] = *(const f32x4*)(bp + 4); }
            }
#pragma unroll
            for (int m = 2 * mp; m < 2 * mp + 2; ++m) {
                const int row = row0 + ai * 128 + m * 16;
                const float rs = rsv[ai][m]; float ssacc = 0.f;
                if (mode == 5) {
                    const f32x4 g0 = acc[ai][0][m][0] * rs, g1 = acc[ai][0][m][1] * rs, u0 = acc[ai][1][m][0] * rs, u1 = acc[ai][1][m][1] * rs;
                    st8(o0 + (size_t)row * DFF + u.pn * 128 + wc * 32 + 8 * fq, (f32x4){siluf(g0[0]) * u0[0], siluf(g0[1]) * u0[1], siluf(g0[2]) * u0[2], siluf(g0[3]) * u0[3]},
                        (f32x4){siluf(g1[0]) * u1[0], siluf(g1[1]) * u1[1], siluf(g1[2]) * u1[2], siluf(g1[3]) * u1[3]});
                } else
#pragma unroll
                for (int bj = 0; bj < 2; ++bj) {
                    const int col = u.pn * 256 + bj * 128 + wc * 32 + 8 * fq;
                    f32x4 v0 = acc[ai][bj][m][0] * rs, v1 = acc[ai][bj][m][1] * rs;
                    if (mode == 0) { st8(o0 + (size_t)row * ldc + col, v0, v1); }
                    else if (mode == 1) {
                        if (col < 2304) st8(o0 + (size_t)row * 2304 + col, v0, v1);
                        else if (col < 3328) { if (col >= 3072) { v0 = v0 * 0.125f; v1 = v1 * 0.125f; } st8(o1 + (size_t)row * 1024 + (col - 2304), v0, v1); }
                        else if (col == 3328) { *(f32x4*)(f0 + (size_t)row * 16) = v0; *(f32x4*)(f0 + (size_t)row * 16 + 4) = v1; }
                        else if (col == 3336) { *(f32x4*)(f0 + (size_t)row * 16 + 8) = v0; }
                    }
                    else if (mode == 2) { v0 = v0 * 0.125f; v1 = v1 * 0.125f; if (col < 768) rope(v0, v1, row, col); st8(o0 + (size_t)row * 1024 + col, v0, v1); }
                    else if (mode == 3) { if (col < 128) rope(v0, v1, row, col); st8(o0 + (size_t)row * 256 + col, v0, v1); }
                    else if (mode == 4) { float* op = f0 + (size_t)row * 1024 + col;
                        const f32x4 x0 = bs[m & 1][bj][0] + v0, x1 = bs[m & 1][bj][1] + v1; *(f32x4*)op = x0; *(f32x4*)(op + 4) = x1;
                        st8(o0 + (size_t)row * 1024 + col, x0, x1);
                        ssacc += (x0[0] * x0[0] + x0[1] * x0[1]) + (x0[2] * x0[2] + x0[3] * x0[3]) + (x1[0] * x1[0] + x1[1] * x1[1]) + (x1[2] * x1[2] + x1[3] * x1[3]); }

                }
                if (mode == 4) { ssacc += shx(ssacc, 16); ssacc += shx(ssacc, 32); if (fq == 0) ssq[(size_t)row * 16 + u.pn * 4 + wc] = ssacc; }
            }
        }
    }
};

DI void run_gemm(LAS unsigned char* lds, const bf16_t* A, const bf16_t* Bt, int M, int N, int K, const Epi& E) {
    pg8::Gemm g{A, Bt, M, N, K}; pg8::StaticOrder S; const int G = gridDim.x, bx = bidx();
    S.init(M, N, G, bx);
    pg8::gemm_phase<Epi, pg8::StaticOrder, true, true>(lds, g, S, E);
    __syncthreads();
}

DI int wmap(int mode, int n, int N) {
    if (mode == 0) return n < N ? n : -1;
    if (mode == 1) return n < 3072 ? n : (n < 3328 ? 3084 + (n - 3072) : (n < 3340 ? 3072 + (n - 3328) : -1));
    if (mode == 2) { const int u = n >> 8, w = n & 255; return w < 128 ? u * 128 + w : DFF + u * 128 + (w - 128); }
    const int lim = (N == 1024) ? 768 : 128;
    if (n < lim) { const int p = n & 63; if (p < 16) { const int q = p >> 3, jj = p & 7; return (n & ~63) + (jj < 4 ? 4 * q + jj : 8 + 4 * q + (jj - 4)); } }
    return n;
}
DI void wconv(LAS unsigned char* lds, const float* __restrict__ W, int K, int N, bf16_t* Wt, int Nout, int mode, const float* gk = nullptr, int first = -1, int stride = 0) {
    LAS float* tile = (LAS float*)lds; const int tid = tidx(), ntk = K / 64, ntn = Nout / 64;
    if (first < 0) { first = bidx(); stride = gridDim.x; }
    for (int t = first; t < ntk * ntn; t += stride) {
        const int tk = t % ntk, tn = t / ntk, k0 = tk * 64, n0 = tn * 64;
        const int j = tid & 63, kk = tid >> 6; const int c = wmap(mode, n0 + j, N);
#pragma unroll
        for (int i = 0; i < 8; ++i) { const int k = i * 8 + kk; tile[k * 65 + j] = c >= 0 ? W[(size_t)(k0 + k) * N + c] * (gk ? gk[k0 + k] : 1.f) : 0.f; }
        lds_barrier();
        const int nn = tid >> 3, k8 = (tid & 7) * 8; u32x4 o;
        o.x = pk2(tile[(k8 + 0) * 65 + nn], tile[(k8 + 1) * 65 + nn]); o.y = pk2(tile[(k8 + 2) * 65 + nn], tile[(k8 + 3) * 65 + nn]);
        o.z = pk2(tile[(k8 + 4) * 65 + nn], tile[(k8 + 5) * 65 + nn]); o.w = pk2(tile[(k8 + 6) * 65 + nn], tile[(k8 + 7) * 65 + nn]);
        *(u32x4*)(Wt + (size_t)(n0 + nn) * K + k0 + k8) = o;
        lds_barrier();
    }
}
DI void conv_layer_weights(LAS unsigned char* lds, PRef p, int layer, unsigned char* slot, int first = -1, int stride = 0, int mask = 15) {
    if (mask & 1) {
        if (layer < 2) wconv(lds, uni(p.gdn_w_in) + (size_t)layer * 1024 * 3340, 1024, 3340, (bf16_t*)(slot + WO_IN), 3584, 1, uni(p.ln_mix) + layer * 1024, first, stride);
        else wconv(lds, uni(p.swa_w_q) + (size_t)(layer - 2) * 1024 * 1024, 1024, 1024, (bf16_t*)(slot + WO_IN), 1024, 3, uni(p.ln_mix) + layer * 1024, first, stride);
    }
    if (mask & 2) wconv(lds, uni(p.w_out) + (size_t)layer * 1024 * 1024, 1024, 1024, (bf16_t*)(slot + WO_OUT), 1024, 0, nullptr, first, stride);
    if (mask & 4) wconv(lds, uni(p.w_gate_up) + (size_t)layer * 1024 * 5632, 1024, 5632, (bf16_t*)(slot + WO_GU), 5632, 2, uni(p.ln_ffn) + layer * 1024, first, stride);
    if (mask & 8) wconv(lds, uni(p.w_down) + (size_t)layer * DFF * 1024, DFF, 1024, (bf16_t*)(slot + WO_DN), 1024, 0, nullptr, first, stride);
}
DI void norm_rows(const float* x, const float* __restrict__ g, bf16_t* out, int rows) {
    const int lane = tidx() & 63, gw = bidx() * 8 + (tidx() >> 6), nw = gridDim.x * 8;
    for (int r = gw; r < rows; r += nw) {
        const f32x4* xr = (const f32x4*)(x + (size_t)r * 1024); f32x4 v[4]; float ss = 0.f;
#pragma unroll
        for (int i = 0; i < 4; ++i) { v[i] = xr[lane + 64 * i]; ss += v[i][0] * v[i][0] + v[i][1] * v[i][1] + v[i][2] * v[i][2] + v[i][3] * v[i][3]; }
        ss = wave_sum(ss); const float rs = rsqrtf(ss * (1.f / 1024.f) + 1e-6f);
#pragma unroll
        for (int i = 0; i < 4; ++i) { const f32x4 gg = ((const f32x4*)g)[lane + 64 * i]; u32x2 o; o.x = pk2(v[i][0] * rs * gg[0], v[i][1] * rs * gg[1]); o.y = pk2(v[i][2] * rs * gg[2], v[i][3] * rs * gg[3]);
            *(u32x2*)(out + (size_t)r * 1024 + (lane + 64 * i) * 4) = o; }
    }
}
DI void xb_rows(const float* x, bf16_t* out, float* ssq, int rows) {
    const int lane = tidx() & 63, gw = bidx() * 8 + (tidx() >> 6), nw = gridDim.x * 8;
    for (int r = gw; r < rows; r += nw) {
        const f32x4* xr = (const f32x4*)(x + (size_t)r * 1024); f32x4 v[4]; float ss = 0.f;
#pragma unroll
        for (int i = 0; i < 4; ++i) { v[i] = xr[lane + 64 * i]; ss += v[i][0] * v[i][0] + v[i][1] * v[i][1] + v[i][2] * v[i][2] + v[i][3] * v[i][3]; }
        ss = wave_sum(ss);
#pragma unroll
        for (int i = 0; i < 4; ++i) { u32x2 o; o.x = pk2(v[i][0], v[i][1]); o.y = pk2(v[i][2], v[i][3]); *(u32x2*)(out + (size_t)r * 1024 + (lane + 64 * i) * 4) = o; }
        if (lane < 16) ssq[(size_t)r * 16 + lane] = lane == 0 ? ss : 0.f;
    }
}
DI void final_norm(float* x, const float* __restrict__ g, int rows) {
    const int lane = tidx() & 63, gw = bidx() * 8 + (tidx() >> 6), nw = gridDim.x * 8;
    for (int r = gw; r < rows; r += nw) {
        f32x4* xr = (f32x4*)(x + (size_t)r * 1024); f32x4 v[4]; float ss = 0.f;
#pragma unroll
        for (int i = 0; i < 4; ++i) { v[i] = xr[lane + 64 * i]; ss += v[i][0] * v[i][0] + v[i][1] * v[i][1] + v[i][2] * v[i][2] + v[i][3] * v[i][3]; }
        ss = wave_sum(ss); const float rs = rsqrtf(ss * (1.f / 1024.f) + 1e-6f);
#pragma unroll
        for (int i = 0; i < 4; ++i) { const f32x4 gg = ((const f32x4*)g)[lane + 64 * i]; xr[lane + 64 * i] = v[i] * rs * gg; }
    }
}
DI void rope_table(PRef p) {
    float* cs = (float*)(uni(p.ws) + WS_CS);
    for (int idx = bidx() * NT + tidx(); idx < MT * 8; idx += gridDim.x * NT) {
        const int r = idx >> 3, i = idx & 7; const float ang = (float)uni(p.pos)[r] * p.inv[i];
        const double a = (double)ang, k = rint(a * 0.15915494309189535), rr = a - k * 6.283185307179586476925; const double r2 = rr * rr;
        double sn = 1.0 / 51090942171709440000.0, cn = 1.0 / 2432902008176640000.0;
        sn = sn * r2 - 1.0 / 121645100408832000.0; cn = cn * r2 - 1.0 / 6402373705728000.0;
        sn = sn * r2 + 1.0 / 355687428096000.0;    cn = cn * r2 + 1.0 / 20922789888000.0;
        sn = sn * r2 - 1.0 / 1307674368000.0;      cn = cn * r2 - 1.0 / 87178291200.0;
        sn = sn * r2 + 1.0 / 6227020800.0;         cn = cn * r2 + 1.0 / 479001600.0;
        sn = sn * r2 - 1.0 / 39916800.0;           cn = cn * r2 - 1.0 / 3628800.0;
        sn = sn * r2 + 1.0 / 362880.0;             cn = cn * r2 + 1.0 / 40320.0;
        sn = sn * r2 - 1.0 / 5040.0;               cn = cn * r2 - 1.0 / 720.0;
        sn = sn * r2 + 1.0 / 120.0;                cn = cn * r2 + 1.0 / 24.0;
        sn = sn * r2 - 1.0 / 6.0;                  cn = cn * r2 - 0.5;
        sn = sn * r2 + 1.0;                        cn = cn * r2 + 1.0;
        sn = sn * rr;
        cs[(size_t)r * 16 + i] = (float)cn; cs[(size_t)r * 16 + 8 + i] = (float)sn;
    }
}

DI void gdn_chunk_phase(LAS unsigned char* lds, PRef p, int a) {
    const bf16_t* P1 = (const bf16_t*)(uni(p.ws) + WS_P1); const float* ab = (const float*)(uni(p.ws) + WS_AB);
    const float* convw = uni(p.gdn_conv) + (size_t)a * 4 * 2304; const float* A_log = uni(p.gdn_A_log) + a * 6; const float* dtb = uni(p.gdn_dt_bias) + a * 6;
    bf16_t* QG = (bf16_t*)(uni(p.ws) + WS_QG); bf16_t* WP = (bf16_t*)(uni(p.ws) + WS_WP); bf16_t* KGT = (bf16_t*)(uni(p.ws) + WS_KGT); bf16_t* UT = (bf16_t*)(uni(p.ws) + WS_UT);
    bf16_t* AI = (bf16_t*)(uni(p.ws) + WS_AI); float* GL = (float*)(uni(p.ws) + WS_GL);
    LAS float* RHS = (LAS float*)lds;
    LAS unsigned char* RAW = lds;
    LAS bf16_t* Qb = (LAS bf16_t*)(lds + 65536);
    LAS bf16_t* Kb = (LAS bf16_t*)(lds + 65536 + 17408);
    LAS float* Lm = (LAS float*)(lds + 65536 + 34816);
    LAS float* CW = (LAS float*)(lds + 116736);
    LAS float* gcs = (LAS float*)(lds + 122880);
    u32x4 pr[7]; float pcw[3], pbl = 0.f, pal = 0.f, pAl = 0.f, pdt = 0.f;
#define CH_LOAD(itn) do { const int tid_ = tidx(), h_ = (itn) % 6, cn_ = (itn) / 6, n_ = cn_ & 255, t0_ = cn_ * 64; \
        _Pragma("unroll") for (int i = 0; i < 7; ++i) { const int idx = tid_ + NT * i, rr = idx / 48, pc = idx % 48, sec = pc >> 4, off = (pc & 15) * 8; \
            pr[i] = (u32x4){0u, 0u, 0u, 0u}; if (idx < 67 * 48 && (rr >= 3 || n_ > 0)) pr[i] = *(const u32x4*)(P1 + (size_t)(t0_ - 3 + rr) * 2304 + sec * 768 + h_ * 128 + off); } \
        _Pragma("unroll") for (int i = 0; i < 3; ++i) { const int idx = tid_ + NT * i, j = idx / 384, c = idx % 384, sec = c >> 7; pcw[i] = convw[j * 2304 + sec * 768 + h_ * 128 + (c & 127)]; } \
        if (tid_ < 64) { pbl = ab[(size_t)(t0_ + tid_) * 16 + h_]; pal = ab[(size_t)(t0_ + tid_) * 16 + 6 + h_]; pAl = A_log[h_]; pdt = dtb[h_]; } } while (0)
    if (bidx() < NITEM) CH_LOAD(bidx());
#pragma unroll 1
    for (int it = bidx(); it < NITEM; it += gridDim.x) {
        const int tid = tidx(), lane = tid & 63, wave = tid >> 6;
        const int h = it % 6, cn = it / 6, t0 = cn * 64;
#pragma unroll
        for (int i = 0; i < 7; ++i) { const int idx = tid + NT * i, rr = idx / 48, pc = idx % 48, sec = pc >> 4, off = (pc & 15) * 8; if (idx < 67 * 48) *(LAS u32x4*)(RAW + rr * 784 + sec * 256 + off * 2) = pr[i]; }
#pragma unroll
        for (int i = 0; i < 3; ++i) CW[tid + NT * i] = pcw[i];
        if (tid < 64) {
            const float bl = pbl, al = pal;
            const float beta = 1.f / (1.f + expf(-bl)); const float xx = al + pdt; const float sp = xx > 20.f ? xx : log1pf(expf(xx));
            float g = -expf(pAl) * sp;
#pragma unroll
            for (int o = 1; o < 64; o <<= 1) { const float y = shup(g, o); if (lane >= o) g += y; }
            const float glast = __builtin_bit_cast(float, __builtin_amdgcn_readlane(__builtin_bit_cast(int, g), 63));
            gcs[tid] = g; gcs[64 + tid] = beta; gcs[128 + tid] = expf(g); gcs[192 + tid] = expf(glast - g);
            if (tid == 63) GL[it] = expf(g);
        }
        lds_barrier();
        const int t = tid >> 3, part = tid & 7;
        float cq[16], ck[16], cv[16];
#pragma unroll
        for (int sec = 0; sec < 3; ++sec)
#pragma unroll
            for (int hf = 0; hf < 2; ++hf) {
                float acc[8];
#pragma unroll
                for (int e = 0; e < 8; ++e) acc[e] = 0.f;
#pragma unroll
                for (int j = 0; j < 4; ++j) {
                    const u32x4 rw = *(const LAS u32x4*)(RAW + (t + j) * 784 + sec * 256 + (part * 16 + hf * 8) * 2);
                    const f32x4 w0 = *(const LAS f32x4*)(CW + j * 384 + sec * 128 + part * 16 + hf * 8), w1 = *(const LAS f32x4*)(CW + j * 384 + sec * 128 + part * 16 + hf * 8 + 4);
                    acc[0] += w0[0] * bflo(rw.x); acc[1] += w0[1] * bfhi(rw.x); acc[2] += w0[2] * bflo(rw.y); acc[3] += w0[3] * bfhi(rw.y);
                    acc[4] += w1[0] * bflo(rw.z); acc[5] += w1[1] * bfhi(rw.z); acc[6] += w1[2] * bflo(rw.w); acc[7] += w1[3] * bfhi(rw.w);
                }
#pragma unroll
                for (int e = 0; e < 8; ++e) { const float s = siluf(acc[e]); if (sec == 0) cq[hf * 8 + e] = s; else if (sec == 1) ck[hf * 8 + e] = s; else cv[hf * 8 + e] = s; }
            }
        float ssq = 0.f, ssk = 0.f;
#pragma unroll
        for (int e = 0; e < 16; ++e) { ssq += cq[e] * cq[e]; ssk += ck[e] * ck[e]; }
        ssq += shx(ssq, 1); ssq += shx(ssq, 2); ssq += shx(ssq, 4);
        ssk += shx(ssk, 1); ssk += shx(ssk, 2); ssk += shx(ssk, 4);
        const float rq = rsqrtf(ssq + 1e-6f) * 0.08838834764831845f, rk = rsqrtf(ssk + 1e-6f);
        const float gct = gcs[t], bt = gcs[64 + t], egt = gcs[128 + t], gclast = gcs[63];
        lds_barrier();
        {
#pragma unroll
            for (int e = 0; e < 16; ++e) { cq[e] *= rq; ck[e] *= rk; }
            u32x4 w;
            w.x = pk2(cq[0], cq[1]); w.y = pk2(cq[2], cq[3]); w.z = pk2(cq[4], cq[5]); w.w = pk2(cq[6], cq[7]); *(LAS u32x4*)(Qb + t * 136 + part * 16) = w;
            w.x = pk2(cq[8], cq[9]); w.y = pk2(cq[10], cq[11]); w.z = pk2(cq[12], cq[13]); w.w = pk2(cq[14], cq[15]); *(LAS u32x4*)(Qb + t * 136 + part * 16 + 8) = w;
            w.x = pk2(ck[0], ck[1]); w.y = pk2(ck[2], ck[3]); w.z = pk2(ck[4], ck[5]); w.w = pk2(ck[6], ck[7]); *(LAS u32x4*)(Kb + t * 136 + part * 16) = w;
            w.x = pk2(ck[8], ck[9]); w.y = pk2(ck[10], ck[11]); w.z = pk2(ck[12], ck[13]); w.w = pk2(ck[14], ck[15]); *(LAS u32x4*)(Kb + t * 136 + part * 16 + 8) = w;
            const float kbe = bt * egt;
#pragma unroll
            for (int e4 = 0; e4 < 4; ++e4) {
                *(LAS f32x4*)(RHS + t * 256 + part * 16 + e4 * 4) = (f32x4){cv[e4 * 4] * bt, cv[e4 * 4 + 1] * bt, cv[e4 * 4 + 2] * bt, cv[e4 * 4 + 3] * bt};
                *(LAS f32x4*)(RHS + t * 256 + 128 + part * 16 + e4 * 4) = (f32x4){ck[e4 * 4] * kbe, ck[e4 * 4 + 1] * kbe, ck[e4 * 4 + 2] * kbe, ck[e4 * 4 + 3] * kbe};
            }
            bf16_t* qgp = QG + (size_t)(t0 + t) * 768 + h * 128 + 32 * (part >> 1) + 4 * (part & 1);
#pragma unroll
            for (int q4 = 0; q4 < 4; ++q4) { u32x2 o; o.x = pk2(cq[q4 * 4] * egt, cq[q4 * 4 + 1] * egt); o.y = pk2(cq[q4 * 4 + 2] * egt, cq[q4 * 4 + 3] * egt); *(u32x2*)(qgp + 8 * q4) = o; }
        }
        lds_barrier();
        {
#pragma unroll
            for (int i = 0; i < 2; ++i) {
                const int pid = tid + NT * i, d = pid >> 3, s8 = pid & 7, tb = 32 * (s8 >> 2) + 4 * (s8 & 3); float v[8];
#pragma unroll
                for (int e = 0; e < 8; ++e) { const int tk = tb + 16 * (e >> 2) + (e & 3); v[e] = bf2f(Kb[tk * 136 + d]) * gcs[192 + tk]; }
                u32x4 w; w.x = pk2(v[0], v[1]); w.y = pk2(v[2], v[3]); w.z = pk2(v[4], v[5]); w.w = pk2(v[6], v[7]);
                *(u32x4*)(KGT + (size_t)it * 8192 + d * 64 + 8 * s8) = w;
            }
            const int mat = wave >> 2, mi = wave & 3, r16 = lane & 15, q = lane >> 4;
            const LAS bf16_t* Ab = Kb + (16 * mi + r16) * 136 + 8 * q;
            bf16x8 af[4];
#pragma unroll
            for (int ks = 0; ks < 4; ++ks) af[ks] = *(const LAS bf16x8*)(Ab + 32 * ks);
            if (mat == 0) {
#pragma unroll
                for (int ni = 0; ni < 4; ++ni) if (ni <= mi) {
                    const LAS bf16_t* Bb = Kb + (16 * ni + r16) * 136 + 8 * q; f32x4 acc = {0.f, 0.f, 0.f, 0.f};
#pragma unroll
                    for (int ks = 0; ks < 4; ++ks) acc = MFMA16(af[ks], *(const LAS bf16x8*)(Bb + 32 * ks), acc);
                    const int kc = 16 * ni + r16; const float gk = gcs[kc];
                    f32x4 lv4;
#pragma unroll
                    for (int j = 0; j < 4; ++j) { const int c = 16 * mi + 4 * q + j; lv4[j] = (c > kc) ? gcs[64 + c] * acc[j] * __expf(fminf(gcs[c] - gk, 0.f)) : 0.f; }
                    *(LAS f32x4*)(Lm + kc * 64 + 16 * mi + 4 * q) = lv4;
                }
            } else {
#pragma unroll
                for (int ni = 0; ni < 4; ++ni) {
                    f32x4 acc = {0.f, 0.f, 0.f, 0.f}; const int c = 16 * ni + r16;
                    if (ni >= mi) {
                        const LAS bf16_t* Bb = Qb + (16 * ni + r16) * 136 + 8 * q;
#pragma unroll
                        for (int ks = 0; ks < 4; ++ks) acc = MFMA16(af[ks], *(const LAS bf16x8*)(Bb + 32 * ks), acc);
                        const float gcc = gcs[c];
#pragma unroll
                        for (int j = 0; j < 4; ++j) { const int kc = 16 * mi + 4 * q + j; acc[j] = (c >= kc) ? acc[j] * __expf(fminf(gcc - gcs[kc], 0.f)) : 0.f; }
                    }
                    u32x2 w; w.x = pk2(acc[0], acc[1]); w.y = pk2(acc[2], acc[3]);
                    *(u32x2*)(AI + (size_t)it * 4096 + c * 64 + 32 * (mi >> 1) + 8 * q + 4 * (mi & 1)) = w;
                }
            }
        }
        lds_barrier();
        { const int itn = (it + (int)gridDim.x < NITEM) ? it + (int)gridDim.x : it; CH_LOAD(itn); }
        if (tid < 256) {
            const LAS float* Lz = Lm + __builtin_amdgcn_mbcnt_lo(0u, 0u);
            float r[64];
#pragma unroll
            for (int i = 0; i < 64; ++i) r[i] = RHS[i * 256 + tid];
            f32x4 ha[8], hb[8];
#define LOADH(buf, j, hf) do { _Pragma("unroll") for (int g = ((((j) + 1) >> 2) > (hf) * 8 ? (((j) + 1) >> 2) : (hf) * 8); g < (hf) * 8 + 8; ++g) buf[g - (hf) * 8] = *(const LAS f32x4*)(Lz + (j) * 64 + 4 * g); } while (0)
#define APPLYH(buf, j, hf) do { const float xj = r[j]; _Pragma("unroll") for (int i = ((j) + 1 > (hf) * 32 ? (j) + 1 : (hf) * 32); i < (hf) * 32 + 32; ++i) r[i] -= buf[(i >> 2) - (hf) * 8][i & 3] * xj; } while (0)
            LOADH(ha, 0, 0);
#pragma unroll
            for (int j = 0; j < 63; ++j) {
                LOADH(hb, j, 1);
                APPLYH(ha, j, 0);
                LOADH(ha, j + 1, 0);
                APPLYH(hb, j, 1);
            }
#undef LOADH
#undef APPLYH
#pragma unroll
            for (int i = 0; i < 64; ++i) RHS[i * 256 + tid] = r[i];
        }
        lds_barrier();
        {
            const int dv = tid >> 2, tq = tid & 3; u32x4 w0, w1; float e[16];
#pragma unroll
            for (int i = 0; i < 16; ++i) e[i] = RHS[(tq * 16 + i) * 256 + dv];
            w0.x = pk2(e[0], e[1]); w0.y = pk2(e[2], e[3]); w0.z = pk2(e[4], e[5]); w0.w = pk2(e[6], e[7]);
            w1.x = pk2(e[8], e[9]); w1.y = pk2(e[10], e[11]); w1.z = pk2(e[12], e[13]); w1.w = pk2(e[14], e[15]);
            bf16_t* up = UT + (size_t)it * 8192 + dv * 64 + tq * 16; *(u32x4*)up = w0; *(u32x4*)(up + 8) = w1;
            bf16_t* wp = WP + (size_t)(t0 + t) * 768 + h * 128 + 32 * (part >> 1) + 4 * (part & 1);
#pragma unroll
            for (int q4 = 0; q4 < 4; ++q4) { const f32x4 xv = *(const LAS f32x4*)(RHS + t * 256 + 128 + part * 16 + q4 * 4); u32x2 o; o.x = pk2(xv[0], xv[1]); o.y = pk2(xv[2], xv[3]); *(u32x2*)(wp + 8 * q4) = o; }
        }
        lds_barrier();
    }
#undef CH_LOAD
}

constexpr int SCAN_NBLK = 96, SCAN_BUF = 62464;
DI void scan_step(const LAS unsigned char* cur, f32x4 (&S)[8], const u32x2 (&uu)[4], float gl, bf16_t* op, int r16, int q) {
    bf16x8 Sb[4];
#pragma unroll
    for (int ks = 0; ks < 4; ++ks) Sb[ks] = pack8(S[2 * ks], S[2 * ks + 1]);
    const LAS unsigned char* bw = cur + r16 * 272 + 16 * q;
    const LAS unsigned char* ba = cur + 34816 + r16 * 144 + 16 * q;
#define FADDR(i) ((i) < 16 ? bw + ((i) % 4) * (16 * 272) + ((i) / 4) * 64 : (i) < 32 ? bw + 17408 + (((i) - 16) % 4) * (16 * 272) + (((i) - 16) / 4) * 64 : \
                  (i) < 40 ? ba + (((i) - 32) % 4) * (16 * 144) + (((i) - 32) / 4) * 64 : ba + 9216 + (((i) - 40) % 8) * (16 * 144) + (((i) - 40) / 8) * 64)
    constexpr int RING = 16; bf16x8 fr[RING]; f32x4 a1[4], o[4]; bf16x8 vb[2];
#pragma unroll
    for (int i = 0; i < 4; ++i) { a1[i] = (f32x4){0.f, 0.f, 0.f, 0.f}; o[i] = (f32x4){0.f, 0.f, 0.f, 0.f}; }
    vb[0] = Sb[0]; vb[1] = Sb[0];
#pragma unroll
    for (int i = 0; i < RING; ++i) fr[i] = *(const LAS bf16x8*)FADDR(i);
#pragma unroll
    for (int i = 0; i < 56; ++i) {
        const bf16x8 f = fr[i % RING];
        if (i + RING < 56) fr[i % RING] = *(const LAS bf16x8*)FADDR(i + RING);
        if (i < 16) a1[i % 4] = MFMA16(f, Sb[i / 4], a1[i % 4]);
        else if (i < 32) o[(i - 16) % 4] = MFMA16(f, Sb[(i - 16) / 4], o[(i - 16) % 4]);
        else if (i < 40) o[(i - 32) % 4] = MFMA16(f, vb[(i - 32) / 4], o[(i - 32) % 4]);
        else { const int dt = (i - 40) % 8, k2 = (i - 40) / 8; if (k2 == 0) S[dt] = S[dt] * gl; S[dt] = MFMA16(f, vb[k2], S[dt]); }
        if (i == 15) {
            f32x4 vn[4];
#pragma unroll
            for (int mt = 0; mt < 4; ++mt) vn[mt] = (f32x4){bflo(uu[mt].x), bfhi(uu[mt].x), bflo(uu[mt].y), bfhi(uu[mt].y)} - a1[mt];
            vb[0] = pack8(vn[0], vn[1]); vb[1] = pack8(vn[2], vn[3]);
        }
        __builtin_amdgcn_sched_barrier(0);
    }
#undef FADDR
#pragma unroll
    for (int mt = 0; mt < 4; ++mt) { u32x2 w; w.x = pk2(o[mt][0], o[mt][1]); w.y = pk2(o[mt][2], o[mt][3]); *(u32x2*)(op + 16 * mt) = w; }
}
DI void gdn_scan_phase(LAS unsigned char* lds, PRef p) {
    if (bidx() >= SCAN_NBLK) return;
    const bf16_t* QG = (const bf16_t*)(uni(p.ws) + WS_QG); const bf16_t* WP = (const bf16_t*)(uni(p.ws) + WS_WP); const bf16_t* KGT = (const bf16_t*)(uni(p.ws) + WS_KGT);
    const bf16_t* UT = (const bf16_t*)(uni(p.ws) + WS_UT); const bf16_t* AI = (const bf16_t*)(uni(p.ws) + WS_AI); const float* GL = (const float*)(uni(p.ws) + WS_GL);
    bf16_t* OT = (bf16_t*)(uni(p.ws) + WS_OT);
    const int tid = tidx(), lane = tid & 63, wave = __builtin_amdgcn_readfirstlane(tid >> 6), r16 = lane & 15, q = lane >> 4;
    const int xcd = bidx() & 7, kx = bidx() >> 3, hg = xcd * 3 + (kx >> 2), bh = hg >> 1, b = bh / 6, h = bh % 6, dv0 = ((hg & 1) * 4 + (kx & 3)) * 16;
    const size_t it0 = (size_t)(b * 256) * 6 + h, tok0 = (size_t)(b * 256) * 64;
    if (wave == 0) {
        f32x4 S[8];
#pragma unroll
        for (int i = 0; i < 8; ++i) S[i] = (f32x4){0.f, 0.f, 0.f, 0.f};
        u32x2 ua[4], ub[4], uc[4], ud[4]; float gla, glb, glc, gld;
        const bf16_t* up = UT + it0 * 8192 + (size_t)(dv0 + r16) * 64 + 4 * q;
        bf16_t* op = OT + it0 * 8192 + (size_t)(dv0 + r16) * 64 + 4 * q;
        const float* glp = GL + it0; const int zdiv = tidx() >> 20;
#define SCAN_LOADU(u, g, nn) do { const size_t o_ = (size_t)min((nn), 255) * (6 * 8192); \
        u[0] = *(const u32x2*)(up + o_); u[1] = *(const u32x2*)(up + o_ + 16); u[2] = *(const u32x2*)(up + o_ + 32); u[3] = *(const u32x2*)(up + o_ + 48); g = glp[min((nn), 255) * 6 + zdiv]; } while (0)
        SCAN_LOADU(ua, gla, 0); SCAN_LOADU(ub, glb, 1); SCAN_LOADU(uc, glc, 2); SCAN_LOADU(ud, gld, 3);
        lds_barrier();
#pragma unroll 1
        for (int n = 0; n < 256; n += 4) {
            scan_step(lds, S, ua, gla, op + (size_t)n * (6 * 8192), r16, q);
            SCAN_LOADU(ua, gla, n + 4);
            lds_barrier();
            scan_step(lds + SCAN_BUF, S, ub, glb, op + (size_t)(n + 1) * (6 * 8192), r16, q);
            SCAN_LOADU(ub, glb, n + 5);
            lds_barrier();
            scan_step(lds, S, uc, glc, op + (size_t)(n + 2) * (6 * 8192), r16, q);
            SCAN_LOADU(uc, glc, n + 6);
            lds_barrier();
            scan_step(lds + SCAN_BUF, S, ud, gld, op + (size_t)(n + 3) * (6 * 8192), r16, q);
            SCAN_LOADU(ud, gld, n + 7);
            lds_barrier();
        }
#undef SCAN_LOADU
    } else {
        const bf16_t* src; size_t sstride; int jsrc, dst, jdst;
        if (wave <= 4) { const int t2 = (tid - 64) & 127, row = t2 >> 4, pc = t2 & 15; const bool isq = wave >= 3;
            src = (isq ? QG : WP) + (tok0 + row) * 768 + h * 128 + pc * 8; sstride = 64 * 768; jsrc = 8 * 768; dst = (isq ? 17408 : 0) + row * 272 + pc * 16; jdst = 8 * 272; }
        else if (wave == 5) { const int t2 = lane; src = AI + it0 * 4096 + t2 * 8; sstride = 6 * 4096; jsrc = 512; dst = 34816 + (t2 >> 3) * 144 + (t2 & 7) * 16; jdst = 8 * 144; }
        else { const int t2 = (tid - 384) & 127; src = KGT + it0 * 8192 + t2 * 8; sstride = 6 * 8192; jsrc = 1024; dst = 44032 + (t2 >> 3) * 144 + (t2 & 7) * 16; jdst = 16 * 144; }
        u32x4 r0[8], r1[8], r2[8], r3[8];
#define SCAN_LOAD(r, nn) do { const bf16_t* s_ = src + (size_t)min((nn), 255) * sstride; \
        _Pragma("unroll") for (int j = 0; j < 8; ++j) r[j] = *(const u32x4*)(s_ + (size_t)j * jsrc); } while (0)
#define SCAN_STORE(r, bufp) do { LAS unsigned char* b_ = (bufp) + dst; \
        _Pragma("unroll") for (int j = 0; j < 8; ++j) *(LAS u32x4*)(b_ + j * jdst) = r[j]; } while (0)
        SCAN_LOAD(r0, 0); SCAN_LOAD(r1, 1); SCAN_LOAD(r2, 2); SCAN_LOAD(r3, 3);
        SCAN_STORE(r0, lds); SCAN_LOAD(r0, 4);
        lds_barrier();
#pragma unroll 1
        for (int n = 0; n < 256; n += 4) {
            SCAN_STORE(r1, lds + SCAN_BUF); SCAN_LOAD(r1, n + 5);
            lds_barrier();
            SCAN_STORE(r2, lds); SCAN_LOAD(r2, n + 6);
            lds_barrier();
            SCAN_STORE(r3, lds + SCAN_BUF); SCAN_LOAD(r3, n + 7);
            lds_barrier();
            SCAN_STORE(r0, lds); SCAN_LOAD(r0, n + 8);
            lds_barrier();
        }
#undef SCAN_LOAD
#undef SCAN_STORE
    }
}

DI void gdn_gate_phase(LAS unsigned char* lds, PRef p, int a) {
    const bf16_t* OT = (const bf16_t*)(uni(p.ws) + WS_OT); const bf16_t* P2 = (const bf16_t*)(uni(p.ws) + WS_P2); bf16_t* MIX = (bf16_t*)(uni(p.ws) + WS_MIX);
    const float* gn = uni(p.gdn_norm) + a * 128; LAS bf16_t* T = (LAS bf16_t*)lds;
    const int tid = tidx(), t = tid >> 3, part = tid & 7;
    for (int it = bidx(); it < NITEM; it += gridDim.x) {
        const int h = it % 6, cn = it / 6, t0 = cn * 64;
#pragma unroll
        for (int i = 0; i < 2; ++i) { const int id = tid + NT * i, row = id >> 3, pc = id & 7; *(LAS u32x4*)(T + row * 72 + pc * 8) = *(const u32x4*)(OT + (size_t)it * 8192 + row * 64 + pc * 8); }
        lds_barrier();
        float o[16]; float ss = 0.f;
#pragma unroll
        for (int e = 0; e < 16; ++e) { o[e] = bf2f(T[(part * 16 + e) * 72 + t]); ss += o[e] * o[e]; }
        ss += shx(ss, 1); ss += shx(ss, 2); ss += shx(ss, 4);
        const float rs = rsqrtf(ss * (1.f / 128.f) + 1e-6f);
        const bf16_t* zp = P2 + (size_t)(t0 + t) * 1024 + h * 128 + part * 16; const u32x4 z0 = *(const u32x4*)zp, z1 = *(const u32x4*)(zp + 8);
        float z[16] = {bflo(z0.x), bfhi(z0.x), bflo(z0.y), bfhi(z0.y), bflo(z0.z), bfhi(z0.z), bflo(z0.w), bfhi(z0.w), bflo(z1.x), bfhi(z1.x), bflo(z1.y), bfhi(z1.y), bflo(z1.z), bfhi(z1.z), bflo(z1.w), bfhi(z1.w)};
        float r[16];
#pragma unroll
        for (int e = 0; e < 16; ++e) r[e] = o[e] * rs * gn[part * 16 + e] * siluf(z[e]);
        u32x4 w0, w1; w0.x = pk2(r[0], r[1]); w0.y = pk2(r[2], r[3]); w0.z = pk2(r[4], r[5]); w0.w = pk2(r[6], r[7]);
        w1.x = pk2(r[8], r[9]); w1.y = pk2(r[10], r[11]); w1.z = pk2(r[12], r[13]); w1.w = pk2(r[14], r[15]);
        bf16_t* mp = MIX + (size_t)(t0 + t) * 1024 + h * 128 + part * 16; *(u32x4*)mp = w0; *(u32x4*)(mp + 8) = w1;
        lds_barrier();
    }
}

template <int MODE> DI void attn_phase(LAS unsigned char* lds, PRef p, int layer, int first = -1, int stride = 0) {
    LAS bf16_t* Ks = (LAS bf16_t*)lds;
    LAS bf16_t* Vt = (LAS bf16_t*)(lds + 36864);
    const bf16_t* Qb = (const bf16_t*)(uni(p.ws) + WS_P2); bf16_t* MIX = (bf16_t*)(uni(p.ws) + WS_MIX);
    const bf16_t* MKV = (const bf16_t*)(uni(p.ws) + WS_MKV); const bf16_t* KV = (const bf16_t*)(uni(p.ws) + WS_KV);
    const int tid = tidx(), lane = tid & 63, wave = tid >> 6, r16 = lane & 15, q = lane >> 4;
    const int nitems = MODE == 0 ? 256 : 512;
    if (first < 0) { first = bidx(); stride = gridDim.x; }
#pragma unroll 1
    for (int it = first; it < nitems; it += stride) {
        int b, hh, tb; size_t tok0;
        if (MODE == 0) { b = it >> 7; hh = (it >> 5) & 3; tb = it & 31; tok0 = (size_t)b * SEQ + tb * 512; }
        else { b = it >> 8; hh = (it >> 7) & 1; tb = it & 127; tok0 = (size_t)b * SEQ + tb * 128; }
#pragma unroll 1
        for (int i = 0; i < 4; ++i) {
            const int id = tid + NT * i, rr = id >> 3, pc = id & 7; u32x4 kv = {0u, 0u, 0u, 0u}, vv = {0u, 0u, 0u, 0u};
            if (MODE == 0) { const bf16_t* kp = MKV + (size_t)(b * 256 + rr) * 2048 + layer * 512 + hh * 64 + pc * 8; kv = *(const u32x4*)kp; vv = *(const u32x4*)(kp + 256); }
            else if (tb > 0 || rr >= 128) { const bf16_t* kp = KV + (tok0 - 128 + rr) * 256 + hh * 64 + pc * 8; kv = *(const u32x4*)kp; vv = *(const u32x4*)(kp + 128); }
            *(LAS u32x4*)(Ks + rr * 72 + pc * 8) = kv;
            LAS bf16_t* vp = Vt + (pc * 8) * 264 + tslot(rr);
            vp[0] = (bf16_t)(vv.x & 0xffffu); vp[264] = (bf16_t)(vv.x >> 16); vp[2 * 264] = (bf16_t)(vv.y & 0xffffu); vp[3 * 264] = (bf16_t)(vv.y >> 16);
            vp[4 * 264] = (bf16_t)(vv.z & 0xffffu); vp[5 * 264] = (bf16_t)(vv.z >> 16); vp[6 * 264] = (bf16_t)(vv.w & 0xffffu); vp[7 * 264] = (bf16_t)(vv.w >> 16);
        }
        lds_barrier();
        const int npass = MODE == 0 ? 32 : 48;
#pragma unroll 1
        for (int ps = wave; ps < npass; ps += 8) {
            int rt, colbase; float sink = 0.f;
            if (MODE == 0) { rt = ps; colbase = 768 + hh * 64; }
            else { const int hq = hh * 6 + (ps >> 3); rt = ps & 7; colbase = hq * 64; sink = uni(p.swa_sinks)[(layer - 2) * 12 + hq]; }
            const size_t tok = tok0 + 16 * rt + r16;
            const bf16_t* qp = Qb + tok * 1024 + colbase + 8 * q;
            const bf16x8 qf0 = *(const bf16x8*)qp, qf1 = *(const bf16x8*)(qp + 32);
            float m = MODE == 1 ? sink : -INFINITY, l = (MODE == 1 && q == 0) ? 1.f : 0.f;
            f32x4 ot[4];
#pragma unroll
            for (int dt = 0; dt < 4; ++dt) ot[dt] = (f32x4){0.f, 0.f, 0.f, 0.f};
            int kk0 = 0, kk1 = 7;
            if (MODE == 1) { kk0 = rt >> 1; if (tb == 0 && kk0 < 4) kk0 = 4; kk1 = (16 * rt + 143) >> 5; }
#pragma unroll 1
            for (int kk = kk0; kk <= kk1; ++kk) {
                const LAS bf16_t* kr = Ks + (32 * kk + r16) * 72 + 8 * q;
                f32x4 s0 = {0.f, 0.f, 0.f, 0.f}, s1 = {0.f, 0.f, 0.f, 0.f};
                s0 = MFMA16(*(const LAS bf16x8*)kr, qf0, s0); s0 = MFMA16(*(const LAS bf16x8*)(kr + 32), qf1, s0);
                s1 = MFMA16(*(const LAS bf16x8*)(kr + 16 * 72), qf0, s1); s1 = MFMA16(*(const LAS bf16x8*)(kr + 16 * 72 + 32), qf1, s1);
                if (MODE == 1) {
#pragma unroll
                    for (int j = 0; j < 4; ++j) { const int d0 = 16 * rt + r16 + 128 - (32 * kk + 4 * q + j), d1 = d0 - 16;
                        if (d0 < 0 || d0 >= 128) s0[j] = -INFINITY; if (d1 < 0 || d1 >= 128) s1[j] = -INFINITY; }
                }
                float gm = fmaxf(fmaxf(fmaxf(s0[0], s0[1]), fmaxf(s0[2], s0[3])), fmaxf(fmaxf(s1[0], s1[1]), fmaxf(s1[2], s1[3])));
                gm = fmaxf(gm, shx(gm, 16)); gm = fmaxf(gm, shx(gm, 32));
                const float mn = fmaxf(m, gm), sc = __expf(m - mn); m = mn; l *= sc;
#pragma unroll
                for (int dt = 0; dt < 4; ++dt) ot[dt] = ot[dt] * sc;
#pragma unroll
                for (int j = 0; j < 4; ++j) { s0[j] = __expf(s0[j] - mn); s1[j] = __expf(s1[j] - mn); l += s0[j] + s1[j]; }
                const bf16x8 pb = pack8(s0, s1);
#pragma unroll
                for (int dt = 0; dt < 4; ++dt) ot[dt] = MFMA16(*(const LAS bf16x8*)(Vt + (16 * dt + r16) * 264 + 32 * kk + 8 * q), pb, ot[dt]);
            }
            l += shx(l, 16); l += shx(l, 32);
            const float inv = 1.f / l; bf16_t* op = MIX + tok * 1024 + colbase + 4 * q;
#pragma unroll
            for (int dt = 0; dt < 4; ++dt) { u32x2 w; w.x = pk2(ot[dt][0] * inv, ot[dt][1] * inv); w.y = pk2(ot[dt][2] * inv, ot[dt][3] * inv); *(u32x2*)(op + 16 * dt) = w; }
        }
        lds_barrier();
    }
}

constexpr int PARAM_OFF = 131072;
DI void grid_bar(unsigned* bar, unsigned gen) {
    __syncthreads();
    if (threadIdx.x == 0) {
        __builtin_amdgcn_fence(__ATOMIC_RELEASE, "agent");
        const unsigned g = blockIdx.x & 7u, ngrp = (gridDim.x + 7u - g) >> 3;
        const unsigned old = __hip_atomic_fetch_add(bar + 64 + 64 * g, 1u, __ATOMIC_RELAXED, __HIP_MEMORY_SCOPE_AGENT);
        if (old + 1u == gen * ngrp) __hip_atomic_fetch_add(bar, 1u, __ATOMIC_RELAXED, __HIP_MEMORY_SCOPE_AGENT);
        const unsigned target = gen * (gridDim.x < 8u ? gridDim.x : 8u);
        while (__hip_atomic_load(bar, __ATOMIC_RELAXED, __HIP_MEMORY_SCOPE_AGENT) < target) __builtin_amdgcn_s_sleep(1);
        __builtin_amdgcn_fence(__ATOMIC_ACQUIRE, "agent");
    }
    __syncthreads();
}
enum { K_P0 = 0, K_GEMM, K_CHUNK, K_SCAN, K_GATE, K_ATTN, K_NORMFFN, K_POST, K_FINAL, K_NOP };

DI void gemm_step(LAS unsigned char* lds, PRef p, int gid, int layer) {
    unsigned char* ws = uni(p.ws); unsigned char* slot = ws + WS_WA0 + (size_t)(layer & 1) * WSLOT;
    const bf16_t* A = (const bf16_t*)(ws + WS_H); const bf16_t* Bt = (const bf16_t*)(slot + WO_IN); int M = MT, N = 1024, K = 1024;
    Epi E{0, 0, nullptr, nullptr, nullptr, nullptr, (const float*)(ws + WS_CS), (float*)(ws + WS_SSQ)};
    if (gid == 0) { A = (const bf16_t*)(ws + WS_MEMN); Bt = (const bf16_t*)(ws + WS_WMKV); M = 512; N = 2048; E.mode = 0; E.ldc = 2048; E.o0 = (bf16_t*)(ws + WS_MKV); }
    else if (gid == 1) { N = 3584; E.mode = 1; E.o0 = (bf16_t*)(ws + WS_P1); E.o1 = (bf16_t*)(ws + WS_P2); E.f0 = (float*)(ws + WS_AB); }
    else if (gid == 2) { E.mode = 2; E.o0 = (bf16_t*)(ws + WS_P2); }
    else if (gid == 3) { Bt = (const bf16_t*)(ws + WS_WKV); N = 256; E.mode = 3; E.o0 = (bf16_t*)(ws + WS_KV); }
    else if (gid == 4) { A = (const bf16_t*)(ws + WS_MIX); Bt = (const bf16_t*)(slot + WO_OUT); E.mode = 4; E.f0 = uni(p.out); E.base = layer == 0 ? uni(p.x) : uni(p.out); E.o0 = (bf16_t*)(ws + WS_H); }
    else if (gid == 5) { Bt = (const bf16_t*)(slot + WO_GU); N = 5632; E.mode = 5; E.o0 = (bf16_t*)(ws + WS_ACT); }
    else { A = (const bf16_t*)(ws + WS_ACT); Bt = (const bf16_t*)(slot + WO_DN); K = DFF; E.mode = 4; E.f0 = uni(p.out); E.base = uni(p.out); E.o0 = (bf16_t*)(ws + WS_H); }
    E.o0 = uni(E.o0); E.o1 = uni(E.o1); E.f0 = uni(E.f0); E.base = uni(E.base); E.cs = uni(E.cs); E.ssq = uni(E.ssq);
    run_gemm(lds, uni(A), uni(Bt), M, N, K, E);
}

__global__ void __launch_bounds__(NT, 2) yoco_fwd(Params pin) {
    extern __shared__ __attribute__((aligned(16))) unsigned char lds_raw[];
    LAS unsigned char* lds = (LAS unsigned char*)lds_raw;
    cg::grid_group grid = cg::this_grid();
    if (blockIdx.x == 0) { ((unsigned*)pin.ws)[threadIdx.x] = 0u; ((unsigned*)pin.ws)[threadIdx.x + NT] = 0u; }
    { const unsigned* src = (const unsigned*)&pin; if (tidx() < sizeof(Params) / 4) ((LAS unsigned*)(lds + PARAM_OFF))[tidx()] = src[tidx()]; }
    __syncthreads();
#define PP pin
    {
        PRef p = PP; unsigned char* ws = uni(p.ws);
        conv_layer_weights(lds, p, 0, ws + WS_WA0, -1, 0, 3);
        wconv(lds, uni(p.w_kv), 1024, 256, (bf16_t*)(ws + WS_WKV), 256, 3, uni(p.ln_kv));
#pragma unroll 1
        for (int l = 0; l < 4; ++l) wconv(lds, uni(p.w_mem_kv) + (size_t)l * 1024 * 512, 1024, 512, (bf16_t*)(ws + WS_WMKV) + (size_t)l * 512 * 1024, 512, 0);
        rope_table(p);
        norm_rows(uni(p.mem), uni(p.ln_mem), (bf16_t*)(ws + WS_MEMN), 512);
        xb_rows(uni(p.x), (bf16_t*)(ws + WS_H), (float*)(ws + WS_SSQ), MT);
        grid.sync();
    }
    constexpr int NSTEP = 14 + 10;
#pragma unroll 1
    for (int s = 0; s < NSTEP; ++s) {
        int kind, layer, gid = 0;
        if (s < 14) { const int k = s % 7; layer = s / 7;
            kind = k == 0 ? K_GEMM : k == 1 ? K_CHUNK : k == 2 ? K_SCAN : k == 3 ? K_GATE : K_GEMM;
            gid = k == 0 ? 1 : k == 4 ? 4 : k == 5 ? 5 : 6; }
        else { const int t = s - 14, k = t % 5; layer = 2 + t / 5;
            kind = k == 1 ? K_ATTN : K_GEMM;
            gid = k == 0 ? 2 : k == 2 ? 4 : k == 3 ? 5 : 6; }
        if (kind == K_GEMM) {
            int g = (s == 0) ? 0 : gid;
            for (;;) { gemm_step(lds, PP, g, layer); if (g == 0) g = gid; else if (g == 2 && layer == 2) g = 3; else break; }
        }
        else if (kind == K_CHUNK) gdn_chunk_phase(lds, PP, layer);
        else if (kind == K_SCAN) { gdn_scan_phase(lds, PP);
            if (bidx() >= SCAN_NBLK) {
                const int f = bidx() - SCAN_NBLK, st = gridDim.x - SCAN_NBLK;
                attn_phase<0>(lds, PP, layer, f, st);
                PRef p = PP;
                if (layer == 0) { conv_layer_weights(lds, p, 0, uni(p.ws) + WS_WA0, f, st, 12); conv_layer_weights(lds, p, 1, uni(p.ws) + WS_WA0 + WSLOT, f, st); }
                else conv_layer_weights(lds, p, 2, uni(p.ws) + WS_WA0, f, st); } }
        else if (kind == K_GATE) gdn_gate_phase(lds, PP, layer);
        else { attn_phase<1>(lds, PP, layer); attn_phase<0>(lds, PP, layer);
            if (layer == 2) { PRef p = PP; conv_layer_weights(lds, p, 3, uni(p.ws) + WS_WA0 + WSLOT); } }
        grid_bar((unsigned*)pin.ws, (unsigned)(s + 1));
    }
    { PRef p = PP; final_norm(uni(p.out), uni(p.ln_final), MT); }
#undef PP
}

extern "C" void kernel_launch(void* const* d_in, const int* in_sizes, int n_in, void* d_out, int out_size, void* d_ws, size_t ws_size, hipStream_t stream) {
    static int grid = 0;
    if (grid == 0) {
        if (n_in != 20 || out_size != MT * DMODEL || ws_size < WS_END) { fprintf(stderr, "kernel_launch: unexpected shapes (n_in %d, out %d, ws %zu)\n", n_in, out_size, ws_size); grid = -1; return; }
        int dev = 0, cus = 0, per_cu = 0;
        (void)hipGetDevice(&dev); (void)hipDeviceGetAttribute(&cus, hipDeviceAttributeMultiprocessorCount, dev);
        if (hipFuncSetAttribute((const void*)yoco_fwd, hipFuncAttributeMaxDynamicSharedMemorySize, LDS_BYTES) != hipSuccess) { fprintf(stderr, "kernel_launch: hipFuncSetAttribute failed\n"); grid = -1; return; }
        (void)hipOccupancyMaxActiveBlocksPerMultiprocessor(&per_cu, (const void*)yoco_fwd, NT, LDS_BYTES);
        (void)hipGetLastError();
        if (per_cu < 1) fprintf(stderr, "kernel_launch: occupancy query says %d blocks/CU\n", per_cu);
        grid = cus > 0 ? cus : 256;
    }
    if (grid < 0) return;
    Params p{};
    p.x = (const float*)d_in[0]; p.mem = (const float*)d_in[1]; p.pos = (const int*)d_in[2]; p.ln_mix = (const float*)d_in[3]; p.ln_ffn = (const float*)d_in[4]; p.ln_mem = (const float*)d_in[5];
    p.w_mem_kv = (const float*)d_in[6]; p.w_out = (const float*)d_in[7]; p.w_gate_up = (const float*)d_in[8]; p.w_down = (const float*)d_in[9]; p.gdn_w_in = (const float*)d_in[10];
    p.gdn_conv = (const float*)d_in[11]; p.gdn_A_log = (const float*)d_in[12]; p.gdn_dt_bias = (const float*)d_in[13]; p.gdn_norm = (const float*)d_in[14]; p.swa_w_q = (const float*)d_in[15];
    p.swa_sinks = (const float*)d_in[16]; p.ln_kv = (const float*)d_in[17]; p.w_kv = (const float*)d_in[18]; p.ln_final = (const float*)d_in[19];
    p.out = (float*)d_out; p.ws = (unsigned char*)d_ws;
    for (int i = 0; i < 8; ++i) p.inv[i] = (float)pow(500000.0, -(double)(2 * i) / 16.0);
    void* args[] = {&p};
    hipError_t e = hipLaunchCooperativeKernel((const void*)yoco_fwd, dim3(grid), dim3(NT), args, LDS_BYTES, stream);
    if (e != hipSuccess) fprintf(stderr, "kernel_launch: cooperative launch failed: %s (grid %d)\n", hipGetErrorString(e), grid);
}
```

```cpp
#include <hip/hip_runtime.h>
#include <hip/hip_cooperative_groups.h>
#include <cstdio>
#include <cstdint>
#include <cmath>
namespace cg = cooperative_groups;
__device__ __forceinline__ int tidx() { int t = threadIdx.x; asm volatile("" : "+v"(t)); return t; }
__device__ __forceinline__ int bidx() { int b = blockIdx.x; asm volatile("" : "+s"(b)); return b; }
namespace pg8 {
#define PG8_LAS __attribute__((address_space(3)))
typedef unsigned short bf16_t;
typedef short bf16x8 __attribute__((ext_vector_type(8)));
typedef float f32x4 __attribute__((ext_vector_type(4)));
typedef unsigned u32x4 __attribute__((ext_vector_type(4)));
constexpr int BM = 256, BK = 64, HALF = 128, HTB = HALF * BK * 2  , STAGE_BYTES = 8 * HTB, NXCD = 8, WGM = 8;

__host__ __device__ __forceinline__ int lds_byte(int r, int c) { const int st = (r >> 4) * 2 + (c >> 5), rr = r & 15, cc = c & 31, ob = rr * 64 + cc * 2; return st * 1024 + (ob ^ (((ob >> 9) & 1) << 5)); }
__host__ __device__ __forceinline__ void stage_rc(int b, int& R, int& C) { const int st = b / 1024, sb = b % 1024, swz = sb ^ (((sb >> 9) & 1) << 5); R = (st >> 1) * 16 + swz / 64; C = (st & 1) * 32 + (swz % 64) / 2; }
__host__ __device__ __forceinline__ int perm32(int rho) { const int n = rho >> 4, i = rho & 15; return 8 * (i >> 2) + 4 * n + (i & 3); }

struct Unit { int pm, pn; };
struct Gemm { const bf16_t* A; const bf16_t* Bt; int M, N, K; };

struct StaticOrder {
    int nM, nN, nwg, G, c;
    __host__ __device__ void init(int M, int N, int G_, int c_) { nM = M / BM; nN = N / BM; nwg = nM * nN; G = G_; c = c_; }
    __host__ __device__ bool next(int i, Unit& u) const {
        const long L = (long)i * G + c; if (L >= nwg) return false;
        int wgid = (int)L; { const int q = nwg / NXCD, r = nwg % NXCD, xcd = wgid % NXCD, off = wgid / NXCD; wgid = (xcd < r ? xcd * (q + 1) : r * (q + 1) + (xcd - r) * q) + off; }
        const int nig = WGM * nN, gid = wgid / nig, fm = gid * WGM, gsz = (nM - fm) < WGM ? (nM - fm) : WGM;
        u.pm = fm + ((wgid % nig) % gsz); u.pn = (wgid % nig) / gsz; return true;
    }
    __device__ __forceinline__ void a_ready(const Unit&) const {}
    __device__ __forceinline__ void done(const Unit&) const {}
};
template <class Epi, class Sched, bool ALIGN_EPI = false, bool SP2 = false>
__device__ __forceinline__ void gemm_phase(PG8_LAS unsigned char* lds, const Gemm g, const Sched& S, const Epi& E) {
    const int tid = tidx(), wid = __builtin_amdgcn_readfirstlane(tid >> 6), lane = tid & 63, wr = wid >> 2, wc = wid & 3, fr = lane & 15, fq = lane >> 4;
    const int K = g.K, nt = K / BK;
    unsigned voffA[2], voffB[2];
#pragma unroll
    for (int i = 0; i < 2; ++i) { int R, C; stage_rc(tid * 16 + i * 8192, R, C); const int Rb = Epi::PERM ? ((R & ~31) + perm32(R & 31)) : R;
        voffA[i] = (unsigned)(R * K + C) * 2u; voffB[i] = (unsigned)(Rb * K + C) * 2u; }
    const size_t kstep = (size_t)(BK * 2);
    const size_t hstep = (size_t)HALF * K * 2;
    const size_t tstep = 2 * hstep;
    const unsigned ldsw = (unsigned)wid * 1024u;
    const int aoff = lds_byte(wr * 64 + fr, fq * 8), boff = lds_byte(wc * 32 + fr, fq * 8);
#define PG8_SA(b, h) (((b) * 2 + (h)) * HTB)
#define PG8_SB(b, h) ((4 + (b) * 2 + (h)) * HTB)
#define PG8_STAGE(bufoff, gbase, voff) do { _Pragma("unroll") for (int _i = 0; _i < 2; ++_i) \
        __builtin_amdgcn_global_load_lds((const unsigned*)((const char*)(gbase) + (voff)[_i]), (PG8_LAS unsigned*)(lds + (bufoff) + ldsw + _i * 8192), 16, 0, 0); } while (0)
#define PG8_LDA(dst, b, h) do { _Pragma("unroll") for (int m = 0; m < 4; ++m) _Pragma("unroll") for (int k = 0; k < 2; ++k) dst[m][k] = *(const PG8_LAS bf16x8*)(lds + PG8_SA(b, h) + aoff + m * 2048 + k * 1024); } while (0)
#define PG8_LDB(dst, b, h) do { _Pragma("unroll") for (int n = 0; n < 2; ++n) _Pragma("unroll") for (int k = 0; k < 2; ++k) dst[n][k] = *(const PG8_LAS bf16x8*)(lds + PG8_SB(b, h) + boff + n * 2048 + k * 1024); } while (0)
#define PG8_MMA(ai, bj, At, Bt) do { __builtin_amdgcn_s_setprio(1); _Pragma("unroll") for (int m = 0; m < 4; ++m) _Pragma("unroll") for (int n = 0; n < 2; ++n) _Pragma("unroll") for (int k = 0; k < 2; ++k) \
        acc[ai][bj][m][n] = __builtin_amdgcn_mfma_f32_16x16x32_bf16(Bt[n][k], At[m][k], acc[ai][bj][m][n], 0, 0, 0); __builtin_amdgcn_s_setprio(0); } while (0)
#define PG8_WAIT_V(n) asm volatile("s_waitcnt vmcnt(" #n ")" ::: "memory")
#define PG8_WAIT_L(n) asm volatile("s_waitcnt lgkmcnt(" #n ")" ::: "memory")
#define PG8_BAR __builtin_amdgcn_s_barrier()
#define PG8_SCHED __builtin_amdgcn_sched_barrier(0)
    Unit cur, nxt; int ui = 0;
    if (!S.next(0, cur)) return;
    f32x4 acc[2][2][4][2];
#pragma unroll
    for (int a = 0; a < 2; ++a)
#pragma unroll
        for (int b = 0; b < 2; ++b)
#pragma unroll
            for (int m = 0; m < 4; ++m)
#pragma unroll
                for (int n = 0; n < 2; ++n) acc[a][b][m][n] = (f32x4){0.f, 0.f, 0.f, 0.f};
    bf16x8 At[4][2], B0[2][2], B1[2][2];
    const char* cA = (const char*)g.A + (size_t)cur.pm * tstep; const char* cB = (const char*)g.Bt + (size_t)cur.pn * tstep;
    S.a_ready(cur);
    if constexpr (SP2) {
        PG8_STAGE(PG8_SB(0, 0), cB, voffB); PG8_STAGE(PG8_SB(0, 1), cB + hstep, voffB); PG8_STAGE(PG8_SA(0, 0), cA, voffA); PG8_STAGE(PG8_SA(0, 1), cA + hstep, voffA);
        if (wr == 1) PG8_BAR;
        PG8_WAIT_V(2); PG8_BAR;
        PG8_STAGE(PG8_SB(1, 0), cB + kstep, voffB); PG8_STAGE(PG8_SA(1, 0), cA + kstep, voffA); PG8_STAGE(PG8_SB(1, 1), cB + hstep + kstep, voffB);
        PG8_WAIT_V(6); PG8_BAR;
    } else {
        PG8_STAGE(PG8_SB(0, 0), cB, voffB); PG8_STAGE(PG8_SA(0, 0), cA, voffA); PG8_STAGE(PG8_SB(0, 1), cB + hstep, voffB); PG8_STAGE(PG8_SA(0, 1), cA + hstep, voffA);
        if (wr == 1) PG8_BAR;
        PG8_WAIT_V(4); PG8_BAR;
        PG8_STAGE(PG8_SB(1, 0), cB + kstep, voffB); PG8_STAGE(PG8_SA(1, 0), cA + kstep, voffA); PG8_STAGE(PG8_SB(1, 1), cB + hstep + kstep, voffB);
        PG8_WAIT_V(6); PG8_BAR;
    }
    for (;;) {
        const bool has_next = S.next(ui + 1, nxt);
        const char* nA = has_next ? (const char*)g.A + (size_t)nxt.pm * tstep : cA; const char* nB = has_next ? (const char*)g.Bt + (size_t)nxt.pn * tstep : cB;
        for (int t = 0; t < nt; t += 2) {
            const bool last = (t == nt - 2);
            const char* a1 = cA + (size_t)(t + 1) * kstep;
            const char* a2 = last ? nA : cA + (size_t)(t + 2) * kstep; const char* b2 = last ? nB : cB + (size_t)(t + 2) * kstep;
            const char* a3 = a2 + kstep; const char* b3 = b2 + kstep;
            if (last && has_next) S.a_ready(nxt);
            if constexpr (SP2) {
            PG8_LDB(B0, 0, 0); PG8_LDB(B1, 0, 1); PG8_SCHED; PG8_LDA(At, 0, 0); PG8_STAGE(PG8_SA(1, 1), a1 + hstep, voffA);
            PG8_WAIT_V(8); PG8_WAIT_L(0); PG8_BAR; PG8_MMA(0, 0, At, B0); PG8_MMA(0, 1, At, B1); PG8_BAR; PG8_SCHED;
            PG8_LDA(At, 0, 1); PG8_STAGE(PG8_SB(0, 0), b2, voffB); PG8_STAGE(PG8_SB(0, 1), b2 + hstep, voffB); PG8_STAGE(PG8_SA(0, 0), a2, voffA);
            PG8_WAIT_V(8); PG8_WAIT_L(0); PG8_BAR; PG8_MMA(1, 0, At, B0); PG8_MMA(1, 1, At, B1); PG8_BAR; PG8_SCHED;
            PG8_LDB(B0, 1, 0); PG8_LDB(B1, 1, 1); PG8_SCHED; PG8_LDA(At, 1, 0); PG8_STAGE(PG8_SA(0, 1), a2 + hstep, voffA);
            PG8_WAIT_V(8); PG8_WAIT_L(0); PG8_BAR; PG8_MMA(0, 0, At, B0); PG8_MMA(0, 1, At, B1); PG8_BAR; PG8_SCHED;
            PG8_LDA(At, 1, 1); PG8_STAGE(PG8_SB(1, 0), b3, voffB); PG8_STAGE(PG8_SB(1, 1), b3 + hstep, voffB); PG8_STAGE(PG8_SA(1, 0), a3, voffA);
            PG8_WAIT_V(8); PG8_WAIT_L(0); PG8_BAR; PG8_MMA(1, 0, At, B0); PG8_MMA(1, 1, At, B1); PG8_BAR; PG8_SCHED;
            } else {
            PG8_LDB(B0, 0, 0); PG8_SCHED; PG8_LDA(At, 0, 0); PG8_STAGE(PG8_SA(1, 1), a1 + hstep, voffA);
            PG8_WAIT_L(8); PG8_BAR; PG8_WAIT_L(0); PG8_MMA(0, 0, At, B0); PG8_BAR; PG8_SCHED;
            PG8_LDB(B1, 0, 1); PG8_STAGE(PG8_SB(0, 0), b2, voffB);
            PG8_BAR; PG8_WAIT_L(0); PG8_MMA(0, 1, At, B1); PG8_BAR;
            PG8_LDA(At, 0, 1); PG8_STAGE(PG8_SA(0, 0), a2, voffA);
            PG8_BAR; PG8_WAIT_L(0); PG8_MMA(1, 0, At, B0); PG8_BAR; PG8_SCHED;
            PG8_STAGE(PG8_SB(0, 1), b2 + hstep, voffB);
            PG8_WAIT_V(6); PG8_BAR; PG8_MMA(1, 1, At, B1); PG8_BAR;
            PG8_LDB(B0, 1, 0); PG8_SCHED; PG8_LDA(At, 1, 0); PG8_STAGE(PG8_SA(0, 1), a2 + hstep, voffA);
            PG8_WAIT_L(8); PG8_BAR; PG8_WAIT_L(0); PG8_MMA(0, 0, At, B0); PG8_BAR; PG8_SCHED;
            PG8_LDB(B1, 1, 1); PG8_STAGE(PG8_SB(1, 0), b3, voffB);
            PG8_BAR; PG8_WAIT_L(0); PG8_MMA(0, 1, At, B1); PG8_BAR;
            PG8_LDA(At, 1, 1); PG8_STAGE(PG8_SA(1, 0), a3, voffA);
            PG8_BAR; PG8_WAIT_L(0); PG8_MMA(1, 0, At, B0); PG8_BAR; PG8_SCHED;
            PG8_STAGE(PG8_SB(1, 1), b3 + hstep, voffB);
            PG8_WAIT_V(6); PG8_BAR; PG8_MMA(1, 1, At, B1); PG8_BAR;
            }
        }
        if constexpr (ALIGN_EPI) { if (wr == 0) PG8_BAR; }
        if constexpr (!Epi::AFTER_DRAIN) { E(acc, cur, wr, wc, fr, fq); S.done(cur); }
        if (!has_next) break;
#pragma unroll
        for (int a = 0; a < 2; ++a)
#pragma unroll
            for (int b = 0; b < 2; ++b)
#pragma unroll
                for (int m = 0; m < 4; ++m)
#pragma unroll
                    for (int n = 0; n < 2; ++n) acc[a][b][m][n] = (f32x4){0.f, 0.f, 0.f, 0.f};
        cur = nxt; cA = nA; cB = nB; ++ui;
        if constexpr (ALIGN_EPI) { if (wr == 1) PG8_BAR; }
    }
    PG8_WAIT_V(0);
    if constexpr (!ALIGN_EPI) { if (wr == 0) PG8_BAR; }
    PG8_BAR;
    if constexpr (Epi::AFTER_DRAIN) { E.fused(acc, cur, wr, wc, fr, fq, lds, wid, lane); S.done(cur); }
#undef PG8_SA
#undef PG8_SB
#undef PG8_STAGE
#undef PG8_LDA
#undef PG8_LDB
#undef PG8_MMA
#undef PG8_WAIT_V
#undef PG8_WAIT_L
#undef PG8_BAR
#undef PG8_SCHED
}
}

#define DI __device__ __forceinline__
#define LAS __attribute__((address_space(3)))
typedef unsigned short bf16_t;
typedef short bf16x8 __attribute__((ext_vector_type(8)));
typedef float f32x4 __attribute__((ext_vector_type(4)));
typedef unsigned u32x4 __attribute__((ext_vector_type(4)));
typedef unsigned u32x2 __attribute__((ext_vector_type(2)));

constexpr int NT = 512;
constexpr int MT = 32768, SEQ = 16384, DMODEL = 1024, DFF = 2816;
constexpr int NITEM = 3072;
constexpr size_t MiB = 1u << 20;
constexpr size_t WS_CS = 1 * MiB;
constexpr size_t WS_AB = 3 * MiB;
constexpr size_t WS_MEMN = 5 * MiB;
constexpr size_t WS_MKV = 6 * MiB;
constexpr size_t WS_WMKV = 8 * MiB;
constexpr size_t WS_WKV = 12 * MiB;
constexpr size_t WS_GL = 13 * MiB;
constexpr size_t WS_KV = 14 * MiB;
constexpr size_t WS_WA0 = 30 * MiB;
constexpr size_t WSLOT = 26 * MiB;
constexpr size_t WO_IN = 0, WO_OUT = 7 * MiB, WO_GU = 9 * MiB, WO_DN = 20 * MiB;
constexpr size_t WS_P1 = 82 * MiB;
constexpr size_t WS_OT = 82 * MiB;
constexpr size_t WS_MIX = 130 * MiB;
constexpr size_t WS_ACT = 82 * MiB;
constexpr size_t WS_HKV = 82 * MiB;
constexpr size_t WS_P2 = 226 * MiB;
constexpr size_t WS_H = 290 * MiB;
constexpr size_t WS_QG = 290 * MiB;
constexpr size_t WS_KGT = 338 * MiB;
constexpr size_t WS_UT = 386 * MiB;
constexpr size_t WS_WP = 434 * MiB;
constexpr size_t WS_AI = 482 * MiB;
constexpr size_t WS_WB0 = 386 * MiB;
constexpr size_t WS_SSQ = 506 * MiB;
constexpr size_t WS_END = 508 * MiB;
constexpr int LDS_BYTES = 135168;

struct Params {
    const float* x; const float* mem; const int* pos; const float* ln_mix; const float* ln_ffn; const float* ln_mem;
    const float* w_mem_kv; const float* w_out; const float* w_gate_up; const float* w_down; const float* gdn_w_in;
    const float* gdn_conv; const float* gdn_A_log; const float* gdn_dt_bias; const float* gdn_norm; const float* swa_w_q;
    const float* swa_sinks; const float* ln_kv; const float* w_kv; const float* ln_final;
    float* out; unsigned char* ws;
    float inv[8];
};

typedef const Params& PRef;
DI unsigned f2bf(float f) { unsigned u = __float_as_uint(f); return (u + 0x7fffu + ((u >> 16) & 1u)) >> 16; }
typedef float f32x2_t __attribute__((ext_vector_type(2)));
typedef __bf16 bf16x2_t __attribute__((ext_vector_type(2)));
DI unsigned pk2(float lo, float hi) { f32x2_t v = {lo, hi}; bf16x2_t b = __builtin_convertvector(v, bf16x2_t); return __builtin_bit_cast(unsigned, b); }
DI float bflo(unsigned w) { return __uint_as_float(w << 16); }
DI float bfhi(unsigned w) { return __uint_as_float(w & 0xffff0000u); }
DI float bf2f(bf16_t b) { return __uint_as_float((unsigned)b << 16); }
DI bf16x8 pack8(f32x4 a, f32x4 b) { u32x4 p; p.x = pk2(a[0], a[1]); p.y = pk2(a[2], a[3]); p.z = pk2(b[0], b[1]); p.w = pk2(b[2], b[3]); return __builtin_bit_cast(bf16x8, p); }
DI float shx(float v, int mask) { const int ln = tidx() & 63; return __builtin_bit_cast(float, __builtin_amdgcn_ds_bpermute((ln ^ mask) << 2, __builtin_bit_cast(int, v))); }
DI float shup(float v, int d) { const int ln = tidx() & 63; return __builtin_bit_cast(float, __builtin_amdgcn_ds_bpermute((ln - d) << 2, __builtin_bit_cast(int, v))); }
DI LAS unsigned char* lnd(LAS unsigned char* q) { asm volatile("" : "+v"(q)); return q; }
#define uni(x) (x)
DI void lds_barrier() { asm volatile("s_waitcnt lgkmcnt(0)" ::: "memory"); __builtin_amdgcn_s_barrier(); asm volatile("" ::: "memory"); }
DI float wave_sum(float v) {
#pragma unroll
    for (int o = 32; o; o >>= 1) v += shx(v, o);
    return v; }
DI float siluf(float v) { return v * __builtin_amdgcn_rcpf(1.f + __expf(-v)); }
DI int tslot(int t) { return (t & ~31) + 8 * ((t & 15) >> 2) + 4 * ((t >> 4) & 1) + (t & 3); }
#define MFMA16(a, b, c) __builtin_amdgcn_mfma_f32_16x16x32_bf16((a), (b), (c), 0, 0, 0)

struct Epi {
    static constexpr bool PERM = true, AFTER_DRAIN = false;
    int mode; int ldc; bf16_t* o0; bf16_t* o1; float* f0; const float* base; const float* cs; float* ssq;
    DI void st8(bf16_t* p, f32x4 v0, f32x4 v1) const { u32x4 w; w.x = pk2(v0[0], v0[1]); w.y = pk2(v0[2], v0[3]); w.z = pk2(v1[0], v1[1]); w.w = pk2(v1[2], v1[3]); *(u32x4*)p = w; }
    DI void rope(f32x4& v0, f32x4& v1, int row, int col) const {
        if ((col & 63) < 16) { const f32x4 c = *(const f32x4*)(cs + (size_t)row * 16 + ((col & 63) >> 1)), s = *(const f32x4*)(cs + (size_t)row * 16 + 8 + ((col & 63) >> 1));
            const f32x4 a = v0 * c - v1 * s, b = v1 * c + v0 * s; v0 = a; v1 = b; }
    }
    DI void operator()(const f32x4 (&acc)[2][2][4][2], const pg8::Unit& u, int wr, int wc, int fr, int fq) const {
        const int row0 = u.pm * 256 + wr * 64 + fr;
        float rsv[2][4];
#pragma unroll
        for (int ai = 0; ai < 2; ++ai)
#pragma unroll
            for (int m = 0; m < 4; ++m) rsv[ai][m] = 1.f;
        if (mode != 0 && mode != 4) {
#pragma unroll
            for (int ai = 0; ai < 2; ++ai)
#pragma unroll
                for (int mp = 0; mp < 2; ++mp) {
                    f32x4 t[2][4];
#pragma unroll
                    for (int m = 0; m < 2; ++m) { const f32x4* sp = (const f32x4*)(ssq + (size_t)(row0 + ai * 128 + (2 * mp + m) * 16) * 16); t[m][0] = sp[0]; t[m][1] = sp[1]; t[m][2] = sp[2]; t[m][3] = sp[3]; }
#pragma unroll
                    for (int m = 0; m < 2; ++m) { const f32x4 c = (t[m][0] + t[m][1]) + (t[m][2] + t[m][3]); rsv[ai][2 * mp + m] = rsqrtf(((c[0] + c[1]) + (c[2] + c[3])) * (1.f / 1024.f) + 1e-6f); }
                }
        }
#pragma unroll
        for (int aim = 0; aim < 4; ++aim) { const int ai = aim >> 1, mp = aim & 1;
            f32x4 bs[2][2][2];
            if (mode == 4) {
#pragma unroll
                for (int m = 0; m < 2; ++m)
#pragma unroll
                    for (int bj = 0; bj < 2; ++bj) { const float* bp = base + (size_t)(row0 + ai * 128 + (2 * mp + m) * 16) * 1024 + u.pn * 256 + bj * 128 + wc * 32 + 8 * fq; bs[m][bj][0] = *(const f32x4*)bp; bs[m][bj][1] = *(const f32x4*)(bp + 4); }
            }
#pragma unroll
            for (int m = 2 * mp; m < 2 * mp + 2; ++m) {
                const int row = row0 + ai * 128 + m * 16;
                const float rs = rsv[ai][m]; float ssacc = 0.f;
                if (mode == 5) {
                    const f32x4 g0 = acc[ai][0][m][0] * rs, g1 = acc[ai][0][m][1] * rs, u0 = acc[ai][1][m][0] * rs, u1 = acc[ai][1][m][1] * rs;
                    st8(o0 + (size_t)row * DFF + u.pn * 128 + wc * 32 + 8 * fq, (f32x4){siluf(g0[0]) * u0[0], siluf(g0[1]) * u0[1], siluf(g0[2]) * u0[2], siluf(g0[3]) * u0[3]},
                        (f32x4){siluf(g1[0]) * u1[0], siluf(g1[1]) * u1[1], siluf(g1[2]) * u1[2], siluf(g1[3]) * u1[3]});
                } else
#pragma unroll
                for (int bj = 0; bj < 2; ++bj) {
                    const int col = u.pn * 256 + bj * 128 + wc * 32 + 8 * fq;
                    f32x4 v0 = acc[ai][bj][m][0] * rs, v1 = acc[ai][bj][m][1] * rs;
                    if (mode == 0) { st8(o0 + (size_t)row * ldc + col, v0, v1); }
                    else if (mode == 1) {
                        if (col < 2304) st8(o0 + (size_t)row * 2304 + col, v0, v1);
                        else if (col < 3328) { if (col >= 3072) { v0 = v0 * 0.125f; v1 = v1 * 0.125f; } st8(o1 + (size_t)row * 1024 + (col - 2304), v0, v1); }
                        else if (col == 3328) { *(f32x4*)(f0 + (size_t)row * 16) = v0; *(f32x4*)(f0 + (size_t)row * 16 + 4) = v1; }
                        else if (col == 3336) { *(f32x4*)(f0 + (size_t)row * 16 + 8) = v0; }
                    }
                    else if (mode == 2) { v0 = v0 * 0.125f; v1 = v1 * 0.125f; if (col < 768) rope(v0, v1, row, col); st8(o0 + (size_t)row * 1024 + col, v0, v1); }
                    else if (mode == 3) { if (col < 128) rope(v0, v1, row, col); st8(o0 + (size_t)row * 256 + col, v0, v1); }
                    else if (mode == 4) { float* op = f0 + (size_t)row * 1024 + col;
                        const f32x4 x0 = bs[m & 1][bj][0] + v0, x1 = bs[m & 1][bj][1] + v1; *(f32x4*)op = x0; *(f32x4*)(op + 4) = x1;
                        st8(o0 + (size_t)row * 1024 + col, x0, x1);
                        ssacc += (x0[0] * x0[0] + x0[1] * x0[1]) + (x0[2] * x0[2] + x0[3] * x0[3]) + (x1[0] * x1[0] + x1[1] * x1[1]) + (x1[2] * x1[2] + x1[3] * x1[3]); }

                }
                if (mode == 4) { ssacc += shx(ssacc, 16); ssacc += shx(ssacc, 32); if (fq == 0) ssq[(size_t)row * 16 + u.pn * 4 + wc] = ssacc; }
            }
        }
    }
};

DI void run_gemm(LAS unsigned char* lds, const bf16_t* A, const bf16_t* Bt, int M, int N, int K, const Epi& E) {
    pg8::Gemm g{A, Bt, M, N, K}; pg8::StaticOrder S; const int G = gridDim.x, bx = bidx();
    S.init(M, N, G, bx);
    pg8::gemm_phase<Epi, pg8::StaticOrder, true, true>(lds, g, S, E);
    __syncthreads();
}

DI int wmap(int mode, int n, int N) {
    if (mode == 0) return n < N ? n : -1;
    if (mode == 1) return n < 3072 ? n : (n < 3328 ? 3084 + (n - 3072) : (n < 3340 ? 3072 + (n - 3328) : -1));
    if (mode == 2) { const int u = n >> 8, w = n & 255; return w < 128 ? u * 128 + w : DFF + u * 128 + (w - 128); }
    const int lim = (N == 1024) ? 768 : 128;
    if (n < lim) { const int p = n & 63; if (p < 16) { const int q = p >> 3, jj = p & 7; return (n & ~63) + (jj < 4 ? 4 * q + jj : 8 + 4 * q + (jj - 4)); } }
    return n;
}
DI void wconv(LAS unsigned char* lds, const float* __restrict__ W, int K, int N, bf16_t* Wt, int Nout, int mode, const float* gk = nullptr, int first = -1, int stride = 0) {
    LAS float* tile = (LAS float*)lds; const int tid = tidx(), ntk = K / 64, ntn = Nout / 64;
    if (first < 0) { first = bidx(); stride = gridDim.x; }
    for (int t = first; t < ntk * ntn; t += stride) {
        const int tk = t % ntk, tn = t / ntk, k0 = tk * 64, n0 = tn * 64;
        const int j = tid & 63, kk = tid >> 6; const int c = wmap(mode, n0 + j, N);
#pragma unroll
        for (int i = 0; i < 8; ++i) { const int k = i * 8 + kk; tile[k * 65 + j] = c >= 0 ? W[(size_t)(k0 + k) * N + c] * (gk ? gk[k0 + k] : 1.f) : 0.f; }
        lds_barrier();
        const int nn = tid >> 3, k8 = (tid & 7) * 8; u32x4 o;
        o.x = pk2(tile[(k8 + 0) * 65 + nn], tile[(k8 + 1) * 65 + nn]); o.y = pk2(tile[(k8 + 2) * 65 + nn], tile[(k8 + 3) * 65 + nn]);
        o.z = pk2(tile[(k8 + 4) * 65 + nn], tile[(k8 + 5) * 65 + nn]); o.w = pk2(tile[(k8 + 6) * 65 + nn], tile[(k8 + 7) * 65 + nn]);
        *(u32x4*)(Wt + (size_t)(n0 + nn) * K + k0 + k8) = o;
        lds_barrier();
    }
}
DI void conv_layer_weights(LAS unsigned char* lds, PRef p, int layer, unsigned char* slot, int first = -1, int stride = 0, int mask = 15) {
    if (mask & 1) {
        if (layer < 2) wconv(lds, uni(p.gdn_w_in) + (size_t)layer * 1024 * 3340, 1024, 3340, (bf16_t*)(slot + WO_IN), 3584, 1, uni(p.ln_mix) + layer * 1024, first, stride);
        else wconv(lds, uni(p.swa_w_q) + (size_t)(layer - 2) * 1024 * 1024, 1024, 1024, (bf16_t*)(slot + WO_IN), 1024, 3, uni(p.ln_mix) + layer * 1024, first, stride);
    }
    if (mask & 2) wconv(lds, uni(p.w_out) + (size_t)layer * 1024 * 1024, 1024, 1024, (bf16_t*)(slot + WO_OUT), 1024, 0, nullptr, first, stride);
    if (mask & 4) wconv(lds, uni(p.w_gate_up) + (size_t)layer * 1024 * 5632, 1024, 5632, (bf16_t*)(slot + WO_GU), 5632, 2, uni(p.ln_ffn) + layer * 1024, first, stride);
    if (mask & 8) wconv(lds, uni(p.w_down) + (size_t)layer * DFF * 1024, DFF, 1024, (bf16_t*)(slot + WO_DN), 1024, 0, nullptr, first, stride);
}
DI void norm_rows(const float* x, const float* __restrict__ g, bf16_t* out, int rows) {
    const int lane = tidx() & 63, gw = bidx() * 8 + (tidx() >> 6), nw = gridDim.x * 8;
    for (int r = gw; r < rows; r += nw) {
        const f32x4* xr = (const f32x4*)(x + (size_t)r * 1024); f32x4 v[4]; float ss = 0.f;
#pragma unroll
        for (int i = 0; i < 4; ++i) { v[i] = xr[lane + 64 * i]; ss += v[i][0] * v[i][0] + v[i][1] * v[i][1] + v[i][2] * v[i][2] + v[i][3] * v[i][3]; }
        ss = wave_sum(ss); const float rs = rsqrtf(ss * (1.f / 1024.f) + 1e-6f);
#pragma unroll
        for (int i = 0; i < 4; ++i) { const f32x4 gg = ((const f32x4*)g)[lane + 64 * i]; u32x2 o; o.x = pk2(v[i][0] * rs * gg[0], v[i][1] * rs * gg[1]); o.y = pk2(v[i][2] * rs * gg[2], v[i][3] * rs * gg[3]);
            *(u32x2*)(out + (size_t)r * 1024 + (lane + 64 * i) * 4) = o; }
    }
}
DI void xb_rows(const float* x, bf16_t* out, float* ssq, int rows) {
    const int lane = tidx() & 63, gw = bidx() * 8 + (tidx() >> 6), nw = gridDim.x * 8;
    for (int r = gw; r < rows; r += nw) {
        const f32x4* xr = (const f32x4*)(x + (size_t)r * 1024); f32x4 v[4]; float ss = 0.f;
#pragma unroll
        for (int i = 0; i < 4; ++i) { v[i] = xr[lane + 64 * i]; ss += v[i][0] * v[i][0] + v[i][1] * v[i][1] + v[i][2] * v[i][2] + v[i][3] * v[i][3]; }
        ss = wave_sum(ss);
#pragma unroll
        for (int i = 0; i < 4; ++i) { u32x2 o; o.x = pk2(v[i][0], v[i][1]); o.y = pk2(v[i][2], v[i][3]); *(u32x2*)(out + (size_t)r * 1024 + (lane + 64 * i) * 4) = o; }
        if (lane < 16) ssq[(size_t)r * 16 + lane] = lane == 0 ? ss : 0.f;
    }
}
DI void final_norm(float* x, const float* __restrict__ g, int rows) {
    const int lane = tidx() & 63, gw = bidx() * 8 + (tidx() >> 6), nw = gridDim.x * 8;
    for (int r = gw; r < rows; r += nw) {
        f32x4* xr = (f32x4*)(x + (size_t)r * 1024); f32x4 v[4]; float ss = 0.f;
#pragma unroll
        for (int i = 0; i < 4; ++i) { v[i] = xr[lane + 64 * i]; ss += v[i][0] * v[i][0] + v[i][1] * v[i][1] + v[i][2] * v[i][2] + v[i][3] * v[i][3]; }
        ss = wave_sum(ss); const float rs = rsqrtf(ss * (1.f / 1024.f) + 1e-6f);
#pragma unroll
        for (int i = 0; i < 4; ++i) { const f32x4 gg = ((const f32x4*)g)[lane + 64 * i]; xr[lane + 64 * i] = v[i] * rs * gg; }
    }
}
DI void rope_table(PRef p) {
    float* cs = (float*)(uni(p.ws) + WS_CS);
    for (int idx = bidx() * NT + tidx(); idx < MT * 8; idx += gridDim.x * NT) {
        const int r = idx >> 3, i = idx & 7; const float ang = (float)uni(p.pos)[r] * p.inv[i];
        const double a = (double)ang, k = rint(a * 0.15915494309189535), rr = a - k * 6.283185307179586476925; const double r2 = rr * rr;
        double sn = 1.0 / 51090942171709440000.0, cn = 1.0 / 2432902008176640000.0;
        sn = sn * r2 - 1.0 / 121645100408832000.0; cn = cn * r2 - 1.0 / 6402373705728000.0;
        sn = sn * r2 + 1.0 / 355687428096000.0;    cn = cn * r2 + 1.0 / 20922789888000.0;
        sn = sn * r2 - 1.0 / 1307674368000.0;      cn = cn * r2 - 1.0 / 87178291200.0;
        sn = sn * r2 + 1.0 / 6227020800.0;         cn = cn * r2 + 1.0 / 479001600.0;
        sn = sn * r2 - 1.0 / 39916800.0;           cn = cn * r2 - 1.0 / 3628800.0;
        sn = sn * r2 + 1.0 / 362880.0;             cn = cn * r2 + 1.0 / 40320.0;
        sn = sn * r2 - 1.0 / 5040.0;               cn = cn * r2 - 1.0 / 720.0;
        sn = sn * r2 + 1.0 / 120.0;                cn = cn * r2 + 1.0 / 24.0;
        sn = sn * r2 - 1.0 / 6.0;                  cn = cn * r2 - 0.5;
        sn = sn * r2 + 1.0;                        cn = cn * r2 + 1.0;
        sn = sn * rr;
        cs[(size_t)r * 16 + i] = (float)cn; cs[(size_t)r * 16 + 8 + i] = (float)sn;
    }
}

template <int J, int HF> DI void solve_loadh(f32x4 (&buf)[8], const LAS float* Lz) {
    constexpr int g0 = (((J + 1) >> 2) > HF * 8) ? ((J + 1) >> 2) : HF * 8;
#pragma unroll
    for (int g = g0; g < HF * 8 + 8; ++g) buf[g - HF * 8] = *(const LAS f32x4*)(Lz + J * 64 + 4 * g);
}
template <int J, int HF> DI void solve_applyh(f32x2_t (&r2)[32], const f32x4 (&buf)[8]) {
    constexpr int st = (J + 1 > HF * 32) ? J + 1 : HF * 32;
    const float xj = r2[J >> 1][J & 1]; const f32x2_t x2 = {xj, xj};
    if constexpr ((st & 1) && st < HF * 32 + 32) r2[st >> 1][1] -= buf[(st >> 2) - HF * 8][st & 3] * xj;
#pragma unroll
    for (int pp = (st + 1) >> 1; pp < HF * 16 + 16; ++pp) r2[pp] -= (f32x2_t){buf[((2 * pp) >> 2) - HF * 8][(2 * pp) & 3], buf[((2 * pp + 1) >> 2) - HF * 8][(2 * pp + 1) & 3]} * x2;
}
template <int J> DI void solve_steps(f32x2_t (&r2)[32], f32x4 (&ha)[8], f32x4 (&hb)[8], const LAS float* Lz) {
    solve_loadh<J, 1>(hb, Lz);
    solve_applyh<J, 0>(r2, ha);
    solve_loadh<J + 1, 0>(ha, Lz);
    solve_applyh<J, 1>(r2, hb);
    if constexpr (J + 1 < 63) solve_steps<J + 1>(r2, ha, hb, Lz);
}
DI void gdn_chunk_phase(LAS unsigned char* lds, PRef p, int a) {
    const bf16_t* P1 = (const bf16_t*)(uni(p.ws) + WS_P1); const float* ab = (const float*)(uni(p.ws) + WS_AB);
    const float* convw = uni(p.gdn_conv) + (size_t)a * 4 * 2304; const float* A_log = uni(p.gdn_A_log) + a * 6; const float* dtb = uni(p.gdn_dt_bias) + a * 6;
    bf16_t* QG = (bf16_t*)(uni(p.ws) + WS_QG); bf16_t* WP = (bf16_t*)(uni(p.ws) + WS_WP); bf16_t* KGT = (bf16_t*)(uni(p.ws) + WS_KGT); bf16_t* UT = (bf16_t*)(uni(p.ws) + WS_UT);
    bf16_t* AI = (bf16_t*)(uni(p.ws) + WS_AI); float* GL = (float*)(uni(p.ws) + WS_GL);
    LAS float* RHS = (LAS float*)lds;
    LAS unsigned char* RAW = lds;
    LAS bf16_t* Qb = (LAS bf16_t*)(lds + 65536);
    LAS bf16_t* Kb = (LAS bf16_t*)(lds + 65536 + 17408);
    LAS float* Lm = (LAS float*)(lds + 65536 + 34816);
    LAS float* CW = (LAS float*)(lds + 116736);
    LAS float* gcs = (LAS float*)(lds + 122880);
    u32x4 pr[7]; float pcw[3], pbl = 0.f, pal = 0.f, pAl = 0.f, pdt = 0.f;
#define CH_LOAD(itn) do { const int tid_ = tidx(), h_ = (itn) % 6, cn_ = (itn) / 6, n_ = cn_ & 255, t0_ = cn_ * 64; \
        _Pragma("unroll") for (int i = 0; i < 7; ++i) { const int idx = tid_ + NT * i, rr = idx / 48, pc = idx % 48, sec = pc >> 4, off = (pc & 15) * 8; \
            pr[i] = (u32x4){0u, 0u, 0u, 0u}; if (idx < 67 * 48 && (rr >= 3 || n_ > 0)) pr[i] = *(const u32x4*)(P1 + (size_t)(t0_ - 3 + rr) * 2304 + sec * 768 + h_ * 128 + off); } \
        _Pragma("unroll") for (int i = 0; i < 3; ++i) { const int idx = tid_ + NT * i, j = idx / 384, c = idx % 384, sec = c >> 7; pcw[i] = convw[j * 2304 + sec * 768 + h_ * 128 + (c & 127)]; } \
        if (tid_ < 64) { pbl = ab[(size_t)(t0_ + tid_) * 16 + h_]; pal = ab[(size_t)(t0_ + tid_) * 16 + 6 + h_]; pAl = A_log[h_]; pdt = dtb[h_]; } } while (0)
    if (bidx() < NITEM) CH_LOAD(bidx());
#pragma unroll 1
    for (int it = bidx(); it < NITEM; it += gridDim.x) {
        const int tid = tidx(), lane = tid & 63, wave = tid >> 6;
        const int h = it % 6, cn = it / 6, t0 = cn * 64;
#pragma unroll
        for (int i = 0; i < 7; ++i) { const int idx = tid + NT * i, rr = idx / 48, pc = idx % 48, sec = pc >> 4, off = (pc & 15) * 8; if (idx < 67 * 48) *(LAS u32x4*)(RAW + rr * 784 + sec * 256 + off * 2) = pr[i]; }
#pragma unroll
        for (int i = 0; i < 3; ++i) CW[tid + NT * i] = pcw[i];
        if (tid < 64) {
            const float bl = pbl, al = pal;
            const float beta = __builtin_amdgcn_rcpf(1.f + __expf(-bl)); const float xx = al + pdt, te = __expf(xx);
            const float sp = xx > 20.f ? xx : (te < 0.02f ? te * (1.f - te * (0.5f - 0.33333334f * te)) : __logf(1.f + te));
            float g = -__expf(pAl) * sp;
#pragma unroll
            for (int o = 1; o < 64; o <<= 1) { const float y = shup(g, o); if (lane >= o) g += y; }
            const float glast = __builtin_bit_cast(float, __builtin_amdgcn_readlane(__builtin_bit_cast(int, g), 63));
            gcs[tid] = g; gcs[64 + tid] = beta; gcs[128 + tid] = __expf(g); gcs[192 + tid] = __expf(glast - g);
            if (tid == 63) GL[it] = __expf(g);
        }
        lds_barrier();
        const int t = tid >> 3, part = tid & 7;
        float cq[16], ck[16], cv[16];
#pragma unroll
        for (int sec = 0; sec < 3; ++sec)
#pragma unroll
            for (int hf = 0; hf < 2; ++hf) {
                float acc[8];
#pragma unroll
                for (int e = 0; e < 8; ++e) acc[e] = 0.f;
#pragma unroll
                for (int j = 0; j < 4; ++j) {
                    const u32x4 rw = *(const LAS u32x4*)(RAW + (t + j) * 784 + sec * 256 + (part * 16 + hf * 8) * 2);
                    const f32x4 w0 = *(const LAS f32x4*)(CW + j * 384 + sec * 128 + part * 16 + hf * 8), w1 = *(const LAS f32x4*)(CW + j * 384 + sec * 128 + part * 16 + hf * 8 + 4);
                    acc[0] += w0[0] * bflo(rw.x); acc[1] += w0[1] * bfhi(rw.x); acc[2] += w0[2] * bflo(rw.y); acc[3] += w0[3] * bfhi(rw.y);
                    acc[4] += w1[0] * bflo(rw.z); acc[5] += w1[1] * bfhi(rw.z); acc[6] += w1[2] * bflo(rw.w); acc[7] += w1[3] * bfhi(rw.w);
                }
#pragma unroll
                for (int e = 0; e < 8; ++e) { const float s = siluf(acc[e]); if (sec == 0) cq[hf * 8 + e] = s; else if (sec == 1) ck[hf * 8 + e] = s; else cv[hf * 8 + e] = s; }
            }
        float ssq = 0.f, ssk = 0.f;
#pragma unroll
        for (int e = 0; e < 16; ++e) { ssq += cq[e] * cq[e]; ssk += ck[e] * ck[e]; }
        ssq += shx(ssq, 1); ssq += shx(ssq, 2); ssq += shx(ssq, 4);
        ssk += shx(ssk, 1); ssk += shx(ssk, 2); ssk += shx(ssk, 4);
        const float rq = rsqrtf(ssq + 1e-6f) * 0.08838834764831845f, rk = rsqrtf(ssk + 1e-6f);
        const float gct = gcs[t], bt = gcs[64 + t], egt = gcs[128 + t], gclast = gcs[63];
        lds_barrier();
        {
#pragma unroll
            for (int e = 0; e < 16; ++e) { cq[e] *= rq; ck[e] *= rk; }
            u32x4 w;
            w.x = pk2(cq[0], cq[1]); w.y = pk2(cq[2], cq[3]); w.z = pk2(cq[4], cq[5]); w.w = pk2(cq[6], cq[7]); *(LAS u32x4*)(Qb + t * 136 + part * 16) = w;
            w.x = pk2(cq[8], cq[9]); w.y = pk2(cq[10], cq[11]); w.z = pk2(cq[12], cq[13]); w.w = pk2(cq[14], cq[15]); *(LAS u32x4*)(Qb + t * 136 + part * 16 + 8) = w;
            w.x = pk2(ck[0], ck[1]); w.y = pk2(ck[2], ck[3]); w.z = pk2(ck[4], ck[5]); w.w = pk2(ck[6], ck[7]); *(LAS u32x4*)(Kb + t * 136 + part * 16) = w;
            w.x = pk2(ck[8], ck[9]); w.y = pk2(ck[10], ck[11]); w.z = pk2(ck[12], ck[13]); w.w = pk2(ck[14], ck[15]); *(LAS u32x4*)(Kb + t * 136 + part * 16 + 8) = w;
            const float kbe = bt * egt;
#pragma unroll
            for (int e4 = 0; e4 < 4; ++e4) {
                *(LAS f32x4*)(RHS + t * 256 + part * 16 + e4 * 4) = (f32x4){cv[e4 * 4] * bt, cv[e4 * 4 + 1] * bt, cv[e4 * 4 + 2] * bt, cv[e4 * 4 + 3] * bt};
                *(LAS f32x4*)(RHS + t * 256 + 128 + part * 16 + e4 * 4) = (f32x4){ck[e4 * 4] * kbe, ck[e4 * 4 + 1] * kbe, ck[e4 * 4 + 2] * kbe, ck[e4 * 4 + 3] * kbe};
            }
            bf16_t* qgp = QG + (size_t)(t0 + t) * 768 + h * 128 + 32 * (part >> 1) + 4 * (part & 1);
#pragma unroll
            for (int q4 = 0; q4 < 4; ++q4) { u32x2 o; o.x = pk2(cq[q4 * 4] * egt, cq[q4 * 4 + 1] * egt); o.y = pk2(cq[q4 * 4 + 2] * egt, cq[q4 * 4 + 3] * egt); *(u32x2*)(qgp + 8 * q4) = o; }
        }
        lds_barrier();
        {
#pragma unroll
            for (int i = 0; i < 2; ++i) {
                const int pid = tid + NT * i, d = pid >> 3, s8 = pid & 7, tb = 32 * (s8 >> 2) + 4 * (s8 & 3); float v[8];
#pragma unroll
                for (int e = 0; e < 8; ++e) { const int tk = tb + 16 * (e >> 2) + (e & 3); v[e] = bf2f(Kb[tk * 136 + d]) * gcs[192 + tk]; }
                u32x4 w; w.x = pk2(v[0], v[1]); w.y = pk2(v[2], v[3]); w.z = pk2(v[4], v[5]); w.w = pk2(v[6], v[7]);
                *(u32x4*)(KGT + (size_t)it * 8192 + d * 64 + 8 * s8) = w;
            }
            const int mat = wave >> 2, mi = wave & 3, r16 = lane & 15, q = lane >> 4;
            const LAS bf16_t* Ab = Kb + (16 * mi + r16) * 136 + 8 * q;
            bf16x8 af[4];
#pragma unroll
            for (int ks = 0; ks < 4; ++ks) af[ks] = *(const LAS bf16x8*)(Ab + 32 * ks);
            if (mat == 0) {
#pragma unroll
                for (int ni = 0; ni < 4; ++ni) if (ni <= mi) {
                    const LAS bf16_t* Bb = Kb + (16 * ni + r16) * 136 + 8 * q; f32x4 acc = {0.f, 0.f, 0.f, 0.f};
#pragma unroll
                    for (int ks = 0; ks < 4; ++ks) acc = MFMA16(af[ks], *(const LAS bf16x8*)(Bb + 32 * ks), acc);
                    const int kc = 16 * ni + r16; const float gk = gcs[kc];
                    f32x4 lv4;
#pragma unroll
                    for (int j = 0; j < 4; ++j) { const int c = 16 * mi + 4 * q + j; lv4[j] = (c > kc) ? gcs[64 + c] * acc[j] * __expf(fminf(gcs[c] - gk, 0.f)) : 0.f; }
                    *(LAS f32x4*)(Lm + kc * 64 + 16 * mi + 4 * q) = lv4;
                }
            } else {
#pragma unroll
                for (int ni = 0; ni < 4; ++ni) {
                    f32x4 acc = {0.f, 0.f, 0.f, 0.f}; const int c = 16 * ni + r16;
                    if (ni >= mi) {
                        const LAS bf16_t* Bb = Qb + (16 * ni + r16) * 136 + 8 * q;
#pragma unroll
                        for (int ks = 0; ks < 4; ++ks) acc = MFMA16(af[ks], *(const LAS bf16x8*)(Bb + 32 * ks), acc);
                        const float gcc = gcs[c];
#pragma unroll
                        for (int j = 0; j < 4; ++j) { const int kc = 16 * mi + 4 * q + j; acc[j] = (c >= kc) ? acc[j] * __expf(fminf(gcc - gcs[kc], 0.f)) : 0.f; }
                    }
                    u32x2 w; w.x = pk2(acc[0], acc[1]); w.y = pk2(acc[2], acc[3]);
                    *(u32x2*)(AI + (size_t)it * 4096 + c * 64 + 32 * (mi >> 1) + 8 * q + 4 * (mi & 1)) = w;
                }
            }
        }
        lds_barrier();
        { const int itn = (it + (int)gridDim.x < NITEM) ? it + (int)gridDim.x : it; CH_LOAD(itn); }
        if (tid < 256) {
            const LAS float* Lz = Lm + __builtin_amdgcn_mbcnt_lo(0u, 0u);
            f32x2_t r2[32];
#pragma unroll
            for (int i = 0; i < 32; ++i) r2[i] = (f32x2_t){RHS[(2 * i) * 256 + tid], RHS[(2 * i + 1) * 256 + tid]};
            f32x4 ha[8], hb[8];
            solve_loadh<0, 0>(ha, Lz);
            solve_steps<0>(r2, ha, hb, Lz);
#pragma unroll
            for (int i = 0; i < 32; ++i) { RHS[(2 * i) * 256 + tid] = r2[i][0]; RHS[(2 * i + 1) * 256 + tid] = r2[i][1]; }
        }
        lds_barrier();
        {
            const int dv = tid >> 2, tq = tid & 3; u32x4 w0, w1; float e[16];
#pragma unroll
            for (int i = 0; i < 16; ++i) e[i] = RHS[(tq * 16 + i) * 256 + dv];
            w0.x = pk2(e[0], e[1]); w0.y = pk2(e[2], e[3]); w0.z = pk2(e[4], e[5]); w0.w = pk2(e[6], e[7]);
            w1.x = pk2(e[8], e[9]); w1.y = pk2(e[10], e[11]); w1.z = pk2(e[12], e[13]); w1.w = pk2(e[14], e[15]);
            bf16_t* up = UT + (size_t)it * 8192 + dv * 64 + tq * 16; *(u32x4*)up = w0; *(u32x4*)(up + 8) = w1;
            bf16_t* wp = WP + (size_t)(t0 + t) * 768 + h * 128 + 32 * (part >> 1) + 4 * (part & 1);
#pragma unroll
            for (int q4 = 0; q4 < 4; ++q4) { const f32x4 xv = *(const LAS f32x4*)(RHS + t * 256 + 128 + part * 16 + q4 * 4); u32x2 o; o.x = pk2(xv[0], xv[1]); o.y = pk2(xv[2], xv[3]); *(u32x2*)(wp + 8 * q4) = o; }
        }
        lds_barrier();
    }
#undef CH_LOAD
}

constexpr int SCAN_NBLK = 96, SCAN_BUF = 62464;
DI void scan_step(const LAS unsigned char* cur, f32x4 (&S)[8], const u32x2 (&uu)[4], float gl, bf16_t* op, int r16, int q) {
    bf16x8 Sb[4];
#pragma unroll
    for (int ks = 0; ks < 4; ++ks) Sb[ks] = pack8(S[2 * ks], S[2 * ks + 1]);
    const LAS unsigned char* bw = cur + r16 * 272 + 16 * q;
    const LAS unsigned char* ba = cur + 34816 + r16 * 144 + 16 * q;
#define FADDR(i) ((i) < 16 ? bw + ((i) % 4) * (16 * 272) + ((i) / 4) * 64 : (i) < 32 ? bw + 17408 + (((i) - 16) % 4) * (16 * 272) + (((i) - 16) / 4) * 64 : \
                  (i) < 40 ? ba + (((i) - 32) % 4) * (16 * 144) + (((i) - 32) / 4) * 64 : ba + 9216 + (((i) - 40) % 8) * (16 * 144) + (((i) - 40) / 8) * 64)
    constexpr int RING = 16; bf16x8 fr[RING]; f32x4 a1[4], o[4]; bf16x8 vb[2];
#pragma unroll
    for (int i = 0; i < 4; ++i) { a1[i] = (f32x4){0.f, 0.f, 0.f, 0.f}; o[i] = (f32x4){0.f, 0.f, 0.f, 0.f}; }
    vb[0] = Sb[0]; vb[1] = Sb[0];
#pragma unroll
    for (int i = 0; i < RING; ++i) fr[i] = *(const LAS bf16x8*)FADDR(i);
#pragma unroll
    for (int i = 0; i < 56; ++i) {
        const bf16x8 f = fr[i % RING];
        if (i + RING < 56) fr[i % RING] = *(const LAS bf16x8*)FADDR(i + RING);
        if (i < 16) a1[i % 4] = MFMA16(f, Sb[i / 4], a1[i % 4]);
        else if (i < 32) o[(i - 16) % 4] = MFMA16(f, Sb[(i - 16) / 4], o[(i - 16) % 4]);
        else if (i < 40) o[(i - 32) % 4] = MFMA16(f, vb[(i - 32) / 4], o[(i - 32) % 4]);
        else { const int dt = (i - 40) % 8, k2 = (i - 40) / 8; if (k2 == 0) S[dt] = S[dt] * gl; S[dt] = MFMA16(f, vb[k2], S[dt]); }
        if (i == 15) {
            f32x4 vn[4];
#pragma unroll
            for (int mt = 0; mt < 4; ++mt) vn[mt] = (f32x4){bflo(uu[mt].x), bfhi(uu[mt].x), bflo(uu[mt].y), bfhi(uu[mt].y)} - a1[mt];
            vb[0] = pack8(vn[0], vn[1]); vb[1] = pack8(vn[2], vn[3]);
        }
        __builtin_amdgcn_sched_barrier(0);
    }
#undef FADDR
#pragma unroll
    for (int mt = 0; mt < 4; ++mt) { u32x2 w; w.x = pk2(o[mt][0], o[mt][1]); w.y = pk2(o[mt][2], o[mt][3]); *(u32x2*)(op + 16 * mt) = w; }
}
DI void gdn_scan_phase(LAS unsigned char* lds, PRef p) {
    if (bidx() >= SCAN_NBLK) return;
    const bf16_t* QG = (const bf16_t*)(uni(p.ws) + WS_QG); const bf16_t* WP = (const bf16_t*)(uni(p.ws) + WS_WP); const bf16_t* KGT = (const bf16_t*)(uni(p.ws) + WS_KGT);
    const bf16_t* UT = (const bf16_t*)(uni(p.ws) + WS_UT); const bf16_t* AI = (const bf16_t*)(uni(p.ws) + WS_AI); const float* GL = (const float*)(uni(p.ws) + WS_GL);
    bf16_t* OT = (bf16_t*)(uni(p.ws) + WS_OT);
    const int tid = tidx(), lane = tid & 63, wave = __builtin_amdgcn_readfirstlane(tid >> 6), r16 = lane & 15, q = lane >> 4;
    const int xcd = bidx() & 7, kx = bidx() >> 3, hg = xcd * 3 + (kx >> 2), bh = hg >> 1, b = bh / 6, h = bh % 6, dv0 = ((hg & 1) * 4 + (kx & 3)) * 16;
    const size_t it0 = (size_t)(b * 256) * 6 + h, tok0 = (size_t)(b * 256) * 64;
    if (wave == 0) {
        f32x4 S[8];
#pragma unroll
        for (int i = 0; i < 8; ++i) S[i] = (f32x4){0.f, 0.f, 0.f, 0.f};
        u32x2 ua[4], ub[4], uc[4], ud[4]; float gla, glb, glc, gld;
        const bf16_t* up = UT + it0 * 8192 + (size_t)(dv0 + r16) * 64 + 4 * q;
        bf16_t* op = OT + it0 * 8192 + (size_t)(dv0 + r16) * 64 + 4 * q;
        const float* glp = GL + it0; const int zdiv = tidx() >> 20;
#define SCAN_LOADU(u, g, nn) do { const size_t o_ = (size_t)min((nn), 255) * (6 * 8192); \
        u[0] = *(const u32x2*)(up + o_); u[1] = *(const u32x2*)(up + o_ + 16); u[2] = *(const u32x2*)(up + o_ + 32); u[3] = *(const u32x2*)(up + o_ + 48); g = glp[min((nn), 255) * 6 + zdiv]; } while (0)
        SCAN_LOADU(ua, gla, 0); SCAN_LOADU(ub, glb, 1); SCAN_LOADU(uc, glc, 2); SCAN_LOADU(ud, gld, 3);
        lds_barrier();
#pragma unroll 1
        for (int n = 0; n < 256; n += 4) {
            scan_step(lds, S, ua, gla, op + (size_t)n * (6 * 8192), r16, q);
            SCAN_LOADU(ua, gla, n + 4);
            lds_barrier();
            scan_step(lds + SCAN_BUF, S, ub, glb, op + (size_t)(n + 1) * (6 * 8192), r16, q);
            SCAN_LOADU(ub, glb, n + 5);
            lds_barrier();
            scan_step(lds, S, uc, glc, op + (size_t)(n + 2) * (6 * 8192), r16, q);
            SCAN_LOADU(uc, glc, n + 6);
            lds_barrier();
            scan_step(lds + SCAN_BUF, S, ud, gld, op + (size_t)(n + 3) * (6 * 8192), r16, q);
            SCAN_LOADU(ud, gld, n + 7);
            lds_barrier();
        }
#undef SCAN_LOADU
    } else {
        const bf16_t* src; size_t sstride; int jsrc, dst, jdst;
        if (wave <= 4) { const int t2 = (tid - 64) & 127, row = t2 >> 4, pc = t2 & 15; const bool isq = wave >= 3;
            src = (isq ? QG : WP) + (tok0 + row) * 768 + h * 128 + pc * 8; sstride = 64 * 768; jsrc = 8 * 768; dst = (isq ? 17408 : 0) + row * 272 + pc * 16; jdst = 8 * 272; }
        else if (wave == 5) { const int t2 = lane; src = AI + it0 * 4096 + t2 * 8; sstride = 6 * 4096; jsrc = 512; dst = 34816 + (t2 >> 3) * 144 + (t2 & 7) * 16; jdst = 8 * 144; }
        else { const int t2 = (tid - 384) & 127; src = KGT + it0 * 8192 + t2 * 8; sstride = 6 * 8192; jsrc = 1024; dst = 44032 + (t2 >> 3) * 144 + (t2 & 7) * 16; jdst = 16 * 144; }
        u32x4 r0[8], r1[8], r2[8], r3[8];
#define SCAN_LOAD(r, nn) do { const bf16_t* s_ = src + (size_t)min((nn), 255) * sstride; \
        _Pragma("unroll") for (int j = 0; j < 8; ++j) r[j] = *(const u32x4*)(s_ + (size_t)j * jsrc); } while (0)
#define SCAN_STORE(r, bufp) do { LAS unsigned char* b_ = (bufp) + dst; \
        _Pragma("unroll") for (int j = 0; j < 8; ++j) *(LAS u32x4*)(b_ + j * jdst) = r[j]; } while (0)
        SCAN_LOAD(r0, 0); SCAN_LOAD(r1, 1); SCAN_LOAD(r2, 2); SCAN_LOAD(r3, 3);
        SCAN_STORE(r0, lds); SCAN_LOAD(r0, 4);
        lds_barrier();
#pragma unroll 1
        for (int n = 0; n < 256; n += 4) {
            SCAN_STORE(r1, lds + SCAN_BUF); SCAN_LOAD(r1, n + 5);
            lds_barrier();
            SCAN_STORE(r2, lds); SCAN_LOAD(r2, n + 6);
            lds_barrier();
            SCAN_STORE(r3, lds + SCAN_BUF); SCAN_LOAD(r3, n + 7);
            lds_barrier();
            SCAN_STORE(r0, lds); SCAN_LOAD(r0, n + 8);
            lds_barrier();
        }
#undef SCAN_LOAD
#undef SCAN_STORE
    }
}

DI void gdn_gate_phase(LAS unsigned char* lds, PRef p, int a) {
    const bf16_t* OT = (const bf16_t*)(uni(p.ws) + WS_OT); const bf16_t* P2 = (const bf16_t*)(uni(p.ws) + WS_P2); bf16_t* MIX = (bf16_t*)(uni(p.ws) + WS_MIX);
    const float* gn = uni(p.gdn_norm) + a * 128; LAS bf16_t* T = (LAS bf16_t*)lds;
    const int tid = tidx(), t = tid >> 3, part = tid & 7;
    for (int it = bidx(); it < NITEM; it += gridDim.x) {
        const int h = it % 6, cn = it / 6, t0 = cn * 64;
#pragma unroll
        for (int i = 0; i < 2; ++i) { const int id = tid + NT * i, row = id >> 3, pc = id & 7; *(LAS u32x4*)(T + row * 72 + pc * 8) = *(const u32x4*)(OT + (size_t)it * 8192 + row * 64 + pc * 8); }
        lds_barrier();
        float o[16]; float ss = 0.f;
#pragma unroll
        for (int e = 0; e < 16; ++e) { o[e] = bf2f(T[(part * 16 + e) * 72 + t]); ss += o[e] * o[e]; }
        ss += shx(ss, 1); ss += shx(ss, 2); ss += shx(ss, 4);
        const float rs = rsqrtf(ss * (1.f / 128.f) + 1e-6f);
        const bf16_t* zp = P2 + (size_t)(t0 + t) * 1024 + h * 128 + part * 16; const u32x4 z0 = *(const u32x4*)zp, z1 = *(const u32x4*)(zp + 8);
        float z[16] = {bflo(z0.x), bfhi(z0.x), bflo(z0.y), bfhi(z0.y), bflo(z0.z), bfhi(z0.z), bflo(z0.w), bfhi(z0.w), bflo(z1.x), bfhi(z1.x), bflo(z1.y), bfhi(z1.y), bflo(z1.z), bfhi(z1.z), bflo(z1.w), bfhi(z1.w)};
        float r[16];
#pragma unroll
        for (int e = 0; e < 16; ++e) r[e] = o[e] * rs * gn[part * 16 + e] * siluf(z[e]);
        u32x4 w0, w1; w0.x = pk2(r[0], r[1]); w0.y = pk2(r[2], r[3]); w0.z = pk2(r[4], r[5]); w0.w = pk2(r[6], r[7]);
        w1.x = pk2(r[8], r[9]); w1.y = pk2(r[10], r[11]); w1.z = pk2(r[12], r[13]); w1.w = pk2(r[14], r[15]);
        bf16_t* mp = MIX + (size_t)(t0 + t) * 1024 + h * 128 + part * 16; *(u32x4*)mp = w0; *(u32x4*)(mp + 8) = w1;
        lds_barrier();
    }
}

template <int MODE> DI void attn_phase(LAS unsigned char* lds, PRef p, int layer, int first = -1, int stride = 0) {
    LAS bf16_t* Ks = (LAS bf16_t*)lds;
    LAS bf16_t* Vt = (LAS bf16_t*)(lds + 36864);
    const bf16_t* Qb = (const bf16_t*)(uni(p.ws) + WS_P2); bf16_t* MIX = (bf16_t*)(uni(p.ws) + WS_MIX);
    const bf16_t* MKV = (const bf16_t*)(uni(p.ws) + WS_MKV); const bf16_t* KV = (const bf16_t*)(uni(p.ws) + WS_KV);
    const int tid = tidx(), lane = tid & 63, wave = tid >> 6, r16 = lane & 15, q = lane >> 4;
    const int nitems = MODE == 0 ? 256 : 512;
    if (first < 0) { first = bidx(); stride = gridDim.x; }
#pragma unroll 1
    for (int it = first; it < nitems; it += stride) {
        int b, hh, tb; size_t tok0;
        if (MODE == 0) { b = it >> 7; hh = (it >> 5) & 3; tb = it & 31; tok0 = (size_t)b * SEQ + tb * 512; }
        else { b = it >> 8; hh = (it >> 7) & 1; tb = it & 127; tok0 = (size_t)b * SEQ + tb * 128; }
#pragma unroll 1
        for (int i = 0; i < 4; ++i) {
            const int id = tid + NT * i, rr = id >> 3, pc = id & 7; u32x4 kv = {0u, 0u, 0u, 0u}, vv = {0u, 0u, 0u, 0u};
            if (MODE == 0) { const bf16_t* kp = MKV + (size_t)(b * 256 + rr) * 2048 + layer * 512 + hh * 64 + pc * 8; kv = *(const u32x4*)kp; vv = *(const u32x4*)(kp + 256); }
            else if (tb > 0 || rr >= 128) { const bf16_t* kp = KV + (tok0 - 128 + rr) * 256 + hh * 64 + pc * 8; kv = *(const u32x4*)kp; vv = *(const u32x4*)(kp + 128); }
            *(LAS u32x4*)(Ks + rr * 72 + pc * 8) = kv;
            LAS bf16_t* vp = Vt + (pc * 8) * 264 + tslot(rr);
            vp[0] = (bf16_t)(vv.x & 0xffffu); vp[264] = (bf16_t)(vv.x >> 16); vp[2 * 264] = (bf16_t)(vv.y & 0xffffu); vp[3 * 264] = (bf16_t)(vv.y >> 16);
            vp[4 * 264] = (bf16_t)(vv.z & 0xffffu); vp[5 * 264] = (bf16_t)(vv.z >> 16); vp[6 * 264] = (bf16_t)(vv.w & 0xffffu); vp[7 * 264] = (bf16_t)(vv.w >> 16);
        }
        lds_barrier();
        const int npass = MODE == 0 ? 32 : 48;
#pragma unroll 1
        for (int ps = wave; ps < npass; ps += 8) {
            int rt, colbase; float sink = 0.f;
            if (MODE == 0) { rt = ps; colbase = 768 + hh * 64; }
            else { const int hq = hh * 6 + (ps >> 3); rt = ps & 7; colbase = hq * 64; sink = uni(p.swa_sinks)[(layer - 2) * 12 + hq]; }
            const size_t tok = tok0 + 16 * rt + r16;
            const bf16_t* qp = Qb + tok * 1024 + colbase + 8 * q;
            const bf16x8 qf0 = *(const bf16x8*)qp, qf1 = *(const bf16x8*)(qp + 32);
            float m = MODE == 1 ? sink : -INFINITY, l = (MODE == 1 && q == 0) ? 1.f : 0.f;
            f32x4 ot[4];
#pragma unroll
            for (int dt = 0; dt < 4; ++dt) ot[dt] = (f32x4){0.f, 0.f, 0.f, 0.f};
            int kk0 = 0, kk1 = 7;
            if (MODE == 1) { kk0 = rt >> 1; if (tb == 0 && kk0 < 4) kk0 = 4; kk1 = (16 * rt + 143) >> 5; }
#pragma unroll 1
            for (int kk = kk0; kk <= kk1; ++kk) {
                const LAS bf16_t* kr = Ks + (32 * kk + r16) * 72 + 8 * q;
                f32x4 s0 = {0.f, 0.f, 0.f, 0.f}, s1 = {0.f, 0.f, 0.f, 0.f};
                s0 = MFMA16(*(const LAS bf16x8*)kr, qf0, s0); s0 = MFMA16(*(const LAS bf16x8*)(kr + 32), qf1, s0);
                s1 = MFMA16(*(const LAS bf16x8*)(kr + 16 * 72), qf0, s1); s1 = MFMA16(*(const LAS bf16x8*)(kr + 16 * 72 + 32), qf1, s1);
                if (MODE == 1) {
#pragma unroll
                    for (int j = 0; j < 4; ++j) { const int d0 = 16 * rt + r16 + 128 - (32 * kk + 4 * q + j), d1 = d0 - 16;
                        if (d0 < 0 || d0 >= 128) s0[j] = -INFINITY; if (d1 < 0 || d1 >= 128) s1[j] = -INFINITY; }
                }
                float gm = fmaxf(fmaxf(fmaxf(s0[0], s0[1]), fmaxf(s0[2], s0[3])), fmaxf(fmaxf(s1[0], s1[1]), fmaxf(s1[2], s1[3])));
                gm = fmaxf(gm, shx(gm, 16)); gm = fmaxf(gm, shx(gm, 32));
                const float mn = fmaxf(m, gm), sc = __expf(m - mn); m = mn; l *= sc;
#pragma unroll
                for (int dt = 0; dt < 4; ++dt) ot[dt] = ot[dt] * sc;
#pragma unroll
                for (int j = 0; j < 4; ++j) { s0[j] = __expf(s0[j] - mn); s1[j] = __expf(s1[j] - mn); l += s0[j] + s1[j]; }
                const bf16x8 pb = pack8(s0, s1);
#pragma unroll
                for (int dt = 0; dt < 4; ++dt) ot[dt] = MFMA16(*(const LAS bf16x8*)(Vt + (16 * dt + r16) * 264 + 32 * kk + 8 * q), pb, ot[dt]);
            }
            l += shx(l, 16); l += shx(l, 32);
            const float inv = 1.f / l; bf16_t* op = MIX + tok * 1024 + colbase + 4 * q;
#pragma unroll
            for (int dt = 0; dt < 4; ++dt) { u32x2 w; w.x = pk2(ot[dt][0] * inv, ot[dt][1] * inv); w.y = pk2(ot[dt][2] * inv, ot[dt][3] * inv); *(u32x2*)(op + 16 * dt) = w; }
        }
        lds_barrier();
    }
}

constexpr int PARAM_OFF = 131072;
DI void grid_bar(unsigned* bar, unsigned gen) {
    __syncthreads();
    if (threadIdx.x == 0) {
        __builtin_amdgcn_fence(__ATOMIC_RELEASE, "agent");
        const unsigned g = blockIdx.x & 7u, ngrp = (gridDim.x + 7u - g) >> 3;
        const unsigned old = __hip_atomic_fetch_add(bar + 64 + 64 * g, 1u, __ATOMIC_RELAXED, __HIP_MEMORY_SCOPE_AGENT);
        if (old + 1u == gen * ngrp) __hip_atomic_fetch_add(bar, 1u, __ATOMIC_RELAXED, __HIP_MEMORY_SCOPE_AGENT);
        const unsigned target = gen * (gridDim.x < 8u ? gridDim.x : 8u);
        while (__hip_atomic_load(bar, __ATOMIC_RELAXED, __HIP_MEMORY_SCOPE_AGENT) < target) __builtin_amdgcn_s_sleep(1);
        __builtin_amdgcn_fence(__ATOMIC_ACQUIRE, "agent");
    }
    __syncthreads();
}
enum { K_P0 = 0, K_GEMM, K_CHUNK, K_SCAN, K_GATE, K_ATTN, K_NORMFFN, K_POST, K_FINAL, K_NOP };

DI void gemm_step(LAS unsigned char* lds, PRef p, int gid, int layer) {
    unsigned char* ws = uni(p.ws); unsigned char* slot = ws + WS_WA0 + (size_t)(layer & 1) * WSLOT;
    const bf16_t* A = (const bf16_t*)(ws + WS_H); const bf16_t* Bt = (const bf16_t*)(slot + WO_IN); int M = MT, N = 1024, K = 1024;
    Epi E{0, 0, nullptr, nullptr, nullptr, nullptr, (const float*)(ws + WS_CS), (float*)(ws + WS_SSQ)};
    if (gid == 0) { A = (const bf16_t*)(ws + WS_MEMN); Bt = (const bf16_t*)(ws + WS_WMKV); M = 512; N = 2048; E.mode = 0; E.ldc = 2048; E.o0 = (bf16_t*)(ws + WS_MKV); }
    else if (gid == 1) { N = 3584; E.mode = 1; E.o0 = (bf16_t*)(ws + WS_P1); E.o1 = (bf16_t*)(ws + WS_P2); E.f0 = (float*)(ws + WS_AB); }
    else if (gid == 2) { E.mode = 2; E.o0 = (bf16_t*)(ws + WS_P2); }
    else if (gid == 3) { Bt = (const bf16_t*)(ws + WS_WKV); N = 256; E.mode = 3; E.o0 = (bf16_t*)(ws + WS_KV); }
    else if (gid == 4) { A = (const bf16_t*)(ws + WS_MIX); Bt = (const bf16_t*)(slot + WO_OUT); E.mode = 4; E.f0 = uni(p.out); E.base = layer == 0 ? uni(p.x) : uni(p.out); E.o0 = (bf16_t*)(ws + WS_H); }
    else if (gid == 5) { Bt = (const bf16_t*)(slot + WO_GU); N = 5632; E.mode = 5; E.o0 = (bf16_t*)(ws + WS_ACT); }
    else { A = (const bf16_t*)(ws + WS_ACT); Bt = (const bf16_t*)(slot + WO_DN); K = DFF; E.mode = 4; E.f0 = uni(p.out); E.base = uni(p.out); E.o0 = (bf16_t*)(ws + WS_H); }
    E.o0 = uni(E.o0); E.o1 = uni(E.o1); E.f0 = uni(E.f0); E.base = uni(E.base); E.cs = uni(E.cs); E.ssq = uni(E.ssq);
    run_gemm(lds, uni(A), uni(Bt), M, N, K, E);
}

__global__ void __launch_bounds__(NT, 2) yoco_fwd(Params pin) {
    extern __shared__ __attribute__((aligned(16))) unsigned char lds_raw[];
    LAS unsigned char* lds = (LAS unsigned char*)lds_raw;
    cg::grid_group grid = cg::this_grid();
    if (blockIdx.x == 0) { ((unsigned*)pin.ws)[threadIdx.x] = 0u; ((unsigned*)pin.ws)[threadIdx.x + NT] = 0u; }
    { const unsigned* src = (const unsigned*)&pin; if (tidx() < sizeof(Params) / 4) ((LAS unsigned*)(lds + PARAM_OFF))[tidx()] = src[tidx()]; }
    __syncthreads();
#define PP pin
    {
        PRef p = PP; unsigned char* ws = uni(p.ws);
        conv_layer_weights(lds, p, 0, ws + WS_WA0, -1, 0, 3);
        wconv(lds, uni(p.w_kv), 1024, 256, (bf16_t*)(ws + WS_WKV), 256, 3, uni(p.ln_kv));
#pragma unroll 1
        for (int l = 0; l < 4; ++l) wconv(lds, uni(p.w_mem_kv) + (size_t)l * 1024 * 512, 1024, 512, (bf16_t*)(ws + WS_WMKV) + (size_t)l * 512 * 1024, 512, 0);
        rope_table(p);
        norm_rows(uni(p.mem), uni(p.ln_mem), (bf16_t*)(ws + WS_MEMN), 512);
        xb_rows(uni(p.x), (bf16_t*)(ws + WS_H), (float*)(ws + WS_SSQ), MT);
        grid.sync();
    }
    constexpr int NSTEP = 14 + 10;
#pragma unroll 1
    for (int s = 0; s < NSTEP; ++s) {
        int kind, layer, gid = 0;
        if (s < 14) { const int k = s % 7; layer = s / 7;
            kind = k == 0 ? K_GEMM : k == 1 ? K_CHUNK : k == 2 ? K_SCAN : k == 3 ? K_GATE : K_GEMM;
            gid = k == 0 ? 1 : k == 4 ? 4 : k == 5 ? 5 : 6; }
        else { const int t = s - 14, k = t % 5; layer = 2 + t / 5;
            kind = k == 1 ? K_ATTN : K_GEMM;
            gid = k == 0 ? 2 : k == 2 ? 4 : k == 3 ? 5 : 6; }
        if (kind == K_GEMM) {
            int g = (s == 0) ? 0 : gid;
            for (;;) { gemm_step(lds, PP, g, layer); if (g == 0) g = gid; else if (g == 2 && layer == 2) g = 3; else break; }
        }
        else if (kind == K_CHUNK) gdn_chunk_phase(lds, PP, layer);
        else if (kind == K_SCAN) { gdn_scan_phase(lds, PP);
            if (bidx() >= SCAN_NBLK) {
                const int f = bidx() - SCAN_NBLK, st = gridDim.x - SCAN_NBLK;
                attn_phase<0>(lds, PP, layer, f, st);
                PRef p = PP;
                if (layer == 0) { conv_layer_weights(lds, p, 0, uni(p.ws) + WS_WA0, f, st, 12); conv_layer_weights(lds, p, 1, uni(p.ws) + WS_WA0 + WSLOT, f, st); }
                else conv_layer_weights(lds, p, 2, uni(p.ws) + WS_WA0, f, st); } }
        else if (kind == K_GATE) gdn_gate_phase(lds, PP, layer);
        else { attn_phase<1>(lds, PP, layer); attn_phase<0>(lds, PP, layer);
            if (layer == 2) { PRef p = PP; conv_layer_weights(lds, p, 3, uni(p.ws) + WS_WA0 + WSLOT); } }
        grid_bar((unsigned*)pin.ws, (unsigned)(s + 1));
    }
    { PRef p = PP; final_norm(uni(p.out), uni(p.ln_final), MT); }
#undef PP
}

extern "C" void kernel_launch(void* const* d_in, const int* in_sizes, int n_in, void* d_out, int out_size, void* d_ws, size_t ws_size, hipStream_t stream) {
    static int grid = 0;
    if (grid == 0) {
        if (n_in != 20 || out_size != MT * DMODEL || ws_size < WS_END) { fprintf(stderr, "kernel_launch: unexpected shapes (n_in %d, out %d, ws %zu)\n", n_in, out_size, ws_size); grid = -1; return; }
        int dev = 0, cus = 0, per_cu = 0;
        (void)hipGetDevice(&dev); (void)hipDeviceGetAttribute(&cus, hipDeviceAttributeMultiprocessorCount, dev);
        if (hipFuncSetAttribute((const void*)yoco_fwd, hipFuncAttributeMaxDynamicSharedMemorySize, LDS_BYTES) != hipSuccess) { fprintf(stderr, "kernel_launch: hipFuncSetAttribute failed\n"); grid = -1; return; }
        (void)hipOccupancyMaxActiveBlocksPerMultiprocessor(&per_cu, (const void*)yoco_fwd, NT, LDS_BYTES);
        (void)hipGetLastError();
        if (per_cu < 1) fprintf(stderr, "kernel_launch: occupancy query says %d blocks/CU\n", per_cu);
        grid = cus > 0 ? cus : 256;
    }
    if (grid < 0) return;
    Params p{};
    p.x = (const float*)d_in[0]; p.mem = (const float*)d_in[1]; p.pos = (const int*)d_in[2]; p.ln_mix = (const float*)d_in[3]; p.ln_ffn = (const float*)d_in[4]; p.ln_mem = (const float*)d_in[5];
    p.w_mem_kv = (const float*)d_in[6]; p.w_out = (const float*)d_in[7]; p.w_gate_up = (const float*)d_in[8]; p.w_down = (const float*)d_in[9]; p.gdn_w_in = (const float*)d_in[10];
    p.gdn_conv = (const float*)d_in[11]; p.gdn_A_log = (const float*)d_in[12]; p.gdn_dt_bias = (const float*)d_in[13]; p.gdn_norm = (const float*)d_in[14]; p.swa_w_q = (const float*)d_in[15];
    p.swa_sinks = (const float*)d_in[16]; p.ln_kv = (const float*)d_in[17]; p.w_kv = (const float*)d_in[18]; p.ln_final = (const float*)d_in[19];
    p.out = (float*)d_out; p.ws = (unsigned char*)d_ws;
    for (int i = 0; i < 8; ++i) p.inv[i] = (float)pow(500000.0, -(double)(2 * i) / 16.0);
    void* args[] = {&p};
    hipError_t e = hipLaunchCooperativeKernel((const void*)yoco_fwd, dim3(grid), dim3(NT), args, LDS_BYTES, stream);
    if (e != hipSuccess) fprintf(stderr, "kernel_launch: cooperative launch failed: %s (grid %d)\n", hipGetErrorString(e), grid);
}
```

```cpp
#include <hip/hip_runtime.h>
#include <hip/hip_cooperative_groups.h>
#include <cstdio>
#include <cstdint>
#include <cmath>
namespace cg = cooperative_groups;
__device__ __forceinline__ int tidx() { int t = threadIdx.x; asm volatile("" : "+v"(t)); return t; }
__device__ __forceinline__ int bidx() { int b = blockIdx.x; asm volatile("" : "+s"(b)); return b; }
namespace pg8 {
#define PG8_LAS __attribute__((address_space(3)))
typedef unsigned short bf16_t;
typedef short bf16x8 __attribute__((ext_vector_type(8)));
typedef float f32x4 __attribute__((ext_vector_type(4)));
typedef unsigned u32x4 __attribute__((ext_vector_type(4)));
constexpr int BM = 256, BK = 64, HALF = 128, HTB = HALF * BK * 2  , STAGE_BYTES = 8 * HTB, NXCD = 8, WGM = 8;

__host__ __device__ __forceinline__ int lds_byte(int r, int c) { const int st = (r >> 4) * 2 + (c >> 5), rr = r & 15, cc = c & 31, ob = rr * 64 + cc * 2; return st * 1024 + (ob ^ (((ob >> 9) & 1) << 5)); }
__host__ __device__ __forceinline__ void stage_rc(int b, int& R, int& C) { const int st = b / 1024, sb = b % 1024, swz = sb ^ (((sb >> 9) & 1) << 5); R = (st >> 1) * 16 + swz / 64; C = (st & 1) * 32 + (swz % 64) / 2; }
__host__ __device__ __forceinline__ int perm32(int rho) { const int n = rho >> 4, i = rho & 15; return 8 * (i >> 2) + 4 * n + (i & 3); }

struct Unit { int pm, pn; };
struct Gemm { const bf16_t* A; const bf16_t* Bt; int M, N, K; };

struct StaticOrder {
    int nM, nN, nwg, G, c;
    __host__ __device__ void init(int M, int N, int G_, int c_) { nM = M / BM; nN = N / BM; nwg = nM * nN; G = G_; c = c_; }
    __host__ __device__ bool next(int i, Unit& u) const {
        const long L = (long)i * G + c; if (L >= nwg) return false;
        int wgid = (int)L; { const int q = nwg / NXCD, r = nwg % NXCD, xcd = wgid % NXCD, off = wgid / NXCD; wgid = (xcd < r ? xcd * (q + 1) : r * (q + 1) + (xcd - r) * q) + off; }
        const int nig = WGM * nN, gid = wgid / nig, fm = gid * WGM, gsz = (nM - fm) < WGM ? (nM - fm) : WGM;
        u.pm = fm + ((wgid % nig) % gsz); u.pn = (wgid % nig) / gsz; return true;
    }
    __device__ __forceinline__ void a_ready(const Unit&) const {}
    __device__ __forceinline__ void done(const Unit&) const {}
};
template <class Epi, class Sched, bool ALIGN_EPI = false, bool SP2 = false>
__device__ __forceinline__ void gemm_phase(PG8_LAS unsigned char* lds, const Gemm g, const Sched& S, const Epi& E) {
    const int tid = tidx(), wid = __builtin_amdgcn_readfirstlane(tid >> 6), lane = tid & 63, wr = wid >> 2, wc = wid & 3, fr = lane & 15, fq = lane >> 4;
    const int K = g.K, nt = K / BK;
    unsigned voffA[2], voffB[2];
#pragma unroll
    for (int i = 0; i < 2; ++i) { int R, C; stage_rc(tid * 16 + i * 8192, R, C); const int Rb = Epi::PERM ? ((R & ~31) + perm32(R & 31)) : R;
        voffA[i] = (unsigned)(R * K + C) * 2u; voffB[i] = (unsigned)(Rb * K + C) * 2u; }
    const size_t kstep = (size_t)(BK * 2);
    const size_t hstep = (size_t)HALF * K * 2;
    const size_t tstep = 2 * hstep;
    const unsigned ldsw = (unsigned)wid * 1024u;
    const int aoff = lds_byte(wr * 64 + fr, fq * 8), boff = lds_byte(wc * 32 + fr, fq * 8);
#define PG8_SA(b, h) (((b) * 2 + (h)) * HTB)
#define PG8_SB(b, h) ((4 + (b) * 2 + (h)) * HTB)
#define PG8_STAGE(bufoff, gbase, voff) do { _Pragma("unroll") for (int _i = 0; _i < 2; ++_i) \
        __builtin_amdgcn_global_load_lds((const unsigned*)((const char*)(gbase) + (voff)[_i]), (PG8_LAS unsigned*)(lds + (bufoff) + ldsw + _i * 8192), 16, 0, 0); } while (0)
#define PG8_LDA(dst, b, h) do { _Pragma("unroll") for (int m = 0; m < 4; ++m) _Pragma("unroll") for (int k = 0; k < 2; ++k) dst[m][k] = *(const PG8_LAS bf16x8*)(lds + PG8_SA(b, h) + aoff + m * 2048 + k * 1024); } while (0)
#define PG8_LDB(dst, b, h) do { _Pragma("unroll") for (int n = 0; n < 2; ++n) _Pragma("unroll") for (int k = 0; k < 2; ++k) dst[n][k] = *(const PG8_LAS bf16x8*)(lds + PG8_SB(b, h) + boff + n * 2048 + k * 1024); } while (0)
#define PG8_MMA(ai, bj, At, Bt) do { __builtin_amdgcn_s_setprio(1); _Pragma("unroll") for (int m = 0; m < 4; ++m) _Pragma("unroll") for (int n = 0; n < 2; ++n) _Pragma("unroll") for (int k = 0; k < 2; ++k) \
        acc[ai][bj][m][n] = __builtin_amdgcn_mfma_f32_16x16x32_bf16(Bt[n][k], At[m][k], acc[ai][bj][m][n], 0, 0, 0); __builtin_amdgcn_s_setprio(0); } while (0)
#define PG8_WAIT_V(n) asm volatile("s_waitcnt vmcnt(" #n ")" ::: "memory")
#define PG8_WAIT_L(n) asm volatile("s_waitcnt lgkmcnt(" #n ")" ::: "memory")
#define PG8_BAR __builtin_amdgcn_s_barrier()
#define PG8_SCHED __builtin_amdgcn_sched_barrier(0)
    Unit cur, nxt; int ui = 0;
    if (!S.next(0, cur)) return;
    f32x4 acc[2][2][4][2];
#pragma unroll
    for (int a = 0; a < 2; ++a)
#pragma unroll
        for (int b = 0; b < 2; ++b)
#pragma unroll
            for (int m = 0; m < 4; ++m)
#pragma unroll
                for (int n = 0; n < 2; ++n) acc[a][b][m][n] = (f32x4){0.f, 0.f, 0.f, 0.f};
    bf16x8 At[4][2], B0[2][2], B1[2][2];
    const char* cA = (const char*)g.A + (size_t)cur.pm * tstep; const char* cB = (const char*)g.Bt + (size_t)cur.pn * tstep;
    S.a_ready(cur);
    if constexpr (SP2) {
        PG8_STAGE(PG8_SB(0, 0), cB, voffB); PG8_STAGE(PG8_SB(0, 1), cB + hstep, voffB); PG8_STAGE(PG8_SA(0, 0), cA, voffA); PG8_STAGE(PG8_SA(0, 1), cA + hstep, voffA);
        if (wr == 1) PG8_BAR;
        PG8_WAIT_V(2); PG8_BAR;
        PG8_STAGE(PG8_SB(1, 0), cB + kstep, voffB); PG8_STAGE(PG8_SA(1, 0), cA + kstep, voffA); PG8_STAGE(PG8_SB(1, 1), cB + hstep + kstep, voffB);
        PG8_WAIT_V(6); PG8_BAR;
    } else {
        PG8_STAGE(PG8_SB(0, 0), cB, voffB); PG8_STAGE(PG8_SA(0, 0), cA, voffA); PG8_STAGE(PG8_SB(0, 1), cB + hstep, voffB); PG8_STAGE(PG8_SA(0, 1), cA + hstep, voffA);
        if (wr == 1) PG8_BAR;
        PG8_WAIT_V(4); PG8_BAR;
        PG8_STAGE(PG8_SB(1, 0), cB + kstep, voffB); PG8_STAGE(PG8_SA(1, 0), cA + kstep, voffA); PG8_STAGE(PG8_SB(1, 1), cB + hstep + kstep, voffB);
        PG8_WAIT_V(6); PG8_BAR;
    }
    for (;;) {
        const bool has_next = S.next(ui + 1, nxt);
        const char* nA = has_next ? (const char*)g.A + (size_t)nxt.pm * tstep : cA; const char* nB = has_next ? (const char*)g.Bt + (size_t)nxt.pn * tstep : cB;
        for (int t = 0; t < nt; t += 2) {
            const bool last = (t == nt - 2);
            const char* a1 = cA + (size_t)(t + 1) * kstep;
            const char* a2 = last ? nA : cA + (size_t)(t + 2) * kstep; const char* b2 = last ? nB : cB + (size_t)(t + 2) * kstep;
            const char* a3 = a2 + kstep; const char* b3 = b2 + kstep;
            if (last && has_next) S.a_ready(nxt);
            if constexpr (SP2) {
            PG8_LDB(B0, 0, 0); PG8_LDB(B1, 0, 1); PG8_SCHED; PG8_LDA(At, 0, 0); PG8_STAGE(PG8_SA(1, 1), a1 + hstep, voffA);
            PG8_WAIT_V(8); PG8_WAIT_L(0); PG8_BAR; PG8_MMA(0, 0, At, B0); PG8_MMA(0, 1, At, B1); PG8_BAR; PG8_SCHED;
            PG8_LDA(At, 0, 1); PG8_STAGE(PG8_SB(0, 0), b2, voffB); PG8_STAGE(PG8_SB(0, 1), b2 + hstep, voffB); PG8_STAGE(PG8_SA(0, 0), a2, voffA);
            PG8_WAIT_V(8); PG8_WAIT_L(0); PG8_BAR; PG8_MMA(1, 0, At, B0); PG8_MMA(1, 1, At, B1); PG8_BAR; PG8_SCHED;
            PG8_LDB(B0, 1, 0); PG8_LDB(B1, 1, 1); PG8_SCHED; PG8_LDA(At, 1, 0); PG8_STAGE(PG8_SA(0, 1), a2 + hstep, voffA);
            PG8_WAIT_V(8); PG8_WAIT_L(0); PG8_BAR; PG8_MMA(0, 0, At, B0); PG8_MMA(0, 1, At, B1); PG8_BAR; PG8_SCHED;
            PG8_LDA(At, 1, 1); PG8_STAGE(PG8_SB(1, 0), b3, voffB); PG8_STAGE(PG8_SB(1, 1), b3 + hstep, voffB); PG8_STAGE(PG8_SA(1, 0), a3, voffA);
            PG8_WAIT_V(8); PG8_WAIT_L(0); PG8_BAR; PG8_MMA(1, 0, At, B0); PG8_MMA(1, 1, At, B1); PG8_BAR; PG8_SCHED;
            } else {
            PG8_LDB(B0, 0, 0); PG8_SCHED; PG8_LDA(At, 0, 0); PG8_STAGE(PG8_SA(1, 1), a1 + hstep, voffA);
            PG8_WAIT_L(8); PG8_BAR; PG8_WAIT_L(0); PG8_MMA(0, 0, At, B0); PG8_BAR; PG8_SCHED;
            PG8_LDB(B1, 0, 1); PG8_STAGE(PG8_SB(0, 0), b2, voffB);
            PG8_BAR; PG8_WAIT_L(0); PG8_MMA(0, 1, At, B1); PG8_BAR;
            PG8_LDA(At, 0, 1); PG8_STAGE(PG8_SA(0, 0), a2, voffA);
            PG8_BAR; PG8_WAIT_L(0); PG8_MMA(1, 0, At, B0); PG8_BAR; PG8_SCHED;
            PG8_STAGE(PG8_SB(0, 1), b2 + hstep, voffB);
            PG8_WAIT_V(6); PG8_BAR; PG8_MMA(1, 1, At, B1); PG8_BAR;
            PG8_LDB(B0, 1, 0); PG8_SCHED; PG8_LDA(At, 1, 0); PG8_STAGE(PG8_SA(0, 1), a2 + hstep, voffA);
            PG8_WAIT_L(8); PG8_BAR; PG8_WAIT_L(0); PG8_MMA(0, 0, At, B0); PG8_BAR; PG8_SCHED;
            PG8_LDB(B1, 1, 1); PG8_STAGE(PG8_SB(1, 0), b3, voffB);
            PG8_BAR; PG8_WAIT_L(0); PG8_MMA(0, 1, At, B1); PG8_BAR;
            PG8_LDA(At, 1, 1); PG8_STAGE(PG8_SA(1, 0), a3, voffA);
            PG8_BAR; PG8_WAIT_L(0); PG8_MMA(1, 0, At, B0); PG8_BAR; PG8_SCHED;
            PG8_STAGE(PG8_SB(1, 1), b3 + hstep, voffB);
            PG8_WAIT_V(6); PG8_BAR; PG8_MMA(1, 1, At, B1); PG8_BAR;
            }
        }
        if constexpr (ALIGN_EPI) { if (wr == 0) PG8_BAR; }
        if constexpr (!Epi::AFTER_DRAIN) { E(acc, cur, wr, wc, fr, fq); S.done(cur); }
        if (!has_next) break;
#pragma unroll
        for (int a = 0; a < 2; ++a)
#pragma unroll
            for (int b = 0; b < 2; ++b)
#pragma unroll
                for (int m = 0; m < 4; ++m)
#pragma unroll
                    for (int n = 0; n < 2; ++n) acc[a][b][m][n] = (f32x4){0.f, 0.f, 0.f, 0.f};
        cur = nxt; cA = nA; cB = nB; ++ui;
        if constexpr (ALIGN_EPI) { if (wr == 1) PG8_BAR; }
    }
    PG8_WAIT_V(0);
    if constexpr (!ALIGN_EPI) { if (wr == 0) PG8_BAR; }
    PG8_BAR;
    if constexpr (Epi::AFTER_DRAIN) { E.fused(acc, cur, wr, wc, fr, fq, lds, wid, lane); S.done(cur); }
#undef PG8_SA
#undef PG8_SB
#undef PG8_STAGE
#undef PG8_LDA
#undef PG8_LDB
#undef PG8_MMA
#undef PG8_WAIT_V
#undef PG8_WAIT_L
#undef PG8_BAR
#undef PG8_SCHED
}
}

#define DI __device__ __forceinline__
#define LAS __attribute__((address_space(3)))
typedef unsigned short bf16_t;
typedef short bf16x8 __attribute__((ext_vector_type(8)));
typedef float f32x4 __attribute__((ext_vector_type(4)));
typedef unsigned u32x4 __attribute__((ext_vector_type(4)));
typedef unsigned u32x2 __attribute__((ext_vector_type(2)));

constexpr int NT = 512;
constexpr int MT = 32768, SEQ = 16384, DMODEL = 1024, DFF = 2816;
constexpr int NITEM = 3072;
constexpr size_t MiB = 1u << 20;
constexpr size_t WS_CS = 1 * MiB;
constexpr size_t WS_AB = 3 * MiB;
constexpr size_t WS_MEMN = 5 * MiB;
constexpr size_t WS_MKV = 6 * MiB;
constexpr size_t WS_WMKV = 8 * MiB;
constexpr size_t WS_WKV = 12 * MiB;
constexpr size_t WS_GL = 13 * MiB;
constexpr size_t WS_KV = 14 * MiB;
constexpr size_t WS_WA0 = 30 * MiB;
constexpr size_t WSLOT = 26 * MiB;
constexpr size_t WO_IN = 0, WO_OUT = 7 * MiB, WO_GU = 9 * MiB, WO_DN = 20 * MiB;
constexpr size_t WS_P1 = 82 * MiB;
constexpr size_t WS_OT = 82 * MiB;
constexpr size_t WS_MIX = 130 * MiB;
constexpr size_t WS_ACT = 82 * MiB;
constexpr size_t WS_HKV = 82 * MiB;
constexpr size_t WS_P2 = 226 * MiB;
constexpr size_t WS_H = 290 * MiB;
constexpr size_t WS_QG = 290 * MiB;
constexpr size_t WS_KGT = 338 * MiB;
constexpr size_t WS_UT = 386 * MiB;
constexpr size_t WS_WP = 434 * MiB;
constexpr size_t WS_AI = 482 * MiB;
constexpr size_t WS_WB0 = 386 * MiB;
constexpr size_t WS_SSQ = 506 * MiB;
constexpr size_t WS_END = 508 * MiB;
constexpr int LDS_BYTES = 135168;

struct Params {
    const float* x; const float* mem; const int* pos; const float* ln_mix; const float* ln_ffn; const float* ln_mem;
    const float* w_mem_kv; const float* w_out; const float* w_gate_up; const float* w_down; const float* gdn_w_in;
    const float* gdn_conv; const float* gdn_A_log; const float* gdn_dt_bias; const float* gdn_norm; const float* swa_w_q;
    const float* swa_sinks; const float* ln_kv; const float* w_kv; const float* ln_final;
    float* out; unsigned char* ws;
    float inv[8];
};

typedef const Params& PRef;
DI unsigned f2bf(float f) { unsigned u = __float_as_uint(f); return (u + 0x7fffu + ((u >> 16) & 1u)) >> 16; }
typedef float f32x2_t __attribute__((ext_vector_type(2)));
typedef __bf16 bf16x2_t __attribute__((ext_vector_type(2)));
DI unsigned pk2(float lo, float hi) { f32x2_t v = {lo, hi}; bf16x2_t b = __builtin_convertvector(v, bf16x2_t); return __builtin_bit_cast(unsigned, b); }
DI float bflo(unsigned w) { return __uint_as_float(w << 16); }
DI float bfhi(unsigned w) { return __uint_as_float(w & 0xffff0000u); }
DI float bf2f(bf16_t b) { return __uint_as_float((unsigned)b << 16); }
DI bf16x8 pack8(f32x4 a, f32x4 b) { u32x4 p; p.x = pk2(a[0], a[1]); p.y = pk2(a[2], a[3]); p.z = pk2(b[0], b[1]); p.w = pk2(b[2], b[3]); return __builtin_bit_cast(bf16x8, p); }
DI float shx(float v, int mask) { const int ln = tidx() & 63; return __builtin_bit_cast(float, __builtin_amdgcn_ds_bpermute((ln ^ mask) << 2, __builtin_bit_cast(int, v))); }
DI float shup(float v, int d) { const int ln = tidx() & 63; return __builtin_bit_cast(float, __builtin_amdgcn_ds_bpermute((ln - d) << 2, __builtin_bit_cast(int, v))); }
DI LAS unsigned char* lnd(LAS unsigned char* q) { asm volatile("" : "+v"(q)); return q; }
#define uni(x) (x)
DI void lds_barrier() { asm volatile("s_waitcnt lgkmcnt(0)" ::: "memory"); __builtin_amdgcn_s_barrier(); asm volatile("" ::: "memory"); }
DI float wave_sum(float v) {
#pragma unroll
    for (int o = 32; o; o >>= 1) v += shx(v, o);
    return v; }
DI float siluf(float v) { return v * __builtin_amdgcn_rcpf(1.f + __expf(-v)); }
DI int tslot(int t) { return (t & ~31) + 8 * ((t & 15) >> 2) + 4 * ((t >> 4) & 1) + (t & 3); }
#define MFMA16(a, b, c) __builtin_amdgcn_mfma_f32_16x16x32_bf16((a), (b), (c), 0, 0, 0)

struct Epi {
    static constexpr bool PERM = true, AFTER_DRAIN = false;
    int mode; int ldc; bf16_t* o0; bf16_t* o1; float* f0; const float* base; const float* cs; float* ssq;
    DI void st8(bf16_t* p, f32x4 v0, f32x4 v1) const { u32x4 w; w.x = pk2(v0[0], v0[1]); w.y = pk2(v0[2], v0[3]); w.z = pk2(v1[0], v1[1]); w.w = pk2(v1[2], v1[3]); *(u32x4*)p = w; }
    DI void rope(f32x4& v0, f32x4& v1, int row, int col) const {
        if ((col & 63) < 16) { const f32x4 c = *(const f32x4*)(cs + (size_t)row * 16 + ((col & 63) >> 1)), s = *(const f32x4*)(cs + (size_t)row * 16 + 8 + ((col & 63) >> 1));
            const f32x4 a = v0 * c - v1 * s, b = v1 * c + v0 * s; v0 = a; v1 = b; }
    }
    DI void operator()(const f32x4 (&acc)[2][2][4][2], const pg8::Unit& u, int wr, int wc, int fr, int fq) const {
        const int row0 = u.pm * 256 + wr * 64 + fr;
        float rsv[2][4];
#pragma unroll
        for (int ai = 0; ai < 2; ++ai)
#pragma unroll
            for (int m = 0; m < 4; ++m) rsv[ai][m] = 1.f;
        if (mode != 0 && mode != 4) {
#pragma unroll
            for (int ai = 0; ai < 2; ++ai)
#pragma unroll
                for (int mp = 0; mp < 2; ++mp) {
                    f32x4 t[2][4];
#pragma unroll
                    for (int m = 0; m < 2; ++m) { const f32x4* sp = (const f32x4*)(ssq + (size_t)(row0 + ai * 128 + (2 * mp + m) * 16) * 16); t[m][0] = sp[0]; t[m][1] = sp[1]; t[m][2] = sp[2]; t[m][3] = sp[3]; }
#pragma unroll
                    for (int m = 0; m < 2; ++m) { const f32x4 c = (t[m][0] + t[m][1]) + (t[m][2] + t[m][3]); rsv[ai][2 * mp + m] = rsqrtf(((c[0] + c[1]) + (c[2] + c[3])) * (1.f / 1024.f) + 1e-6f); }
                }
        }
#pragma unroll
        for (int aim = 0; aim < 4; ++aim) { const int ai = aim >> 1, mp = aim & 1;
            f32x4 bs[2][2][2];
            if (mode == 4) {
#pragma unroll
                for (int m = 0; m < 2; ++m)
#pragma unroll
                    for (int bj = 0; bj < 2; ++bj) { const float* bp = base + (size_t)(row0 + ai * 128 + (2 * mp + m) * 16) * 1024 + u.pn * 256 + bj * 128 + wc * 32 + 8 * fq; bs[m][bj][0] = *(const f32x4*)bp; bs[m][bj][1] = *(const f32x4*)(bp + 4); }
            }
#pragma unroll
            for (int m = 2 * mp; m < 2 * mp + 2; ++m) {
                const int row = row0 + ai * 128 + m * 16;
                const float rs = rsv[ai][m]; float ssacc = 0.f;
                if (mode == 5) {
                    const f32x4 g0 = acc[ai][0][m][0] * rs, g1 = acc[ai][0][m][1] * rs, u0 = acc[ai][1][m][0] * rs, u1 = acc[ai][1][m][1] * rs;
                    st8(o0 + (size_t)row * DFF + u.pn * 128 + wc * 32 + 8 * fq, (f32x4){siluf(g0[0]) * u0[0], siluf(g0[1]) * u0[1], siluf(g0[2]) * u0[2], siluf(g0[3]) * u0[3]},
                        (f32x4){siluf(g1[0]) * u1[0], siluf(g1[1]) * u1[1], siluf(g1[2]) * u1[2], siluf(g1[3]) * u1[3]});
                } else
#pragma unroll
                for (int bj = 0; bj < 2; ++bj) {
                    const int col = u.pn * 256 + bj * 128 + wc * 32 + 8 * fq;
                    f32x4 v0 = acc[ai][bj][m][0] * rs, v1 = acc[ai][bj][m][1] * rs;
                    if (mode == 0) { st8(o0 + (size_t)row * ldc + col, v0, v1); }
                    else if (mode == 1) {
                        if (col < 2304) st8(o0 + (size_t)row * 2304 + col, v0, v1);
                        else if (col < 3328) { if (col >= 3072) { v0 = v0 * 0.125f; v1 = v1 * 0.125f; } st8(o1 + (size_t)row * 1024 + (col - 2304), v0, v1); }
                        else if (col == 3328) { *(f32x4*)(f0 + (size_t)row * 16) = v0; *(f32x4*)(f0 + (size_t)row * 16 + 4) = v1; }
                        else if (col == 3336) { *(f32x4*)(f0 + (size_t)row * 16 + 8) = v0; }
                    }
                    else if (mode == 2) { v0 = v0 * 0.125f; v1 = v1 * 0.125f; if (col < 768) rope(v0, v1, row, col); st8(o0 + (size_t)row * 1024 + col, v0, v1); }
                    else if (mode == 3) { if (col < 128) rope(v0, v1, row, col); st8(o0 + (size_t)row * 256 + col, v0, v1); }
                    else if (mode == 4) { float* op = f0 + (size_t)row * 1024 + col;
                        const f32x4 x0 = bs[m & 1][bj][0] + v0, x1 = bs[m & 1][bj][1] + v1; *(f32x4*)op = x0; *(f32x4*)(op + 4) = x1;
                        st8(o0 + (size_t)row * 1024 + col, x0, x1);
                        ssacc += (x0[0] * x0[0] + x0[1] * x0[1]) + (x0[2] * x0[2] + x0[3] * x0[3]) + (x1[0] * x1[0] + x1[1] * x1[1]) + (x1[2] * x1[2] + x1[3] * x1[3]); }

                }
                if (mode == 4) { ssacc += shx(ssacc, 16); ssacc += shx(ssacc, 32); if (fq == 0) ssq[(size_t)row * 16 + u.pn * 4 + wc] = ssacc; }
            }
        }
    }
};

DI void run_gemm(LAS unsigned char* lds, const bf16_t* A, const bf16_t* Bt, int M, int N, int K, const Epi& E) {
    pg8::Gemm g{A, Bt, M, N, K}; pg8::StaticOrder S; const int G = gridDim.x, bx = bidx();
    S.init(M, N, G, bx);
    pg8::gemm_phase<Epi, pg8::StaticOrder, true, true>(lds, g, S, E);
    __syncthreads();
}

DI int wmap(int mode, int n, int N) {
    if (mode == 0) return n < N ? n : -1;
    if (mode == 1) return n < 3072 ? n : (n < 3328 ? 3084 + (n - 3072) : (n < 3340 ? 3072 + (n - 3328) : -1));
    if (mode == 2) { const int u = n >> 8, w = n & 255; return w < 128 ? u * 128 + w : DFF + u * 128 + (w - 128); }
    const int lim = (N == 1024) ? 768 : 128;
    if (n < lim) { const int p = n & 63; if (p < 16) { const int q = p >> 3, jj = p & 7; return (n & ~63) + (jj < 4 ? 4 * q + jj : 8 + 4 * q + (jj - 4)); } }
    return n;
}
DI void wconv(LAS unsigned char* lds, const float* __restrict__ W, int K, int N, bf16_t* Wt, int Nout, int mode, const float* gk = nullptr, int first = -1, int stride = 0) {
    LAS float* tile = (LAS float*)lds; const int tid = tidx(), ntk = K / 64, ntn = Nout / 64;
    if (first < 0) { first = bidx(); stride = gridDim.x; }
    for (int t = first; t < ntk * ntn; t += stride) {
        const int tk = t % ntk, tn = t / ntk, k0 = tk * 64, n0 = tn * 64;
        const int j = tid & 63, kk = tid >> 6; const int c = wmap(mode, n0 + j, N);
#pragma unroll
        for (int i = 0; i < 8; ++i) { const int k = i * 8 + kk; tile[k * 65 + j] = c >= 0 ? W[(size_t)(k0 + k) * N + c] * (gk ? gk[k0 + k] : 1.f) : 0.f; }
        lds_barrier();
        const int nn = tid >> 3, k8 = (tid & 7) * 8; u32x4 o;
        o.x = pk2(tile[(k8 + 0) * 65 + nn], tile[(k8 + 1) * 65 + nn]); o.y = pk2(tile[(k8 + 2) * 65 + nn], tile[(k8 + 3) * 65 + nn]);
        o.z = pk2(tile[(k8 + 4) * 65 + nn], tile[(k8 + 5) * 65 + nn]); o.w = pk2(tile[(k8 + 6) * 65 + nn], tile[(k8 + 7) * 65 + nn]);
        *(u32x4*)(Wt + (size_t)(n0 + nn) * K + k0 + k8) = o;
        lds_barrier();
    }
}
DI void conv_layer_weights(LAS unsigned char* lds, PRef p, int layer, unsigned char* slot, int first = -1, int stride = 0, int mask = 15) {
    if (mask & 1) {
        if (layer < 2) wconv(lds, uni(p.gdn_w_in) + (size_t)layer * 1024 * 3340, 1024, 3340, (bf16_t*)(slot + WO_IN), 3584, 1, uni(p.ln_mix) + layer * 1024, first, stride);
        else wconv(lds, uni(p.swa_w_q) + (size_t)(layer - 2) * 1024 * 1024, 1024, 1024, (bf16_t*)(slot + WO_IN), 1024, 3, uni(p.ln_mix) + layer * 1024, first, stride);
    }
    if (mask & 2) wconv(lds, uni(p.w_out) + (size_t)layer * 1024 * 1024, 1024, 1024, (bf16_t*)(slot + WO_OUT), 1024, 0, nullptr, first, stride);
    if (mask & 4) wconv(lds, uni(p.w_gate_up) + (size_t)layer * 1024 * 5632, 1024, 5632, (bf16_t*)(slot + WO_GU), 5632, 2, uni(p.ln_ffn) + layer * 1024, first, stride);
    if (mask & 8) wconv(lds, uni(p.w_down) + (size_t)layer * DFF * 1024, DFF, 1024, (bf16_t*)(slot + WO_DN), 1024, 0, nullptr, first, stride);
}
DI void norm_rows(const float* x, const float* __restrict__ g, bf16_t* out, int rows) {
    const int lane = tidx() & 63, gw = bidx() * 8 + (tidx() >> 6), nw = gridDim.x * 8;
    for (int r = gw; r < rows; r += nw) {
        const f32x4* xr = (const f32x4*)(x + (size_t)r * 1024); f32x4 v[4]; float ss = 0.f;
#pragma unroll
        for (int i = 0; i < 4; ++i) { v[i] = xr[lane + 64 * i]; ss += v[i][0] * v[i][0] + v[i][1] * v[i][1] + v[i][2] * v[i][2] + v[i][3] * v[i][3]; }
        ss = wave_sum(ss); const float rs = rsqrtf(ss * (1.f / 1024.f) + 1e-6f);
#pragma unroll
        for (int i = 0; i < 4; ++i) { const f32x4 gg = ((const f32x4*)g)[lane + 64 * i]; u32x2 o; o.x = pk2(v[i][0] * rs * gg[0], v[i][1] * rs * gg[1]); o.y = pk2(v[i][2] * rs * gg[2], v[i][3] * rs * gg[3]);
            *(u32x2*)(out + (size_t)r * 1024 + (lane + 64 * i) * 4) = o; }
    }
}
DI void xb_rows(const float* x, bf16_t* out, float* ssq, int rows) {
    const int lane = tidx() & 63, gw = bidx() * 8 + (tidx() >> 6), nw = gridDim.x * 8;
    for (int r = gw; r < rows; r += nw) {
        const f32x4* xr = (const f32x4*)(x + (size_t)r * 1024); f32x4 v[4]; float ss = 0.f;
#pragma unroll
        for (int i = 0; i < 4; ++i) { v[i] = xr[lane + 64 * i]; ss += v[i][0] * v[i][0] + v[i][1] * v[i][1] + v[i][2] * v[i][2] + v[i][3] * v[i][3]; }
        ss = wave_sum(ss);
#pragma unroll
        for (int i = 0; i < 4; ++i) { u32x2 o; o.x = pk2(v[i][0], v[i][1]); o.y = pk2(v[i][2], v[i][3]); *(u32x2*)(out + (size_t)r * 1024 + (lane + 64 * i) * 4) = o; }
        if (lane < 16) ssq[(size_t)r * 16 + lane] = lane == 0 ? ss : 0.f;
    }
}
DI void final_norm(float* x, const float* __restrict__ g, int rows) {
    const int lane = tidx() & 63, gw = bidx() * 8 + (tidx() >> 6), nw = gridDim.x * 8;
    for (int r = gw; r < rows; r += nw) {
        f32x4* xr = (f32x4*)(x + (size_t)r * 1024); f32x4 v[4]; float ss = 0.f;
#pragma unroll
        for (int i = 0; i < 4; ++i) { v[i] = xr[lane + 64 * i]; ss += v[i][0] * v[i][0] + v[i][1] * v[i][1] + v[i][2] * v[i][2] + v[i][3] * v[i][3]; }
        ss = wave_sum(ss); const float rs = rsqrtf(ss * (1.f / 1024.f) + 1e-6f);
#pragma unroll
        for (int i = 0; i < 4; ++i) { const f32x4 gg = ((const f32x4*)g)[lane + 64 * i]; xr[lane + 64 * i] = v[i] * rs * gg; }
    }
}
DI void rope_table(PRef p) {
    float* cs = (float*)(uni(p.ws) + WS_CS);
    for (int idx = bidx() * NT + tidx(); idx < MT * 8; idx += gridDim.x * NT) {
        const int r = idx >> 3, i = idx & 7; const float ang = (float)uni(p.pos)[r] * p.inv[i];
        const double a = (double)ang, k = rint(a * 0.15915494309189535), rr = a - k * 6.283185307179586476925; const double r2 = rr * rr;
        double sn = 1.0 / 51090942171709440000.0, cn = 1.0 / 2432902008176640000.0;
        sn = sn * r2 - 1.0 / 121645100408832000.0; cn = cn * r2 - 1.0 / 6402373705728000.0;
        sn = sn * r2 + 1.0 / 355687428096000.0;    cn = cn * r2 + 1.0 / 20922789888000.0;
        sn = sn * r2 - 1.0 / 1307674368000.0;      cn = cn * r2 - 1.0 / 87178291200.0;
        sn = sn * r2 + 1.0 / 6227020800.0;         cn = cn * r2 + 1.0 / 479001600.0;
        sn = sn * r2 - 1.0 / 39916800.0;           cn = cn * r2 - 1.0 / 3628800.0;
        sn = sn * r2 + 1.0 / 362880.0;             cn = cn * r2 + 1.0 / 40320.0;
        sn = sn * r2 - 1.0 / 5040.0;               cn = cn * r2 - 1.0 / 720.0;
        sn = sn * r2 + 1.0 / 120.0;                cn = cn * r2 + 1.0 / 24.0;
        sn = sn * r2 - 1.0 / 6.0;                  cn = cn * r2 - 0.5;
        sn = sn * r2 + 1.0;                        cn = cn * r2 + 1.0;
        sn = sn * rr;
        cs[(size_t)r * 16 + i] = (float)cn; cs[(size_t)r * 16 + 8 + i] = (float)sn;
    }
}

template <int J, int HF> DI void solve_loadh(f32x4 (&buf)[8], const LAS float* Lz) {
    constexpr int g0 = (((J + 1) >> 2) > HF * 8) ? ((J + 1) >> 2) : HF * 8;
#pragma unroll
    for (int g = g0; g < HF * 8 + 8; ++g) buf[g - HF * 8] = *(const LAS f32x4*)(Lz + J * 64 + 4 * g);
}
template <int J, int HF> DI void solve_applyh(f32x2_t (&r2)[32], const f32x4 (&buf)[8]) {
    constexpr int st = (J + 1 > HF * 32) ? J + 1 : HF * 32;
    const float xj = r2[J >> 1][J & 1]; const f32x2_t x2 = {xj, xj};
    if constexpr ((st & 1) && st < HF * 32 + 32) r2[st >> 1][1] -= buf[(st >> 2) - HF * 8][st & 3] * xj;
#pragma unroll
    for (int pp = (st + 1) >> 1; pp < HF * 16 + 16; ++pp) r2[pp] -= (f32x2_t){buf[((2 * pp) >> 2) - HF * 8][(2 * pp) & 3], buf[((2 * pp + 1) >> 2) - HF * 8][(2 * pp + 1) & 3]} * x2;
}
template <int J> DI void solve_steps(f32x2_t (&r2)[32], f32x4 (&ha)[8], f32x4 (&hb)[8], const LAS float* Lz) {
    solve_loadh<J, 1>(hb, Lz);
    solve_applyh<J, 0>(r2, ha);
    solve_loadh<J + 1, 0>(ha, Lz);
    solve_applyh<J, 1>(r2, hb);
    if constexpr (J + 1 < 63) solve_steps<J + 1>(r2, ha, hb, Lz);
}
DI void gdn_chunk_phase(LAS unsigned char* lds, PRef p, int a) {
    const bf16_t* P1 = (const bf16_t*)(uni(p.ws) + WS_P1); const float* ab = (const float*)(uni(p.ws) + WS_AB);
    const float* convw = uni(p.gdn_conv) + (size_t)a * 4 * 2304; const float* A_log = uni(p.gdn_A_log) + a * 6; const float* dtb = uni(p.gdn_dt_bias) + a * 6;
    bf16_t* QG = (bf16_t*)(uni(p.ws) + WS_QG); bf16_t* WP = (bf16_t*)(uni(p.ws) + WS_WP); bf16_t* KGT = (bf16_t*)(uni(p.ws) + WS_KGT); bf16_t* UT = (bf16_t*)(uni(p.ws) + WS_UT);
    bf16_t* AI = (bf16_t*)(uni(p.ws) + WS_AI); float* GL = (float*)(uni(p.ws) + WS_GL);
    LAS float* RHS = (LAS float*)lds;
    LAS unsigned char* RAW = lds;
    LAS bf16_t* Qb = (LAS bf16_t*)(lds + 65536);
    LAS bf16_t* Kb = (LAS bf16_t*)(lds + 65536 + 17408);
    LAS float* Lm = (LAS float*)(lds + 65536 + 34816);
    LAS float* CW = (LAS float*)(lds + 116736);
    LAS float* gcs = (LAS float*)(lds + 122880);
    u32x4 pr[7]; float pcw[3], pbl = 0.f, pal = 0.f, pAl = 0.f, pdt = 0.f;
#define CH_LOAD(itn) do { const int tid_ = tidx(), h_ = (itn) % 6, cn_ = (itn) / 6, n_ = cn_ & 255, t0_ = cn_ * 64; \
        _Pragma("unroll") for (int i = 0; i < 7; ++i) { const int idx = tid_ + NT * i, rr = idx / 48, pc = idx % 48, sec = pc >> 4, off = (pc & 15) * 8; \
            pr[i] = (u32x4){0u, 0u, 0u, 0u}; if (idx < 67 * 48 && (rr >= 3 || n_ > 0)) pr[i] = *(const u32x4*)(P1 + (size_t)(t0_ - 3 + rr) * 2304 + sec * 768 + h_ * 128 + off); } \
        _Pragma("unroll") for (int i = 0; i < 3; ++i) { const int idx = tid_ + NT * i, j = idx / 384, c = idx % 384, sec = c >> 7; pcw[i] = convw[j * 2304 + sec * 768 + h_ * 128 + (c & 127)]; } \
        if (tid_ < 64) { pbl = ab[(size_t)(t0_ + tid_) * 16 + h_]; pal = ab[(size_t)(t0_ + tid_) * 16 + 6 + h_]; pAl = A_log[h_]; pdt = dtb[h_]; } } while (0)
    if (bidx() < NITEM) CH_LOAD(bidx());
#pragma unroll 1
    for (int it = bidx(); it < NITEM; it += gridDim.x) {
        const int tid = tidx(), lane = tid & 63, wave = tid >> 6;
        const int h = it % 6, cn = it / 6, t0 = cn * 64;
#pragma unroll
        for (int i = 0; i < 7; ++i) { const int idx = tid + NT * i, rr = idx / 48, pc = idx % 48, sec = pc >> 4, off = (pc & 15) * 8; if (idx < 67 * 48) *(LAS u32x4*)(RAW + rr * 784 + sec * 256 + off * 2) = pr[i]; }
#pragma unroll
        for (int i = 0; i < 3; ++i) CW[tid + NT * i] = pcw[i];
        if (tid < 64) {
            const float bl = pbl, al = pal;
            const float beta = __builtin_amdgcn_rcpf(1.f + __expf(-bl)); const float xx = al + pdt, te = __expf(xx);
            const float sp = xx > 20.f ? xx : (te < 0.02f ? te * (1.f - te * (0.5f - 0.33333334f * te)) : __logf(1.f + te));
            float g = -__expf(pAl) * sp;
#pragma unroll
            for (int o = 1; o < 64; o <<= 1) { const float y = shup(g, o); if (lane >= o) g += y; }
            const float glast = __builtin_bit_cast(float, __builtin_amdgcn_readlane(__builtin_bit_cast(int, g), 63));
            gcs[tid] = g; gcs[64 + tid] = beta; gcs[128 + tid] = __expf(g); gcs[192 + tid] = __expf(glast - g);
            if (tid == 63) GL[it] = __expf(g);
        }
        lds_barrier();
        const int t = tid >> 3, part = tid & 7;
        float cq[16], ck[16], cv[16];
#pragma unroll
        for (int sec = 0; sec < 3; ++sec)
#pragma unroll
            for (int hf = 0; hf < 2; ++hf) {
                f32x2_t a2[4];
#pragma unroll
                for (int e = 0; e < 4; ++e) a2[e] = (f32x2_t){0.f, 0.f};
#pragma unroll
                for (int j = 0; j < 4; ++j) {
                    const u32x4 rw = *(const LAS u32x4*)(RAW + (t + j) * 784 + sec * 256 + (part * 16 + hf * 8) * 2);
                    const f32x4 w0 = *(const LAS f32x4*)(CW + j * 384 + sec * 128 + part * 16 + hf * 8), w1 = *(const LAS f32x4*)(CW + j * 384 + sec * 128 + part * 16 + hf * 8 + 4);
                    a2[0] += (f32x2_t){w0[0], w0[1]} * (f32x2_t){bflo(rw.x), bfhi(rw.x)}; a2[1] += (f32x2_t){w0[2], w0[3]} * (f32x2_t){bflo(rw.y), bfhi(rw.y)};
                    a2[2] += (f32x2_t){w1[0], w1[1]} * (f32x2_t){bflo(rw.z), bfhi(rw.z)}; a2[3] += (f32x2_t){w1[2], w1[3]} * (f32x2_t){bflo(rw.w), bfhi(rw.w)};
                }
                const float acc[8] = {a2[0][0], a2[0][1], a2[1][0], a2[1][1], a2[2][0], a2[2][1], a2[3][0], a2[3][1]};
#pragma unroll
                for (int e = 0; e < 8; ++e) { const float s = siluf(acc[e]); if (sec == 0) cq[hf * 8 + e] = s; else if (sec == 1) ck[hf * 8 + e] = s; else cv[hf * 8 + e] = s; }
            }
        float ssq = 0.f, ssk = 0.f;
#pragma unroll
        for (int e = 0; e < 16; ++e) { ssq += cq[e] * cq[e]; ssk += ck[e] * ck[e]; }
        ssq += shx(ssq, 1); ssq += shx(ssq, 2); ssq += shx(ssq, 4);
        ssk += shx(ssk, 1); ssk += shx(ssk, 2); ssk += shx(ssk, 4);
        const float rq = rsqrtf(ssq + 1e-6f) * 0.08838834764831845f, rk = rsqrtf(ssk + 1e-6f);
        const float gct = gcs[t], bt = gcs[64 + t], egt = gcs[128 + t], gclast = gcs[63];
        lds_barrier();
        {
#pragma unroll
            for (int e = 0; e < 16; ++e) { cq[e] *= rq; ck[e] *= rk; }
            u32x4 w;
            w.x = pk2(cq[0], cq[1]); w.y = pk2(cq[2], cq[3]); w.z = pk2(cq[4], cq[5]); w.w = pk2(cq[6], cq[7]); *(LAS u32x4*)(Qb + t * 136 + part * 16) = w;
            w.x = pk2(cq[8], cq[9]); w.y = pk2(cq[10], cq[11]); w.z = pk2(cq[12], cq[13]); w.w = pk2(cq[14], cq[15]); *(LAS u32x4*)(Qb + t * 136 + part * 16 + 8) = w;
            w.x = pk2(ck[0], ck[1]); w.y = pk2(ck[2], ck[3]); w.z = pk2(ck[4], ck[5]); w.w = pk2(ck[6], ck[7]); *(LAS u32x4*)(Kb + t * 136 + part * 16) = w;
            w.x = pk2(ck[8], ck[9]); w.y = pk2(ck[10], ck[11]); w.z = pk2(ck[12], ck[13]); w.w = pk2(ck[14], ck[15]); *(LAS u32x4*)(Kb + t * 136 + part * 16 + 8) = w;
            const float kbe = bt * egt;
#pragma unroll
            for (int e4 = 0; e4 < 4; ++e4) {
                *(LAS f32x4*)(RHS + t * 256 + part * 16 + e4 * 4) = (f32x4){cv[e4 * 4] * bt, cv[e4 * 4 + 1] * bt, cv[e4 * 4 + 2] * bt, cv[e4 * 4 + 3] * bt};
                *(LAS f32x4*)(RHS + t * 256 + 128 + part * 16 + e4 * 4) = (f32x4){ck[e4 * 4] * kbe, ck[e4 * 4 + 1] * kbe, ck[e4 * 4 + 2] * kbe, ck[e4 * 4 + 3] * kbe};
            }
            bf16_t* qgp = QG + (size_t)(t0 + t) * 768 + h * 128 + 32 * (part >> 1) + 4 * (part & 1);
#pragma unroll
            for (int q4 = 0; q4 < 4; ++q4) { u32x2 o; o.x = pk2(cq[q4 * 4] * egt, cq[q4 * 4 + 1] * egt); o.y = pk2(cq[q4 * 4 + 2] * egt, cq[q4 * 4 + 3] * egt); *(u32x2*)(qgp + 8 * q4) = o; }
        }
        lds_barrier();
        {
#pragma unroll
            for (int i = 0; i < 2; ++i) {
                const int pid = tid + NT * i, d = pid >> 3, s8 = pid & 7, tb = 32 * (s8 >> 2) + 4 * (s8 & 3); float v[8];
#pragma unroll
                for (int e = 0; e < 8; ++e) { const int tk = tb + 16 * (e >> 2) + (e & 3); v[e] = bf2f(Kb[tk * 136 + d]) * gcs[192 + tk]; }
                u32x4 w; w.x = pk2(v[0], v[1]); w.y = pk2(v[2], v[3]); w.z = pk2(v[4], v[5]); w.w = pk2(v[6], v[7]);
                *(u32x4*)(KGT + (size_t)it * 8192 + d * 64 + 8 * s8) = w;
            }
            const int mat = wave >> 2, mi = wave & 3, r16 = lane & 15, q = lane >> 4;
            const LAS bf16_t* Ab = Kb + (16 * mi + r16) * 136 + 8 * q;
            bf16x8 af[4];
#pragma unroll
            for (int ks = 0; ks < 4; ++ks) af[ks] = *(const LAS bf16x8*)(Ab + 32 * ks);
            if (mat == 0) {
#pragma unroll
                for (int ni = 0; ni < 4; ++ni) if (ni <= mi) {
                    const LAS bf16_t* Bb = Kb + (16 * ni + r16) * 136 + 8 * q; f32x4 acc = {0.f, 0.f, 0.f, 0.f};
#pragma unroll
                    for (int ks = 0; ks < 4; ++ks) acc = MFMA16(af[ks], *(const LAS bf16x8*)(Bb + 32 * ks), acc);
                    const int kc = 16 * ni + r16; const float gk = gcs[kc];
                    f32x4 lv4;
#pragma unroll
                    for (int j = 0; j < 4; ++j) { const int c = 16 * mi + 4 * q + j; lv4[j] = (c > kc) ? gcs[64 + c] * acc[j] * __expf(fminf(gcs[c] - gk, 0.f)) : 0.f; }
                    *(LAS f32x4*)(Lm + kc * 64 + 16 * mi + 4 * q) = lv4;
                }
            } else {
#pragma unroll
                for (int ni = 0; ni < 4; ++ni) {
                    f32x4 acc = {0.f, 0.f, 0.f, 0.f}; const int c = 16 * ni + r16;
                    if (ni >= mi) {
                        const LAS bf16_t* Bb = Qb + (16 * ni + r16) * 136 + 8 * q;
#pragma unroll
                        for (int ks = 0; ks < 4; ++ks) acc = MFMA16(af[ks], *(const LAS bf16x8*)(Bb + 32 * ks), acc);
                        const float gcc = gcs[c];
#pragma unroll
                        for (int j = 0; j < 4; ++j) { const int kc = 16 * mi + 4 * q + j; acc[j] = (c >= kc) ? acc[j] * __expf(fminf(gcc - gcs[kc], 0.f)) : 0.f; }
                    }
                    u32x2 w; w.x = pk2(acc[0], acc[1]); w.y = pk2(acc[2], acc[3]);
                    *(u32x2*)(AI + (size_t)it * 4096 + c * 64 + 32 * (mi >> 1) + 8 * q + 4 * (mi & 1)) = w;
                }
            }
        }
        lds_barrier();
        { const int itn = (it + (int)gridDim.x < NITEM) ? it + (int)gridDim.x : it; CH_LOAD(itn); }
        if (tid < 256) {
            const LAS float* Lz = Lm + __builtin_amdgcn_mbcnt_lo(0u, 0u);
            f32x2_t r2[32];
#pragma unroll
            for (int i = 0; i < 32; ++i) r2[i] = (f32x2_t){RHS[(2 * i) * 256 + tid], RHS[(2 * i + 1) * 256 + tid]};
            f32x4 ha[8], hb[8];
            solve_loadh<0, 0>(ha, Lz);
            solve_steps<0>(r2, ha, hb, Lz);
#pragma unroll
            for (int i = 0; i < 32; ++i) { RHS[(2 * i) * 256 + tid] = r2[i][0]; RHS[(2 * i + 1) * 256 + tid] = r2[i][1]; }
        }
        lds_barrier();
        {
            const int dv = tid >> 2, tq = tid & 3; u32x4 w0, w1; float e[16];
#pragma unroll
            for (int i = 0; i < 16; ++i) e[i] = RHS[(tq * 16 + i) * 256 + dv];
            w0.x = pk2(e[0], e[1]); w0.y = pk2(e[2], e[3]); w0.z = pk2(e[4], e[5]); w0.w = pk2(e[6], e[7]);
            w1.x = pk2(e[8], e[9]); w1.y = pk2(e[10], e[11]); w1.z = pk2(e[12], e[13]); w1.w = pk2(e[14], e[15]);
            bf16_t* up = UT + (size_t)it * 8192 + dv * 64 + tq * 16; *(u32x4*)up = w0; *(u32x4*)(up + 8) = w1;
            bf16_t* wp = WP + (size_t)(t0 + t) * 768 + h * 128 + 32 * (part >> 1) + 4 * (part & 1);
#pragma unroll
            for (int q4 = 0; q4 < 4; ++q4) { const f32x4 xv = *(const LAS f32x4*)(RHS + t * 256 + 128 + part * 16 + q4 * 4); u32x2 o; o.x = pk2(xv[0], xv[1]); o.y = pk2(xv[2], xv[3]); *(u32x2*)(wp + 8 * q4) = o; }
        }
        lds_barrier();
    }
#undef CH_LOAD
}

constexpr int SCAN_NBLK = 96, SCAN_BUF = 62464;
DI void scan_step(const LAS unsigned char* cur, f32x4 (&S)[8], const u32x2 (&uu)[4], float gl, bf16_t* op, int r16, int q) {
    bf16x8 Sb[4];
#pragma unroll
    for (int ks = 0; ks < 4; ++ks) Sb[ks] = pack8(S[2 * ks], S[2 * ks + 1]);
    const LAS unsigned char* bw = cur + r16 * 272 + 16 * q;
    const LAS unsigned char* ba = cur + 34816 + r16 * 144 + 16 * q;
#define FADDR(i) ((i) < 16 ? bw + ((i) % 4) * (16 * 272) + ((i) / 4) * 64 : (i) < 32 ? bw + 17408 + (((i) - 16) % 4) * (16 * 272) + (((i) - 16) / 4) * 64 : \
                  (i) < 40 ? ba + (((i) - 32) % 4) * (16 * 144) + (((i) - 32) / 4) * 64 : ba + 9216 + (((i) - 40) % 8) * (16 * 144) + (((i) - 40) / 8) * 64)
    constexpr int RING = 16; bf16x8 fr[RING]; f32x4 a1[4], o[4]; bf16x8 vb[2];
#pragma unroll
    for (int i = 0; i < 4; ++i) { a1[i] = (f32x4){0.f, 0.f, 0.f, 0.f}; o[i] = (f32x4){0.f, 0.f, 0.f, 0.f}; }
    vb[0] = Sb[0]; vb[1] = Sb[0];
#pragma unroll
    for (int i = 0; i < RING; ++i) fr[i] = *(const LAS bf16x8*)FADDR(i);
#pragma unroll
    for (int i = 0; i < 56; ++i) {
        const bf16x8 f = fr[i % RING];
        if (i + RING < 56) fr[i % RING] = *(const LAS bf16x8*)FADDR(i + RING);
        if (i < 16) a1[i % 4] = MFMA16(f, Sb[i / 4], a1[i % 4]);
        else if (i < 32) o[(i - 16) % 4] = MFMA16(f, Sb[(i - 16) / 4], o[(i - 16) % 4]);
        else if (i < 40) o[(i - 32) % 4] = MFMA16(f, vb[(i - 32) / 4], o[(i - 32) % 4]);
        else { const int dt = (i - 40) % 8, k2 = (i - 40) / 8; if (k2 == 0) S[dt] = S[dt] * gl; S[dt] = MFMA16(f, vb[k2], S[dt]); }
        if (i == 15) {
            f32x4 vn[4];
#pragma unroll
            for (int mt = 0; mt < 4; ++mt) vn[mt] = (f32x4){bflo(uu[mt].x), bfhi(uu[mt].x), bflo(uu[mt].y), bfhi(uu[mt].y)} - a1[mt];
            vb[0] = pack8(vn[0], vn[1]); vb[1] = pack8(vn[2], vn[3]);
        }
        __builtin_amdgcn_sched_barrier(0);
    }
#undef FADDR
#pragma unroll
    for (int mt = 0; mt < 4; ++mt) { u32x2 w; w.x = pk2(o[mt][0], o[mt][1]); w.y = pk2(o[mt][2], o[mt][3]); *(u32x2*)(op + 16 * mt) = w; }
}
DI void gdn_scan_phase(LAS unsigned char* lds, PRef p) {
    if (bidx() >= SCAN_NBLK) return;
    const bf16_t* QG = (const bf16_t*)(uni(p.ws) + WS_QG); const bf16_t* WP = (const bf16_t*)(uni(p.ws) + WS_WP); const bf16_t* KGT = (const bf16_t*)(uni(p.ws) + WS_KGT);
    const bf16_t* UT = (const bf16_t*)(uni(p.ws) + WS_UT); const bf16_t* AI = (const bf16_t*)(uni(p.ws) + WS_AI); const float* GL = (const float*)(uni(p.ws) + WS_GL);
    bf16_t* OT = (bf16_t*)(uni(p.ws) + WS_OT);
    const int tid = tidx(), lane = tid & 63, wave = __builtin_amdgcn_readfirstlane(tid >> 6), r16 = lane & 15, q = lane >> 4;
    const int xcd = bidx() & 7, kx = bidx() >> 3, hg = xcd * 3 + (kx >> 2), bh = hg >> 1, b = bh / 6, h = bh % 6, dv0 = ((hg & 1) * 4 + (kx & 3)) * 16;
    const size_t it0 = (size_t)(b * 256) * 6 + h, tok0 = (size_t)(b * 256) * 64;
    if (wave == 0) {
        f32x4 S[8];
#pragma unroll
        for (int i = 0; i < 8; ++i) S[i] = (f32x4){0.f, 0.f, 0.f, 0.f};
        u32x2 ua[4], ub[4], uc[4], ud[4]; float gla, glb, glc, gld;
        const bf16_t* up = UT + it0 * 8192 + (size_t)(dv0 + r16) * 64 + 4 * q;
        bf16_t* op = OT + it0 * 8192 + (size_t)(dv0 + r16) * 64 + 4 * q;
        const float* glp = GL + it0; const int zdiv = tidx() >> 20;
#define SCAN_LOADU(u, g, nn) do { const size_t o_ = (size_t)min((nn), 255) * (6 * 8192); \
        u[0] = *(const u32x2*)(up + o_); u[1] = *(const u32x2*)(up + o_ + 16); u[2] = *(const u32x2*)(up + o_ + 32); u[3] = *(const u32x2*)(up + o_ + 48); g = glp[min((nn), 255) * 6 + zdiv]; } while (0)
        SCAN_LOADU(ua, gla, 0); SCAN_LOADU(ub, glb, 1); SCAN_LOADU(uc, glc, 2); SCAN_LOADU(ud, gld, 3);
        lds_barrier();
#pragma unroll 1
        for (int n = 0; n < 256; n += 4) {
            scan_step(lds, S, ua, gla, op + (size_t)n * (6 * 8192), r16, q);
            SCAN_LOADU(ua, gla, n + 4);
            lds_barrier();
            scan_step(lds + SCAN_BUF, S, ub, glb, op + (size_t)(n + 1) * (6 * 8192), r16, q);
            SCAN_LOADU(ub, glb, n + 5);
            lds_barrier();
            scan_step(lds, S, uc, glc, op + (size_t)(n + 2) * (6 * 8192), r16, q);
            SCAN_LOADU(uc, glc, n + 6);
            lds_barrier();
            scan_step(lds + SCAN_BUF, S, ud, gld, op + (size_t)(n + 3) * (6 * 8192), r16, q);
            SCAN_LOADU(ud, gld, n + 7);
            lds_barrier();
        }
#undef SCAN_LOADU
    } else {
        const bf16_t* src; size_t sstride; int jsrc, dst, jdst;
        if (wave <= 4) { const int t2 = (tid - 64) & 127, row = t2 >> 4, pc = t2 & 15; const bool isq = wave >= 3;
            src = (isq ? QG : WP) + (tok0 + row) * 768 + h * 128 + pc * 8; sstride = 64 * 768; jsrc = 8 * 768; dst = (isq ? 17408 : 0) + row * 272 + pc * 16; jdst = 8 * 272; }
        else if (wave == 5) { const int t2 = lane; src = AI + it0 * 4096 + t2 * 8; sstride = 6 * 4096; jsrc = 512; dst = 34816 + (t2 >> 3) * 144 + (t2 & 7) * 16; jdst = 8 * 144; }
        else { const int t2 = (tid - 384) & 127; src = KGT + it0 * 8192 + t2 * 8; sstride = 6 * 8192; jsrc = 1024; dst = 44032 + (t2 >> 3) * 144 + (t2 & 7) * 16; jdst = 16 * 144; }
        u32x4 r0[8], r1[8], r2[8], r3[8];
#define SCAN_LOAD(r, nn) do { const bf16_t* s_ = src + (size_t)min((nn), 255) * sstride; \
        _Pragma("unroll") for (int j = 0; j < 8; ++j) r[j] = *(const u32x4*)(s_ + (size_t)j * jsrc); } while (0)
#define SCAN_STORE(r, bufp) do { LAS unsigned char* b_ = (bufp) + dst; \
        _Pragma("unroll") for (int j = 0; j < 8; ++j) *(LAS u32x4*)(b_ + j * jdst) = r[j]; } while (0)
        SCAN_LOAD(r0, 0); SCAN_LOAD(r1, 1); SCAN_LOAD(r2, 2); SCAN_LOAD(r3, 3);
        SCAN_STORE(r0, lds); SCAN_LOAD(r0, 4);
        lds_barrier();
#pragma unroll 1
        for (int n = 0; n < 256; n += 4) {
            SCAN_STORE(r1, lds + SCAN_BUF); SCAN_LOAD(r1, n + 5);
            lds_barrier();
            SCAN_STORE(r2, lds); SCAN_LOAD(r2, n + 6);
            lds_barrier();
            SCAN_STORE(r3, lds + SCAN_BUF); SCAN_LOAD(r3, n + 7);
            lds_barrier();
            SCAN_STORE(r0, lds); SCAN_LOAD(r0, n + 8);
            lds_barrier();
        }
#undef SCAN_LOAD
#undef SCAN_STORE
    }
}

DI void gdn_gate_phase(LAS unsigned char* lds, PRef p, int a) {
    const bf16_t* OT = (const bf16_t*)(uni(p.ws) + WS_OT); const bf16_t* P2 = (const bf16_t*)(uni(p.ws) + WS_P2); bf16_t* MIX = (bf16_t*)(uni(p.ws) + WS_MIX);
    const float* gn = uni(p.gdn_norm) + a * 128; LAS bf16_t* T = (LAS bf16_t*)lds;
    const int tid = tidx(), t = tid >> 3, part = tid & 7;
    for (int it = bidx(); it < NITEM; it += gridDim.x) {
        const int h = it % 6, cn = it / 6, t0 = cn * 64;
#pragma unroll
        for (int i = 0; i < 2; ++i) { const int id = tid + NT * i, row = id >> 3, pc = id & 7; *(LAS u32x4*)(T + row * 72 + pc * 8) = *(const u32x4*)(OT + (size_t)it * 8192 + row * 64 + pc * 8); }
        lds_barrier();
        float o[16]; float ss = 0.f;
#pragma unroll
        for (int e = 0; e < 16; ++e) { o[e] = bf2f(T[(part * 16 + e) * 72 + t]); ss += o[e] * o[e]; }
        ss += shx(ss, 1); ss += shx(ss, 2); ss += shx(ss, 4);
        const float rs = rsqrtf(ss * (1.f / 128.f) + 1e-6f);
        const bf16_t* zp = P2 + (size_t)(t0 + t) * 1024 + h * 128 + part * 16; const u32x4 z0 = *(const u32x4*)zp, z1 = *(const u32x4*)(zp + 8);
        float z[16] = {bflo(z0.x), bfhi(z0.x), bflo(z0.y), bfhi(z0.y), bflo(z0.z), bfhi(z0.z), bflo(z0.w), bfhi(z0.w), bflo(z1.x), bfhi(z1.x), bflo(z1.y), bfhi(z1.y), bflo(z1.z), bfhi(z1.z), bflo(z1.w), bfhi(z1.w)};
        float r[16];
#pragma unroll
        for (int e = 0; e < 16; ++e) r[e] = o[e] * rs * gn[part * 16 + e] * siluf(z[e]);
        u32x4 w0, w1; w0.x = pk2(r[0], r[1]); w0.y = pk2(r[2], r[3]); w0.z = pk2(r[4], r[5]); w0.w = pk2(r[6], r[7]);
        w1.x = pk2(r[8], r[9]); w1.y = pk2(r[10], r[11]); w1.z = pk2(r[12], r[13]); w1.w = pk2(r[14], r[15]);
        bf16_t* mp = MIX + (size_t)(t0 + t) * 1024 + h * 128 + part * 16; *(u32x4*)mp = w0; *(u32x4*)(mp + 8) = w1;
        lds_barrier();
    }
}

template <int MODE> DI void attn_phase(LAS unsigned char* lds, PRef p, int layer, int first = -1, int stride = 0) {
    LAS bf16_t* Ks = (LAS bf16_t*)lds;
    LAS bf16_t* Vt = (LAS bf16_t*)(lds + 36864);
    const bf16_t* Qb = (const bf16_t*)(uni(p.ws) + WS_P2); bf16_t* MIX = (bf16_t*)(uni(p.ws) + WS_MIX);
    const bf16_t* MKV = (const bf16_t*)(uni(p.ws) + WS_MKV); const bf16_t* KV = (const bf16_t*)(uni(p.ws) + WS_KV);
    const int tid = tidx(), lane = tid & 63, wave = tid >> 6, r16 = lane & 15, q = lane >> 4;
    const int nitems = MODE == 0 ? 256 : 512;
    if (first < 0) { first = bidx(); stride = gridDim.x; }
#pragma unroll 1
    for (int it = first; it < nitems; it += stride) {
        int b, hh, tb; size_t tok0;
        if (MODE == 0) { b = it >> 7; hh = (it >> 5) & 3; tb = it & 31; tok0 = (size_t)b * SEQ + tb * 512; }
        else { b = it >> 8; hh = (it >> 7) & 1; tb = it & 127; tok0 = (size_t)b * SEQ + tb * 128; }
#pragma unroll 1
        for (int i = 0; i < 4; ++i) {
            const int id = tid + NT * i, rr = id >> 3, pc = id & 7; u32x4 kv = {0u, 0u, 0u, 0u}, vv = {0u, 0u, 0u, 0u};
            if (MODE == 0) { const bf16_t* kp = MKV + (size_t)(b * 256 + rr) * 2048 + layer * 512 + hh * 64 + pc * 8; kv = *(const u32x4*)kp; vv = *(const u32x4*)(kp + 256); }
            else if (tb > 0 || rr >= 128) { const bf16_t* kp = KV + (tok0 - 128 + rr) * 256 + hh * 64 + pc * 8; kv = *(const u32x4*)kp; vv = *(const u32x4*)(kp + 128); }
            *(LAS u32x4*)(Ks + rr * 72 + pc * 8) = kv;
            LAS bf16_t* vp = Vt + (pc * 8) * 264 + tslot(rr);
            vp[0] = (bf16_t)(vv.x & 0xffffu); vp[264] = (bf16_t)(vv.x >> 16); vp[2 * 264] = (bf16_t)(vv.y & 0xffffu); vp[3 * 264] = (bf16_t)(vv.y >> 16);
            vp[4 * 264] = (bf16_t)(vv.z & 0xffffu); vp[5 * 264] = (bf16_t)(vv.z >> 16); vp[6 * 264] = (bf16_t)(vv.w & 0xffffu); vp[7 * 264] = (bf16_t)(vv.w >> 16);
        }
        lds_barrier();
        const int npass = MODE == 0 ? 32 : 48;
#pragma unroll 1
        for (int ps = wave; ps < npass; ps += 8) {
            int rt, colbase; float sink = 0.f;
            if (MODE == 0) { rt = ps; colbase = 768 + hh * 64; }
            else { const int hq = hh * 6 + (ps >> 3); rt = ps & 7; colbase = hq * 64; sink = uni(p.swa_sinks)[(layer - 2) * 12 + hq]; }
            const size_t tok = tok0 + 16 * rt + r16;
            const bf16_t* qp = Qb + tok * 1024 + colbase + 8 * q;
            const bf16x8 qf0 = *(const bf16x8*)qp, qf1 = *(const bf16x8*)(qp + 32);
            float m = MODE == 1 ? sink : -INFINITY, l = (MODE == 1 && q == 0) ? 1.f : 0.f;
            f32x4 ot[4];
#pragma unroll
            for (int dt = 0; dt < 4; ++dt) ot[dt] = (f32x4){0.f, 0.f, 0.f, 0.f};
            int kk0 = 0, kk1 = 7;
            if (MODE == 1) { kk0 = rt >> 1; if (tb == 0 && kk0 < 4) kk0 = 4; kk1 = (16 * rt + 143) >> 5; }
#pragma unroll 1
            for (int kk = kk0; kk <= kk1; ++kk) {
                const LAS bf16_t* kr = Ks + (32 * kk + r16) * 72 + 8 * q;
                f32x4 s0 = {0.f, 0.f, 0.f, 0.f}, s1 = {0.f, 0.f, 0.f, 0.f};
                s0 = MFMA16(*(const LAS bf16x8*)kr, qf0, s0); s0 = MFMA16(*(const LAS bf16x8*)(kr + 32), qf1, s0);
                s1 = MFMA16(*(const LAS bf16x8*)(kr + 16 * 72), qf0, s1); s1 = MFMA16(*(const LAS bf16x8*)(kr + 16 * 72 + 32), qf1, s1);
                if (MODE == 1) {
#pragma unroll
                    for (int j = 0; j < 4; ++j) { const int d0 = 16 * rt + r16 + 128 - (32 * kk + 4 * q + j), d1 = d0 - 16;
                        if (d0 < 0 || d0 >= 128) s0[j] = -INFINITY; if (d1 < 0 || d1 >= 128) s1[j] = -INFINITY; }
                }
                float gm = fmaxf(fmaxf(fmaxf(s0[0], s0[1]), fmaxf(s0[2], s0[3])), fmaxf(fmaxf(s1[0], s1[1]), fmaxf(s1[2], s1[3])));
                gm = fmaxf(gm, shx(gm, 16)); gm = fmaxf(gm, shx(gm, 32));
                const float mn = fmaxf(m, gm), sc = __expf(m - mn); m = mn; l *= sc;
#pragma unroll
                for (int dt = 0; dt < 4; ++dt) ot[dt] = ot[dt] * sc;
#pragma unroll
                for (int j = 0; j < 4; ++j) { s0[j] = __expf(s0[j] - mn); s1[j] = __expf(s1[j] - mn); l += s0[j] + s1[j]; }
                const bf16x8 pb = pack8(s0, s1);
#pragma unroll
                for (int dt = 0; dt < 4; ++dt) ot[dt] = MFMA16(*(const LAS bf16x8*)(Vt + (16 * dt + r16) * 264 + 32 * kk + 8 * q), pb, ot[dt]);
            }
            l += shx(l, 16); l += shx(l, 32);
            const float inv = 1.f / l; bf16_t* op = MIX + tok * 1024 + colbase + 4 * q;
#pragma unroll
            for (int dt = 0; dt < 4; ++dt) { u32x2 w; w.x = pk2(ot[dt][0] * inv, ot[dt][1] * inv); w.y = pk2(ot[dt][2] * inv, ot[dt][3] * inv); *(u32x2*)(op + 16 * dt) = w; }
        }
        lds_barrier();
    }
}

constexpr int PARAM_OFF = 131072;
DI void grid_bar(unsigned* bar, unsigned gen) {
    __syncthreads();
    if (threadIdx.x == 0) {
        __builtin_amdgcn_fence(__ATOMIC_RELEASE, "agent");
        const unsigned g = blockIdx.x & 7u, ngrp = (gridDim.x + 7u - g) >> 3;
        const unsigned old = __hip_atomic_fetch_add(bar + 64 + 64 * g, 1u, __ATOMIC_RELAXED, __HIP_MEMORY_SCOPE_AGENT);
        if (old + 1u == gen * ngrp) __hip_atomic_fetch_add(bar, 1u, __ATOMIC_RELAXED, __HIP_MEMORY_SCOPE_AGENT);
        const unsigned target = gen * (gridDim.x < 8u ? gridDim.x : 8u);
        while (__hip_atomic_load(bar, __ATOMIC_RELAXED, __HIP_MEMORY_SCOPE_AGENT) < target) __builtin_amdgcn_s_sleep(1);
        __builtin_amdgcn_fence(__ATOMIC_ACQUIRE, "agent");
    }
    __syncthreads();
}
enum { K_P0 = 0, K_GEMM, K_CHUNK, K_SCAN, K_GATE, K_ATTN, K_NORMFFN, K_POST, K_FINAL, K_NOP };

DI void gemm_step(LAS unsigned char* lds, PRef p, int gid, int layer) {
    unsigned char* ws = uni(p.ws); unsigned char* slot = ws + WS_WA0 + (size_t)(layer & 1) * WSLOT;
    const bf16_t* A = (const bf16_t*)(ws + WS_H); const bf16_t* Bt = (const bf16_t*)(slot + WO_IN); int M = MT, N = 1024, K = 1024;
    Epi E{0, 0, nullptr, nullptr, nullptr, nullptr, (const float*)(ws + WS_CS), (float*)(ws + WS_SSQ)};
    if (gid == 0) { A = (const bf16_t*)(ws + WS_MEMN); Bt = (const bf16_t*)(ws + WS_WMKV); M = 512; N = 2048; E.mode = 0; E.ldc = 2048; E.o0 = (bf16_t*)(ws + WS_MKV); }
    else if (gid == 1) { N = 3584; E.mode = 1; E.o0 = (bf16_t*)(ws + WS_P1); E.o1 = (bf16_t*)(ws + WS_P2); E.f0 = (float*)(ws + WS_AB); }
    else if (gid == 2) { E.mode = 2; E.o0 = (bf16_t*)(ws + WS_P2); }
    else if (gid == 3) { Bt = (const bf16_t*)(ws + WS_WKV); N = 256; E.mode = 3; E.o0 = (bf16_t*)(ws + WS_KV); }
    else if (gid == 4) { A = (const bf16_t*)(ws + WS_MIX); Bt = (const bf16_t*)(slot + WO_OUT); E.mode = 4; E.f0 = uni(p.out); E.base = layer == 0 ? uni(p.x) : uni(p.out); E.o0 = (bf16_t*)(ws + WS_H); }
    else if (gid == 5) { Bt = (const bf16_t*)(slot + WO_GU); N = 5632; E.mode = 5; E.o0 = (bf16_t*)(ws + WS_ACT); }
    else { A = (const bf16_t*)(ws + WS_ACT); Bt = (const bf16_t*)(slot + WO_DN); K = DFF; E.mode = 4; E.f0 = uni(p.out); E.base = uni(p.out); E.o0 = (bf16_t*)(ws + WS_H); }
    E.o0 = uni(E.o0); E.o1 = uni(E.o1); E.f0 = uni(E.f0); E.base = uni(E.base); E.cs = uni(E.cs); E.ssq = uni(E.ssq);
    run_gemm(lds, uni(A), uni(Bt), M, N, K, E);
}

__global__ void __launch_bounds__(NT, 2) yoco_fwd(Params pin) {
    extern __shared__ __attribute__((aligned(16))) unsigned char lds_raw[];
    LAS unsigned char* lds = (LAS unsigned char*)lds_raw;
    cg::grid_group grid = cg::this_grid();
    if (blockIdx.x == 0) { ((unsigned*)pin.ws)[threadIdx.x] = 0u; ((unsigned*)pin.ws)[threadIdx.x + NT] = 0u; }
    { const unsigned* src = (const unsigned*)&pin; if (tidx() < sizeof(Params) / 4) ((LAS unsigned*)(lds + PARAM_OFF))[tidx()] = src[tidx()]; }
    __syncthreads();
#define PP pin
    {
        PRef p = PP; unsigned char* ws = uni(p.ws);
        conv_layer_weights(lds, p, 0, ws + WS_WA0, -1, 0, 3);
        wconv(lds, uni(p.w_kv), 1024, 256, (bf16_t*)(ws + WS_WKV), 256, 3, uni(p.ln_kv));
#pragma unroll 1
        for (int l = 0; l < 4; ++l) wconv(lds, uni(p.w_mem_kv) + (size_t)l * 1024 * 512, 1024, 512, (bf16_t*)(ws + WS_WMKV) + (size_t)l * 512 * 1024, 512, 0);
        rope_table(p);
        norm_rows(uni(p.mem), uni(p.ln_mem), (bf16_t*)(ws + WS_MEMN), 512);
        xb_rows(uni(p.x), (bf16_t*)(ws + WS_H), (float*)(ws + WS_SSQ), MT);
        grid.sync();
    }
    constexpr int NSTEP = 14 + 10;
#pragma unroll 1
    for (int s = 0; s < NSTEP; ++s) {
        int kind, layer, gid = 0;
        if (s < 14) { const int k = s % 7; layer = s / 7;
            kind = k == 0 ? K_GEMM : k == 1 ? K_CHUNK : k == 2 ? K_SCAN : k == 3 ? K_GATE : K_GEMM;
            gid = k == 0 ? 1 : k == 4 ? 4 : k == 5 ? 5 : 6; }
        else { const int t = s - 14, k = t % 5; layer = 2 + t / 5;
            kind = k == 1 ? K_ATTN : K_GEMM;
            gid = k == 0 ? 2 : k == 2 ? 4 : k == 3 ? 5 : 6; }
        if (kind == K_GEMM) {
            int g = (s == 0) ? 0 : gid;
            for (;;) { gemm_step(lds, PP, g, layer); if (g == 0) g = gid; else if (g == 2 && layer == 2) g = 3; else break; }
        }
        else if (kind == K_CHUNK) gdn_chunk_phase(lds, PP, layer);
        else if (kind == K_SCAN) { gdn_scan_phase(lds, PP);
            if (bidx() >= SCAN_NBLK) {
                const int f = bidx() - SCAN_NBLK, st = gridDim.x - SCAN_NBLK;
                attn_phase<0>(lds, PP, layer, f, st);
                PRef p = PP;
                if (layer == 0) { conv_layer_weights(lds, p, 0, uni(p.ws) + WS_WA0, f, st, 12); conv_layer_weights(lds, p, 1, uni(p.ws) + WS_WA0 + WSLOT, f, st); }
                else conv_layer_weights(lds, p, 2, uni(p.ws) + WS_WA0, f, st); } }
        else if (kind == K_GATE) gdn_gate_phase(lds, PP, layer);
        else { attn_phase<1>(lds, PP, layer); attn_phase<0>(lds, PP, layer);
            if (layer == 2) { PRef p = PP; conv_layer_weights(lds, p, 3, uni(p.ws) + WS_WA0 + WSLOT); } }
        grid_bar((unsigned*)pin.ws, (unsigned)(s + 1));
    }
    { PRef p = PP; final_norm(uni(p.out), uni(p.ln_final), MT); }
#undef PP
}

extern "C" void kernel_launch(void* const* d_in, const int* in_sizes, int n_in, void* d_out, int out_size, void* d_ws, size_t ws_size, hipStream_t stream) {
    static int grid = 0;
    if (grid == 0) {
        if (n_in != 20 || out_size != MT * DMODEL || ws_size < WS_END) { fprintf(stderr, "kernel_launch: unexpected shapes (n_in %d, out %d, ws %zu)\n", n_in, out_size, ws_size); grid = -1; return; }
        int dev = 0, cus = 0, per_cu = 0;
        (void)hipGetDevice(&dev); (void)hipDeviceGetAttribute(&cus, hipDeviceAttributeMultiprocessorCount, dev);
        if (hipFuncSetAttribute((const void*)yoco_fwd, hipFuncAttributeMaxDynamicSharedMemorySize, LDS_BYTES) != hipSuccess) { fprintf(stderr, "kernel_launch: hipFuncSetAttribute failed\n"); grid = -1; return; }
        (void)hipOccupancyMaxActiveBlocksPerMultiprocessor(&per_cu, (const void*)yoco_fwd, NT, LDS_BYTES);
        (void)hipGetLastError();
        if (per_cu < 1) fprintf(stderr, "kernel_launch: occupancy query says %d blocks/CU\n", per_cu);
        grid = cus > 0 ? cus : 256;
    }
    if (grid < 0) return;
    Params p{};
    p.x = (const float*)d_in[0]; p.mem = (const float*)d_in[1]; p.pos = (const int*)d_in[2]; p.ln_mix = (const float*)d_in[3]; p.ln_ffn = (const float*)d_in[4]; p.ln_mem = (const float*)d_in[5];
    p.w_mem_kv = (const float*)d_in[6]; p.w_out = (const float*)d_in[7]; p.w_gate_up = (const float*)d_in[8]; p.w_down = (const float*)d_in[9]; p.gdn_w_in = (const float*)d_in[10];
    p.gdn_conv = (const float*)d_in[11]; p.gdn_A_log = (const float*)d_in[12]; p.gdn_dt_bias = (const float*)d_in[13]; p.gdn_norm = (const float*)d_in[14]; p.swa_w_q = (const float*)d_in[15];
    p.swa_sinks = (const float*)d_in[16]; p.ln_kv = (const float*)d_in[17]; p.w_kv = (const float*)d_in[18]; p.ln_final = (const float*)d_in[19];
    p.out = (float*)d_out; p.ws = (unsigned char*)d_ws;
    for (int i = 0; i < 8; ++i) p.inv[i] = (float)pow(500000.0, -(double)(2 * i) / 16.0);
    void* args[] = {&p};
    hipError_t e = hipLaunchCooperativeKernel((const void*)yoco_fwd, dim3(grid), dim3(NT), args, LDS_BYTES, stream);
    if (e != hipSuccess) fprintf(stderr, "kernel_launch: cooperative launch failed: %s (grid %d)\n", hipGetErrorString(e), grid);
}
```

```cpp
#include <hip/hip_runtime.h>
#include <hip/hip_cooperative_groups.h>
#include <cstdio>
#include <cstdint>
#include <cmath>
namespace cg = cooperative_groups;
__device__ __forceinline__ int tidx() { int t = threadIdx.x; asm volatile("" : "+v"(t)); return t; }
__device__ __forceinline__ int bidx() { int b = blockIdx.x; asm volatile("" : "+s"(b)); return b; }
namespace pg8 {
#define PG8_LAS __attribute__((address_space(3)))
typedef unsigned short bf16_t;
typedef short bf16x8 __attribute__((ext_vector_type(8)));
typedef float f32x4 __attribute__((ext_vector_type(4)));
typedef unsigned u32x4 __attribute__((ext_vector_type(4)));
constexpr int BM = 256, BK = 64, HALF = 128, HTB = HALF * BK * 2  , STAGE_BYTES = 8 * HTB, NXCD = 8, WGM = 8;

__host__ __device__ __forceinline__ int lds_byte(int r, int c) { const int st = (r >> 4) * 2 + (c >> 5), rr = r & 15, cc = c & 31, ob = rr * 64 + cc * 2; return st * 1024 + (ob ^ (((ob >> 9) & 1) << 5)); }
__host__ __device__ __forceinline__ void stage_rc(int b, int& R, int& C) { const int st = b / 1024, sb = b % 1024, swz = sb ^ (((sb >> 9) & 1) << 5); R = (st >> 1) * 16 + swz / 64; C = (st & 1) * 32 + (swz % 64) / 2; }
__host__ __device__ __forceinline__ int perm32(int rho) { const int n = rho >> 4, i = rho & 15; return 8 * (i >> 2) + 4 * n + (i & 3); }

struct Unit { int pm, pn; };
struct Gemm { const bf16_t* A; const bf16_t* Bt; int M, N, K; };

struct StaticOrder {
    int nM, nN, nwg, G, c;
    __host__ __device__ void init(int M, int N, int G_, int c_) { nM = M / BM; nN = N / BM; nwg = nM * nN; G = G_; c = c_; }
    __host__ __device__ bool next(int i, Unit& u) const {
        const long L = (long)i * G + c; if (L >= nwg) return false;
        int wgid = (int)L; { const int q = nwg / NXCD, r = nwg % NXCD, xcd = wgid % NXCD, off = wgid / NXCD; wgid = (xcd < r ? xcd * (q + 1) : r * (q + 1) + (xcd - r) * q) + off; }
        const int nig = WGM * nN, gid = wgid / nig, fm = gid * WGM, gsz = (nM - fm) < WGM ? (nM - fm) : WGM;
        u.pm = fm + ((wgid % nig) % gsz); u.pn = (wgid % nig) / gsz; return true;
    }
    __device__ __forceinline__ void a_ready(const Unit&) const {}
    __device__ __forceinline__ void done(const Unit&) const {}
};
template <class Epi, class Sched, bool ALIGN_EPI = false, bool SP2 = false>
__device__ __forceinline__ void gemm_phase(PG8_LAS unsigned char* lds, const Gemm g, const Sched& S, const Epi& E) {
    const int tid = tidx(), wid = __builtin_amdgcn_readfirstlane(tid >> 6), lane = tid & 63, wr = wid >> 2, wc = wid & 3, fr = lane & 15, fq = lane >> 4;
    const int K = g.K, nt = K / BK;
    unsigned voffA[2], voffB[2];
#pragma unroll
    for (int i = 0; i < 2; ++i) { int R, C; stage_rc(tid * 16 + i * 8192, R, C); const int Rb = Epi::PERM ? ((R & ~31) + perm32(R & 31)) : R;
        voffA[i] = (unsigned)(R * K + C) * 2u; voffB[i] = (unsigned)(Rb * K + C) * 2u; }
    const size_t kstep = (size_t)(BK * 2);
    const size_t hstep = (size_t)HALF * K * 2;
    const size_t tstep = 2 * hstep;
    const unsigned ldsw = (unsigned)wid * 1024u;
    const int aoff = lds_byte(wr * 64 + fr, fq * 8), boff = lds_byte(wc * 32 + fr, fq * 8);
#define PG8_SA(b, h) (((b) * 2 + (h)) * HTB)
#define PG8_SB(b, h) ((4 + (b) * 2 + (h)) * HTB)
#define PG8_STAGE(bufoff, gbase, voff) do { _Pragma("unroll") for (int _i = 0; _i < 2; ++_i) \
        __builtin_amdgcn_global_load_lds((const unsigned*)((const char*)(gbase) + (voff)[_i]), (PG8_LAS unsigned*)(lds + (bufoff) + ldsw + _i * 8192), 16, 0, 0); } while (0)
#define PG8_LDA(dst, b, h) do { _Pragma("unroll") for (int m = 0; m < 4; ++m) _Pragma("unroll") for (int k = 0; k < 2; ++k) dst[m][k] = *(const PG8_LAS bf16x8*)(lds + PG8_SA(b, h) + aoff + m * 2048 + k * 1024); } while (0)
#define PG8_LDB(dst, b, h) do { _Pragma("unroll") for (int n = 0; n < 2; ++n) _Pragma("unroll") for (int k = 0; k < 2; ++k) dst[n][k] = *(const PG8_LAS bf16x8*)(lds + PG8_SB(b, h) + boff + n * 2048 + k * 1024); } while (0)
#define PG8_MMA(ai, bj, At, Bt) do { __builtin_amdgcn_s_setprio(1); _Pragma("unroll") for (int m = 0; m < 4; ++m) _Pragma("unroll") for (int n = 0; n < 2; ++n) _Pragma("unroll") for (int k = 0; k < 2; ++k) \
        acc[ai][bj][m][n] = __builtin_amdgcn_mfma_f32_16x16x32_bf16(Bt[n][k], At[m][k], acc[ai][bj][m][n], 0, 0, 0); __builtin_amdgcn_s_setprio(0); } while (0)
#define PG8_WAIT_V(n) asm volatile("s_waitcnt vmcnt(" #n ")" ::: "memory")
#define PG8_WAIT_L(n) asm volatile("s_waitcnt lgkmcnt(" #n ")" ::: "memory")
#define PG8_BAR __builtin_amdgcn_s_barrier()
#define PG8_SCHED __builtin_amdgcn_sched_barrier(0)
    Unit cur, nxt; int ui = 0;
    if (!S.next(0, cur)) return;
    f32x4 acc[2][2][4][2];
#pragma unroll
    for (int a = 0; a < 2; ++a)
#pragma unroll
        for (int b = 0; b < 2; ++b)
#pragma unroll
            for (int m = 0; m < 4; ++m)
#pragma unroll
                for (int n = 0; n < 2; ++n) acc[a][b][m][n] = (f32x4){0.f, 0.f, 0.f, 0.f};
    bf16x8 At[4][2], B0[2][2], B1[2][2];
    const char* cA = (const char*)g.A + (size_t)cur.pm * tstep; const char* cB = (const char*)g.Bt + (size_t)cur.pn * tstep;
    S.a_ready(cur);
    if constexpr (SP2) {
        PG8_STAGE(PG8_SB(0, 0), cB, voffB); PG8_STAGE(PG8_SB(0, 1), cB + hstep, voffB); PG8_STAGE(PG8_SA(0, 0), cA, voffA); PG8_STAGE(PG8_SA(0, 1), cA + hstep, voffA);
        if (wr == 1) PG8_BAR;
        PG8_WAIT_V(2); PG8_BAR;
        PG8_STAGE(PG8_SB(1, 0), cB + kstep, voffB); PG8_STAGE(PG8_SA(1, 0), cA + kstep, voffA); PG8_STAGE(PG8_SB(1, 1), cB + hstep + kstep, voffB);
        PG8_WAIT_V(6); PG8_BAR;
    } else {
        PG8_STAGE(PG8_SB(0, 0), cB, voffB); PG8_STAGE(PG8_SA(0, 0), cA, voffA); PG8_STAGE(PG8_SB(0, 1), cB + hstep, voffB); PG8_STAGE(PG8_SA(0, 1), cA + hstep, voffA);
        if (wr == 1) PG8_BAR;
        PG8_WAIT_V(4); PG8_BAR;
        PG8_STAGE(PG8_SB(1, 0), cB + kstep, voffB); PG8_STAGE(PG8_SA(1, 0), cA + kstep, voffA); PG8_STAGE(PG8_SB(1, 1), cB + hstep + kstep, voffB);
        PG8_WAIT_V(6); PG8_BAR;
    }
    for (;;) {
        const bool has_next = S.next(ui + 1, nxt);
        const char* nA = has_next ? (const char*)g.A + (size_t)nxt.pm * tstep : cA; const char* nB = has_next ? (const char*)g.Bt + (size_t)nxt.pn * tstep : cB;
        for (int t = 0; t < nt; t += 2) {
            const bool last = (t == nt - 2);
            const char* a1 = cA + (size_t)(t + 1) * kstep;
            const char* a2 = last ? nA : cA + (size_t)(t + 2) * kstep; const char* b2 = last ? nB : cB + (size_t)(t + 2) * kstep;
            const char* a3 = a2 + kstep; const char* b3 = b2 + kstep;
            if (last && has_next) S.a_ready(nxt);
            if constexpr (SP2) {
            PG8_LDB(B0, 0, 0); PG8_LDB(B1, 0, 1); PG8_SCHED; PG8_LDA(At, 0, 0); PG8_STAGE(PG8_SA(1, 1), a1 + hstep, voffA);
            PG8_WAIT_V(8); PG8_WAIT_L(0); PG8_BAR; PG8_MMA(0, 0, At, B0); PG8_MMA(0, 1, At, B1); PG8_BAR; PG8_SCHED;
            PG8_LDA(At, 0, 1); PG8_STAGE(PG8_SB(0, 0), b2, voffB); PG8_STAGE(PG8_SB(0, 1), b2 + hstep, voffB); PG8_STAGE(PG8_SA(0, 0), a2, voffA);
            PG8_WAIT_V(8); PG8_WAIT_L(0); PG8_BAR; PG8_MMA(1, 0, At, B0); PG8_MMA(1, 1, At, B1); PG8_BAR; PG8_SCHED;
            PG8_LDB(B0, 1, 0); PG8_LDB(B1, 1, 1); PG8_SCHED; PG8_LDA(At, 1, 0); PG8_STAGE(PG8_SA(0, 1), a2 + hstep, voffA);
            PG8_WAIT_V(8); PG8_WAIT_L(0); PG8_BAR; PG8_MMA(0, 0, At, B0); PG8_MMA(0, 1, At, B1); PG8_BAR; PG8_SCHED;
            PG8_LDA(At, 1, 1); PG8_STAGE(PG8_SB(1, 0), b3, voffB); PG8_STAGE(PG8_SB(1, 1), b3 + hstep, voffB); PG8_STAGE(PG8_SA(1, 0), a3, voffA);
            PG8_WAIT_V(8); PG8_WAIT_L(0); PG8_BAR; PG8_MMA(1, 0, At, B0); PG8_MMA(1, 1, At, B1); PG8_BAR; PG8_SCHED;
            } else {
            PG8_LDB(B0, 0, 0); PG8_SCHED; PG8_LDA(At, 0, 0); PG8_STAGE(PG8_SA(1, 1), a1 + hstep, voffA);
            PG8_WAIT_L(8); PG8_BAR; PG8_WAIT_L(0); PG8_MMA(0, 0, At, B0); PG8_BAR; PG8_SCHED;
            PG8_LDB(B1, 0, 1); PG8_STAGE(PG8_SB(0, 0), b2, voffB);
            PG8_BAR; PG8_WAIT_L(0); PG8_MMA(0, 1, At, B1); PG8_BAR;
            PG8_LDA(At, 0, 1); PG8_STAGE(PG8_SA(0, 0), a2, voffA);
            PG8_BAR; PG8_WAIT_L(0); PG8_MMA(1, 0, At, B0); PG8_BAR; PG8_SCHED;
            PG8_STAGE(PG8_SB(0, 1), b2 + hstep, voffB);
            PG8_WAIT_V(6); PG8_BAR; PG8_MMA(1, 1, At, B1); PG8_BAR;
            PG8_LDB(B0, 1, 0); PG8_SCHED; PG8_LDA(At, 1, 0); PG8_STAGE(PG8_SA(0, 1), a2 + hstep, voffA);
            PG8_WAIT_L(8); PG8_BAR; PG8_WAIT_L(0); PG8_MMA(0, 0, At, B0); PG8_BAR; PG8_SCHED;
            PG8_LDB(B1, 1, 1); PG8_STAGE(PG8_SB(1, 0), b3, voffB);
            PG8_BAR; PG8_WAIT_L(0); PG8_MMA(0, 1, At, B1); PG8_BAR;
            PG8_LDA(At, 1, 1); PG8_STAGE(PG8_SA(1, 0), a3, voffA);
            PG8_BAR; PG8_WAIT_L(0); PG8_MMA(1, 0, At, B0); PG8_BAR; PG8_SCHED;
            PG8_STAGE(PG8_SB(1, 1), b3 + hstep, voffB);
            PG8_WAIT_V(6); PG8_BAR; PG8_MMA(1, 1, At, B1); PG8_BAR;
            }
        }
        if constexpr (ALIGN_EPI) { if (wr == 0) PG8_BAR; }
        if constexpr (!Epi::AFTER_DRAIN) { E(acc, cur, wr, wc, fr, fq); S.done(cur); }
        if (!has_next) break;
#pragma unroll
        for (int a = 0; a < 2; ++a)
#pragma unroll
            for (int b = 0; b < 2; ++b)
#pragma unroll
                for (int m = 0; m < 4; ++m)
#pragma unroll
                    for (int n = 0; n < 2; ++n) acc[a][b][m][n] = (f32x4){0.f, 0.f, 0.f, 0.f};
        cur = nxt; cA = nA; cB = nB; ++ui;
        if constexpr (ALIGN_EPI) { if (wr == 1) PG8_BAR; }
    }
    PG8_WAIT_V(0);
    if constexpr (!ALIGN_EPI) { if (wr == 0) PG8_BAR; }
    PG8_BAR;
    if constexpr (Epi::AFTER_DRAIN) { E.fused(acc, cur, wr, wc, fr, fq, lds, wid, lane); S.done(cur); }
#undef PG8_SA
#undef PG8_SB
#undef PG8_STAGE
#undef PG8_LDA
#undef PG8_LDB
#undef PG8_MMA
#undef PG8_WAIT_V
#undef PG8_WAIT_L
#undef PG8_BAR
#undef PG8_SCHED
}
}

#define DI __device__ __forceinline__
#define LAS __attribute__((address_space(3)))
typedef unsigned short bf16_t;
typedef short bf16x8 __attribute__((ext_vector_type(8)));
typedef float f32x4 __attribute__((ext_vector_type(4)));
typedef unsigned u32x4 __attribute__((ext_vector_type(4)));
typedef unsigned u32x2 __attribute__((ext_vector_type(2)));

constexpr int NT = 512;
constexpr int MT = 32768, SEQ = 16384, DMODEL = 1024, DFF = 2816;
constexpr int NITEM = 3072;
constexpr size_t MiB = 1u << 20;
constexpr size_t WS_CS = 1 * MiB;
constexpr size_t WS_AB = 3 * MiB;
constexpr size_t WS_MEMN = 5 * MiB;
constexpr size_t WS_MKV = 6 * MiB;
constexpr size_t WS_WMKV = 8 * MiB;
constexpr size_t WS_WKV = 12 * MiB;
constexpr size_t WS_GL = 13 * MiB;
constexpr size_t WS_KV = 14 * MiB;
constexpr size_t WS_WA0 = 30 * MiB;
constexpr size_t WSLOT = 26 * MiB;
constexpr size_t WO_IN = 0, WO_OUT = 7 * MiB, WO_GU = 9 * MiB, WO_DN = 20 * MiB;
constexpr size_t WS_P1 = 82 * MiB;
constexpr size_t WS_OT = 82 * MiB;
constexpr size_t WS_MIX = 130 * MiB;
constexpr size_t WS_ACT = 82 * MiB;
constexpr size_t WS_HKV = 82 * MiB;
constexpr size_t WS_P2 = 226 * MiB;
constexpr size_t WS_H = 290 * MiB;
constexpr size_t WS_QG = 290 * MiB;
constexpr size_t WS_KGT = 338 * MiB;
constexpr size_t WS_UT = 386 * MiB;
constexpr size_t WS_WP = 434 * MiB;
constexpr size_t WS_AI = 482 * MiB;
constexpr size_t WS_WB0 = 386 * MiB;
constexpr size_t WS_SSQ = 506 * MiB;
constexpr size_t WS_END = 508 * MiB;
constexpr int LDS_BYTES = 135168;

struct Params {
    const float* x; const float* mem; const int* pos; const float* ln_mix; const float* ln_ffn; const float* ln_mem;
    const float* w_mem_kv; const float* w_out; const float* w_gate_up; const float* w_down; const float* gdn_w_in;
    const float* gdn_conv; const float* gdn_A_log; const float* gdn_dt_bias; const float* gdn_norm; const float* swa_w_q;
    const float* swa_sinks; const float* ln_kv; const float* w_kv; const float* ln_final;
    float* out; unsigned char* ws;
    float inv[8];
};

typedef const Params& PRef;
DI unsigned f2bf(float f) { unsigned u = __float_as_uint(f); return (u + 0x7fffu + ((u >> 16) & 1u)) >> 16; }
typedef float f32x2_t __attribute__((ext_vector_type(2)));
typedef __bf16 bf16x2_t __attribute__((ext_vector_type(2)));
DI unsigned pk2(float lo, float hi) { f32x2_t v = {lo, hi}; bf16x2_t b = __builtin_convertvector(v, bf16x2_t); return __builtin_bit_cast(unsigned, b); }
DI float bflo(unsigned w) { return __uint_as_float(w << 16); }
DI float bfhi(unsigned w) { return __uint_as_float(w & 0xffff0000u); }
DI float bf2f(bf16_t b) { return __uint_as_float((unsigned)b << 16); }
DI bf16x8 pack8(f32x4 a, f32x4 b) { u32x4 p; p.x = pk2(a[0], a[1]); p.y = pk2(a[2], a[3]); p.z = pk2(b[0], b[1]); p.w = pk2(b[2], b[3]); return __builtin_bit_cast(bf16x8, p); }
DI float shx(float v, int mask) { const int ln = tidx() & 63; return __builtin_bit_cast(float, __builtin_amdgcn_ds_bpermute((ln ^ mask) << 2, __builtin_bit_cast(int, v))); }
DI float shup(float v, int d) { const int ln = tidx() & 63; return __builtin_bit_cast(float, __builtin_amdgcn_ds_bpermute((ln - d) << 2, __builtin_bit_cast(int, v))); }
DI LAS unsigned char* lnd(LAS unsigned char* q) { asm volatile("" : "+v"(q)); return q; }
#define uni(x) (x)
DI void lds_barrier() { asm volatile("s_waitcnt lgkmcnt(0)" ::: "memory"); __builtin_amdgcn_s_barrier(); asm volatile("" ::: "memory"); }
DI float wave_sum(float v) {
#pragma unroll
    for (int o = 32; o; o >>= 1) v += shx(v, o);
    return v; }
DI float siluf(float v) { return v * __builtin_amdgcn_rcpf(1.f + __expf(-v)); }
DI int tslot(int t) { return (t & ~31) + 8 * ((t & 15) >> 2) + 4 * ((t >> 4) & 1) + (t & 3); }
#define MFMA16(a, b, c) __builtin_amdgcn_mfma_f32_16x16x32_bf16((a), (b), (c), 0, 0, 0)

struct Epi {
    static constexpr bool PERM = true, AFTER_DRAIN = false;
    int mode; int ldc; bf16_t* o0; bf16_t* o1; float* f0; const float* base; const float* cs; float* ssq;
    DI void st8(bf16_t* p, f32x4 v0, f32x4 v1) const { u32x4 w; w.x = pk2(v0[0], v0[1]); w.y = pk2(v0[2], v0[3]); w.z = pk2(v1[0], v1[1]); w.w = pk2(v1[2], v1[3]); *(u32x4*)p = w; }
    DI void rope(f32x4& v0, f32x4& v1, int row, int col) const {
        if ((col & 63) < 16) { const f32x4 c = *(const f32x4*)(cs + (size_t)row * 16 + ((col & 63) >> 1)), s = *(const f32x4*)(cs + (size_t)row * 16 + 8 + ((col & 63) >> 1));
            const f32x4 a = v0 * c - v1 * s, b = v1 * c + v0 * s; v0 = a; v1 = b; }
    }
    DI void operator()(const f32x4 (&acc)[2][2][4][2], const pg8::Unit& u, int wr, int wc, int fr, int fq) const {
        const int row0 = u.pm * 256 + wr * 64 + fr;
        float rsv[2][4];
#pragma unroll
        for (int ai = 0; ai < 2; ++ai)
#pragma unroll
            for (int m = 0; m < 4; ++m) rsv[ai][m] = 1.f;
        if (mode != 0 && mode != 4) {
#pragma unroll
            for (int ai = 0; ai < 2; ++ai)
#pragma unroll
                for (int mp = 0; mp < 2; ++mp) {
                    f32x4 t[2][4];
#pragma unroll
                    for (int m = 0; m < 2; ++m) { const f32x4* sp = (const f32x4*)(ssq + (size_t)(row0 + ai * 128 + (2 * mp + m) * 16) * 16); t[m][0] = sp[0]; t[m][1] = sp[1]; t[m][2] = sp[2]; t[m][3] = sp[3]; }
#pragma unroll
                    for (int m = 0; m < 2; ++m) { const f32x4 c = (t[m][0] + t[m][1]) + (t[m][2] + t[m][3]); rsv[ai][2 * mp + m] = rsqrtf(((c[0] + c[1]) + (c[2] + c[3])) * (1.f / 1024.f) + 1e-6f); }
                }
        }
#pragma unroll
        for (int aim = 0; aim < 4; ++aim) { const int ai = aim >> 1, mp = aim & 1;
            f32x4 bs[2][2][2];
            if (mode == 4) {
#pragma unroll
                for (int m = 0; m < 2; ++m)
#pragma unroll
                    for (int bj = 0; bj < 2; ++bj) { const float* bp = base + (size_t)(row0 + ai * 128 + (2 * mp + m) * 16) * 1024 + u.pn * 256 + bj * 128 + wc * 32 + 8 * fq; bs[m][bj][0] = *(const f32x4*)bp; bs[m][bj][1] = *(const f32x4*)(bp + 4); }
            }
#pragma unroll
            for (int m = 2 * mp; m < 2 * mp + 2; ++m) {
                const int row = row0 + ai * 128 + m * 16;
                const float rs = rsv[ai][m]; float ssacc = 0.f;
                if (mode == 5) {
                    const f32x4 g0 = acc[ai][0][m][0] * rs, g1 = acc[ai][0][m][1] * rs, u0 = acc[ai][1][m][0] * rs, u1 = acc[ai][1][m][1] * rs;
                    st8(o0 + (size_t)row * DFF + u.pn * 128 + wc * 32 + 8 * fq, (f32x4){siluf(g0[0]) * u0[0], siluf(g0[1]) * u0[1], siluf(g0[2]) * u0[2], siluf(g0[3]) * u0[3]},
                        (f32x4){siluf(g1[0]) * u1[0], siluf(g1[1]) * u1[1], siluf(g1[2]) * u1[2], siluf(g1[3]) * u1[3]});
                } else
#pragma unroll
                for (int bj = 0; bj < 2; ++bj) {
                    const int col = u.pn * 256 + bj * 128 + wc * 32 + 8 * fq;
                    f32x4 v0 = acc[ai][bj][m][0] * rs, v1 = acc[ai][bj][m][1] * rs;
                    if (mode == 0) { st8(o0 + (size_t)row * ldc + col, v0, v1); }
                    else if (mode == 1) {
                        if (col < 2304) st8(o0 + (size_t)row * 2304 + col, v0, v1);
                        else if (col < 3328) { if (col >= 3072) { v0 = v0 * 0.125f; v1 = v1 * 0.125f; } st8(o1 + (size_t)row * 1024 + (col - 2304), v0, v1); }
                        else if (col == 3328) { *(f32x4*)(f0 + (size_t)row * 16) = v0; *(f32x4*)(f0 + (size_t)row * 16 + 4) = v1; }
                        else if (col == 3336) { *(f32x4*)(f0 + (size_t)row * 16 + 8) = v0; }
                    }
                    else if (mode == 2) { v0 = v0 * 0.125f; v1 = v1 * 0.125f; if (col < 768) rope(v0, v1, row, col); st8(o0 + (size_t)row * 1024 + col, v0, v1); }
                    else if (mode == 3) { if (col < 128) rope(v0, v1, row, col); st8(o0 + (size_t)row * 256 + col, v0, v1); }
                    else if (mode == 4) { float* op = f0 + (size_t)row * 1024 + col;
                        const f32x4 x0 = bs[m & 1][bj][0] + v0, x1 = bs[m & 1][bj][1] + v1; *(f32x4*)op = x0; *(f32x4*)(op + 4) = x1;
                        st8(o0 + (size_t)row * 1024 + col, x0, x1);
                        ssacc += (x0[0] * x0[0] + x0[1] * x0[1]) + (x0[2] * x0[2] + x0[3] * x0[3]) + (x1[0] * x1[0] + x1[1] * x1[1]) + (x1[2] * x1[2] + x1[3] * x1[3]); }

                }
                if (mode == 4) { ssacc += shx(ssacc, 16); ssacc += shx(ssacc, 32); if (fq == 0) ssq[(size_t)row * 16 + u.pn * 4 + wc] = ssacc; }
            }
        }
    }
};

DI void run_gemm(LAS unsigned char* lds, const bf16_t* A, const bf16_t* Bt, int M, int N, int K, const Epi& E) {
    pg8::Gemm g{A, Bt, M, N, K}; pg8::StaticOrder S; const int G = gridDim.x, bx = bidx();
    S.init(M, N, G, bx);
    pg8::gemm_phase<Epi, pg8::StaticOrder, true, true>(lds, g, S, E);
    __syncthreads();
}

DI int wmap(int mode, int n, int N) {
    if (mode == 0) return n < N ? n : -1;
    if (mode == 1) return n < 3072 ? n : (n < 3328 ? 3084 + (n - 3072) : (n < 3340 ? 3072 + (n - 3328) : -1));
    if (mode == 2) { const int u = n >> 8, w = n & 255; return w < 128 ? u * 128 + w : DFF + u * 128 + (w - 128); }
    const int lim = (N == 1024) ? 768 : 128;
    if (n < lim) { const int p = n & 63; if (p < 16) { const int q = p >> 3, jj = p & 7; return (n & ~63) + (jj < 4 ? 4 * q + jj : 8 + 4 * q + (jj - 4)); } }
    return n;
}
DI void wconv(LAS unsigned char* lds, const float* __restrict__ W, int K, int N, bf16_t* Wt, int Nout, int mode, const float* gk = nullptr, int first = -1, int stride = 0) {
    LAS float* tile = (LAS float*)lds; const int tid = tidx(), ntk = K / 64, ntn = Nout / 64;
    if (first < 0) { first = bidx(); stride = gridDim.x; }
    for (int t = first; t < ntk * ntn; t += stride) {
        const int tk = t % ntk, tn = t / ntk, k0 = tk * 64, n0 = tn * 64;
        const int j = tid & 63, kk = tid >> 6; const int c = wmap(mode, n0 + j, N);
#pragma unroll
        for (int i = 0; i < 8; ++i) { const int k = i * 8 + kk; tile[k * 65 + j] = c >= 0 ? W[(size_t)(k0 + k) * N + c] * (gk ? gk[k0 + k] : 1.f) : 0.f; }
        lds_barrier();
        const int nn = tid >> 3, k8 = (tid & 7) * 8; u32x4 o;
        o.x = pk2(tile[(k8 + 0) * 65 + nn], tile[(k8 + 1) * 65 + nn]); o.y = pk2(tile[(k8 + 2) * 65 + nn], tile[(k8 + 3) * 65 + nn]);
        o.z = pk2(tile[(k8 + 4) * 65 + nn], tile[(k8 + 5) * 65 + nn]); o.w = pk2(tile[(k8 + 6) * 65 + nn], tile[(k8 + 7) * 65 + nn]);
        *(u32x4*)(Wt + (size_t)(n0 + nn) * K + k0 + k8) = o;
        lds_barrier();
    }
}
DI void conv_layer_weights(LAS unsigned char* lds, PRef p, int layer, unsigned char* slot, int first = -1, int stride = 0, int mask = 15) {
    if (mask & 1) {
        if (layer < 2) wconv(lds, uni(p.gdn_w_in) + (size_t)layer * 1024 * 3340, 1024, 3340, (bf16_t*)(slot + WO_IN), 3584, 1, uni(p.ln_mix) + layer * 1024, first, stride);
        else wconv(lds, uni(p.swa_w_q) + (size_t)(layer - 2) * 1024 * 1024, 1024, 1024, (bf16_t*)(slot + WO_IN), 1024, 3, uni(p.ln_mix) + layer * 1024, first, stride);
    }
    if (mask & 2) wconv(lds, uni(p.w_out) + (size_t)layer * 1024 * 1024, 1024, 1024, (bf16_t*)(slot + WO_OUT), 1024, 0, nullptr, first, stride);
    if (mask & 4) wconv(lds, uni(p.w_gate_up) + (size_t)layer * 1024 * 5632, 1024, 5632, (bf16_t*)(slot + WO_GU), 5632, 2, uni(p.ln_ffn) + layer * 1024, first, stride);
    if (mask & 8) wconv(lds, uni(p.w_down) + (size_t)layer * DFF * 1024, DFF, 1024, (bf16_t*)(slot + WO_DN), 1024, 0, nullptr, first, stride);
}
DI void norm_rows(const float* x, const float* __restrict__ g, bf16_t* out, int rows) {
    const int lane = tidx() & 63, gw = bidx() * 8 + (tidx() >> 6), nw = gridDim.x * 8;
    for (int r = gw; r < rows; r += nw) {
        const f32x4* xr = (const f32x4*)(x + (size_t)r * 1024); f32x4 v[4]; float ss = 0.f;
#pragma unroll
        for (int i = 0; i < 4; ++i) { v[i] = xr[lane + 64 * i]; ss += v[i][0] * v[i][0] + v[i][1] * v[i][1] + v[i][2] * v[i][2] + v[i][3] * v[i][3]; }
        ss = wave_sum(ss); const float rs = rsqrtf(ss * (1.f / 1024.f) + 1e-6f);
#pragma unroll
        for (int i = 0; i < 4; ++i) { const f32x4 gg = ((const f32x4*)g)[lane + 64 * i]; u32x2 o; o.x = pk2(v[i][0] * rs * gg[0], v[i][1] * rs * gg[1]); o.y = pk2(v[i][2] * rs * gg[2], v[i][3] * rs * gg[3]);
            *(u32x2*)(out + (size_t)r * 1024 + (lane + 64 * i) * 4) = o; }
    }
}
DI void xb_rows(const float* x, bf16_t* out, float* ssq, int rows) {
    const int lane = tidx() & 63, gw = bidx() * 8 + (tidx() >> 6), nw = gridDim.x * 8;
    for (int r = gw; r < rows; r += nw) {
        const f32x4* xr = (const f32x4*)(x + (size_t)r * 1024); f32x4 v[4]; float ss = 0.f;
#pragma unroll
        for (int i = 0; i < 4; ++i) { v[i] = xr[lane + 64 * i]; ss += v[i][0] * v[i][0] + v[i][1] * v[i][1] + v[i][2] * v[i][2] + v[i][3] * v[i][3]; }
        ss = wave_sum(ss);
#pragma unroll
        for (int i = 0; i < 4; ++i) { u32x2 o; o.x = pk2(v[i][0], v[i][1]); o.y = pk2(v[i][2], v[i][3]); *(u32x2*)(out + (size_t)r * 1024 + (lane + 64 * i) * 4) = o; }
        if (lane < 16) ssq[(size_t)r * 16 + lane] = lane == 0 ? ss : 0.f;
    }
}
DI void final_norm(float* x, const float* __restrict__ g, int rows) {
    const int lane = tidx() & 63, gw = bidx() * 8 + (tidx() >> 6), nw = gridDim.x * 8;
    for (int r = gw; r < rows; r += nw) {
        f32x4* xr = (f32x4*)(x + (size_t)r * 1024); f32x4 v[4]; float ss = 0.f;
#pragma unroll
        for (int i = 0; i < 4; ++i) { v[i] = xr[lane + 64 * i]; ss += v[i][0] * v[i][0] + v[i][1] * v[i][1] + v[i][2] * v[i][2] + v[i][3] * v[i][3]; }
        ss = wave_sum(ss); const float rs = rsqrtf(ss * (1.f / 1024.f) + 1e-6f);
#pragma unroll
        for (int i = 0; i < 4; ++i) { const f32x4 gg = ((const f32x4*)g)[lane + 64 * i]; xr[lane + 64 * i] = v[i] * rs * gg; }
    }
}
DI void rope_table(PRef p) {
    float* cs = (float*)(uni(p.ws) + WS_CS);
    for (int idx = bidx() * NT + tidx(); idx < MT * 8; idx += gridDim.x * NT) {
        const int r = idx >> 3, i = idx & 7; const float ang = (float)uni(p.pos)[r] * p.inv[i];
        const double a = (double)ang, k = rint(a * 0.15915494309189535), rr = a - k * 6.283185307179586476925; const double r2 = rr * rr;
        double sn = 1.0 / 51090942171709440000.0, cn = 1.0 / 2432902008176640000.0;
        sn = sn * r2 - 1.0 / 121645100408832000.0; cn = cn * r2 - 1.0 / 6402373705728000.0;
        sn = sn * r2 + 1.0 / 355687428096000.0;    cn = cn * r2 + 1.0 / 20922789888000.0;
        sn = sn * r2 - 1.0 / 1307674368000.0;      cn = cn * r2 - 1.0 / 87178291200.0;
        sn = sn * r2 + 1.0 / 6227020800.0;         cn = cn * r2 + 1.0 / 479001600.0;
        sn = sn * r2 - 1.0 / 39916800.0;           cn = cn * r2 - 1.0 / 3628800.0;
        sn = sn * r2 + 1.0 / 362880.0;             cn = cn * r2 + 1.0 / 40320.0;
        sn = sn * r2 - 1.0 / 5040.0;               cn = cn * r2 - 1.0 / 720.0;
        sn = sn * r2 + 1.0 / 120.0;                cn = cn * r2 + 1.0 / 24.0;
        sn = sn * r2 - 1.0 / 6.0;                  cn = cn * r2 - 0.5;
        sn = sn * r2 + 1.0;                        cn = cn * r2 + 1.0;
        sn = sn * rr;
        cs[(size_t)r * 16 + i] = (float)cn; cs[(size_t)r * 16 + 8 + i] = (float)sn;
    }
}

template <int J, int HF> DI void solve_loadh(f32x4 (&buf)[8], const LAS float* Lz) {
    constexpr int g0 = (((J + 1) >> 2) > HF * 8) ? ((J + 1) >> 2) : HF * 8;
#pragma unroll
    for (int g = g0; g < HF * 8 + 8; ++g) buf[g - HF * 8] = *(const LAS f32x4*)(Lz + J * 64 + 4 * g);
}
template <int J, int HF> DI void solve_applyh(f32x2_t (&r2)[32], const f32x4 (&buf)[8]) {
    constexpr int st = (J + 1 > HF * 32) ? J + 1 : HF * 32;
    const float xj = r2[J >> 1][J & 1]; const f32x2_t x2 = {xj, xj};
    if constexpr ((st & 1) && st < HF * 32 + 32) r2[st >> 1][1] -= buf[(st >> 2) - HF * 8][st & 3] * xj;
#pragma unroll
    for (int pp = (st + 1) >> 1; pp < HF * 16 + 16; ++pp) r2[pp] -= (f32x2_t){buf[((2 * pp) >> 2) - HF * 8][(2 * pp) & 3], buf[((2 * pp + 1) >> 2) - HF * 8][(2 * pp + 1) & 3]} * x2;
}
template <int J> DI void solve_steps(f32x2_t (&r2)[32], f32x4 (&ha)[8], f32x4 (&hb)[8], const LAS float* Lz) {
    solve_loadh<J, 1>(hb, Lz);
    solve_applyh<J, 0>(r2, ha);
    solve_loadh<J + 1, 0>(ha, Lz);
    solve_applyh<J, 1>(r2, hb);
    if constexpr (J + 1 < 63) solve_steps<J + 1>(r2, ha, hb, Lz);
}
DI void gdn_chunk_phase(LAS unsigned char* lds, PRef p, int a) {
    const bf16_t* P1 = (const bf16_t*)(uni(p.ws) + WS_P1); const float* ab = (const float*)(uni(p.ws) + WS_AB);
    const float* convw = uni(p.gdn_conv) + (size_t)a * 4 * 2304; const float* A_log = uni(p.gdn_A_log) + a * 6; const float* dtb = uni(p.gdn_dt_bias) + a * 6;
    bf16_t* QG = (bf16_t*)(uni(p.ws) + WS_QG); bf16_t* WP = (bf16_t*)(uni(p.ws) + WS_WP); bf16_t* KGT = (bf16_t*)(uni(p.ws) + WS_KGT); bf16_t* UT = (bf16_t*)(uni(p.ws) + WS_UT);
    bf16_t* AI = (bf16_t*)(uni(p.ws) + WS_AI); float* GL = (float*)(uni(p.ws) + WS_GL);
    LAS float* RHS = (LAS float*)lds;
    LAS unsigned char* RAW = lds;
    LAS bf16_t* Qb = (LAS bf16_t*)(lds + 65536);
    LAS bf16_t* Kb = (LAS bf16_t*)(lds + 65536 + 17408);
    LAS float* Lm = (LAS float*)(lds + 65536 + 34816);
    LAS float* CW = (LAS float*)(lds + 116736);
    LAS float* gcs = (LAS float*)(lds + 122880);
    u32x4 pr[7]; float pcw[3], pbl = 0.f, pal = 0.f, pAl = 0.f, pdt = 0.f;
#define CH_LOAD(itn) do { const int tid_ = tidx(), h_ = (itn) % 6, cn_ = (itn) / 6, n_ = cn_ & 255, t0_ = cn_ * 64; \
        _Pragma("unroll") for (int i = 0; i < 7; ++i) { const int idx = tid_ + NT * i, rr = idx / 48, pc = idx % 48, sec = pc >> 4, off = (pc & 15) * 8; \
            pr[i] = (u32x4){0u, 0u, 0u, 0u}; if (idx < 67 * 48 && (rr >= 3 || n_ > 0)) pr[i] = *(const u32x4*)(P1 + (size_t)(t0_ - 3 + rr) * 2304 + sec * 768 + h_ * 128 + off); } \
        _Pragma("unroll") for (int i = 0; i < 3; ++i) { const int idx = tid_ + NT * i, j = idx / 384, c = idx % 384, sec = c >> 7; pcw[i] = convw[j * 2304 + sec * 768 + h_ * 128 + (c & 127)]; } \
        if (tid_ < 64) { pbl = ab[(size_t)(t0_ + tid_) * 16 + h_]; pal = ab[(size_t)(t0_ + tid_) * 16 + 6 + h_]; pAl = A_log[h_]; pdt = dtb[h_]; } } while (0)
    if (bidx() < NITEM) CH_LOAD(bidx());
#pragma unroll 1
    for (int it = bidx(); it < NITEM; it += gridDim.x) {
        const int tid = tidx(), lane = tid & 63, wave = tid >> 6;
        const int h = it % 6, cn = it / 6, t0 = cn * 64;
#pragma unroll
        for (int i = 0; i < 7; ++i) { const int idx = tid + NT * i, rr = idx / 48, pc = idx % 48, sec = pc >> 4, off = (pc & 15) * 8; if (idx < 67 * 48) *(LAS u32x4*)(RAW + rr * 784 + sec * 256 + off * 2) = pr[i]; }
#pragma unroll
        for (int i = 0; i < 3; ++i) CW[tid + NT * i] = pcw[i];
        if (tid < 64) {
            const float bl = pbl, al = pal;
            const float beta = __builtin_amdgcn_rcpf(1.f + __expf(-bl)); const float xx = al + pdt, te = __expf(xx);
            const float sp = xx > 20.f ? xx : (te < 0.02f ? te * (1.f - te * (0.5f - 0.33333334f * te)) : __logf(1.f + te));
            float g = -__expf(pAl) * sp;
#pragma unroll
            for (int o = 1; o < 64; o <<= 1) { const float y = shup(g, o); if (lane >= o) g += y; }
            const float glast = __builtin_bit_cast(float, __builtin_amdgcn_readlane(__builtin_bit_cast(int, g), 63));
            gcs[tid] = g; gcs[64 + tid] = beta; gcs[128 + tid] = __expf(g); gcs[192 + tid] = __expf(glast - g);
            if (tid == 63) GL[it] = __expf(g);
        }
        lds_barrier();
        const int t = tid >> 3, part = tid & 7;
        float cq[16], ck[16], cv[16];
#pragma unroll
        for (int sec = 0; sec < 3; ++sec)
#pragma unroll
            for (int hf = 0; hf < 2; ++hf) {
                f32x2_t a2[4];
#pragma unroll
                for (int e = 0; e < 4; ++e) a2[e] = (f32x2_t){0.f, 0.f};
#pragma unroll
                for (int j = 0; j < 4; ++j) {
                    const u32x4 rw = *(const LAS u32x4*)(RAW + (t + j) * 784 + sec * 256 + (part * 16 + hf * 8) * 2);
                    const f32x4 w0 = *(const LAS f32x4*)(CW + j * 384 + sec * 128 + part * 16 + hf * 8), w1 = *(const LAS f32x4*)(CW + j * 384 + sec * 128 + part * 16 + hf * 8 + 4);
                    a2[0] += (f32x2_t){w0[0], w0[1]} * (f32x2_t){bflo(rw.x), bfhi(rw.x)}; a2[1] += (f32x2_t){w0[2], w0[3]} * (f32x2_t){bflo(rw.y), bfhi(rw.y)};
                    a2[2] += (f32x2_t){w1[0], w1[1]} * (f32x2_t){bflo(rw.z), bfhi(rw.z)}; a2[3] += (f32x2_t){w1[2], w1[3]} * (f32x2_t){bflo(rw.w), bfhi(rw.w)};
                }
                const float acc[8] = {a2[0][0], a2[0][1], a2[1][0], a2[1][1], a2[2][0], a2[2][1], a2[3][0], a2[3][1]};
#pragma unroll
                for (int e = 0; e < 8; ++e) { const float s = siluf(acc[e]); if (sec == 0) cq[hf * 8 + e] = s; else if (sec == 1) ck[hf * 8 + e] = s; else cv[hf * 8 + e] = s; }
            }
        float ssq = 0.f, ssk = 0.f;
#pragma unroll
        for (int e = 0; e < 16; ++e) { ssq += cq[e] * cq[e]; ssk += ck[e] * ck[e]; }
        ssq += shx(ssq, 1); ssq += shx(ssq, 2); ssq += shx(ssq, 4);
        ssk += shx(ssk, 1); ssk += shx(ssk, 2); ssk += shx(ssk, 4);
        const float rq = rsqrtf(ssq + 1e-6f) * 0.08838834764831845f, rk = rsqrtf(ssk + 1e-6f);
        const float gct = gcs[t], bt = gcs[64 + t], egt = gcs[128 + t], gclast = gcs[63];
        lds_barrier();
        {
#pragma unroll
            for (int e = 0; e < 16; ++e) { cq[e] *= rq; ck[e] *= rk; }
            u32x4 w;
            w.x = pk2(cq[0], cq[1]); w.y = pk2(cq[2], cq[3]); w.z = pk2(cq[4], cq[5]); w.w = pk2(cq[6], cq[7]); *(LAS u32x4*)(Qb + t * 136 + part * 16) = w;
            w.x = pk2(cq[8], cq[9]); w.y = pk2(cq[10], cq[11]); w.z = pk2(cq[12], cq[13]); w.w = pk2(cq[14], cq[15]); *(LAS u32x4*)(Qb + t * 136 + part * 16 + 8) = w;
            w.x = pk2(ck[0], ck[1]); w.y = pk2(ck[2], ck[3]); w.z = pk2(ck[4], ck[5]); w.w = pk2(ck[6], ck[7]); *(LAS u32x4*)(Kb + t * 136 + part * 16) = w;
            w.x = pk2(ck[8], ck[9]); w.y = pk2(ck[10], ck[11]); w.z = pk2(ck[12], ck[13]); w.w = pk2(ck[14], ck[15]); *(LAS u32x4*)(Kb + t * 136 + part * 16 + 8) = w;
            const float kbe = bt * egt;
#pragma unroll
            for (int e4 = 0; e4 < 4; ++e4) {
                *(LAS f32x4*)(RHS + t * 256 + part * 16 + e4 * 4) = (f32x4){cv[e4 * 4] * bt, cv[e4 * 4 + 1] * bt, cv[e4 * 4 + 2] * bt, cv[e4 * 4 + 3] * bt};
                *(LAS f32x4*)(RHS + t * 256 + 128 + part * 16 + e4 * 4) = (f32x4){ck[e4 * 4] * kbe, ck[e4 * 4 + 1] * kbe, ck[e4 * 4 + 2] * kbe, ck[e4 * 4 + 3] * kbe};
            }
            bf16_t* qgp = QG + (size_t)(t0 + t) * 768 + h * 128 + 32 * (part >> 1) + 4 * (part & 1);
#pragma unroll
            for (int q4 = 0; q4 < 4; ++q4) { u32x2 o; o.x = pk2(cq[q4 * 4] * egt, cq[q4 * 4 + 1] * egt); o.y = pk2(cq[q4 * 4 + 2] * egt, cq[q4 * 4 + 3] * egt); *(u32x2*)(qgp + 8 * q4) = o; }
        }
        lds_barrier();
        {
#pragma unroll
            for (int i = 0; i < 2; ++i) {
                const int pid = tid + NT * i, d = pid >> 3, s8 = pid & 7, tb = 32 * (s8 >> 2) + 4 * (s8 & 3); float v[8];
#pragma unroll
                for (int e = 0; e < 8; ++e) { const int tk = tb + 16 * (e >> 2) + (e & 3); v[e] = bf2f(Kb[tk * 136 + d]) * gcs[192 + tk]; }
                u32x4 w; w.x = pk2(v[0], v[1]); w.y = pk2(v[2], v[3]); w.z = pk2(v[4], v[5]); w.w = pk2(v[6], v[7]);
                *(u32x4*)(KGT + (size_t)it * 8192 + d * 64 + 8 * s8) = w;
            }
            const int mat = wave >> 2, mi = wave & 3, r16 = lane & 15, q = lane >> 4;
            const LAS bf16_t* Ab = Kb + (16 * mi + r16) * 136 + 8 * q;
            bf16x8 af[4];
#pragma unroll
            for (int ks = 0; ks < 4; ++ks) af[ks] = *(const LAS bf16x8*)(Ab + 32 * ks);
            if (mat == 0) {
#pragma unroll
                for (int ni = 0; ni < 4; ++ni) if (ni <= mi) {
                    const LAS bf16_t* Bb = Kb + (16 * ni + r16) * 136 + 8 * q; f32x4 acc = {0.f, 0.f, 0.f, 0.f};
#pragma unroll
                    for (int ks = 0; ks < 4; ++ks) acc = MFMA16(af[ks], *(const LAS bf16x8*)(Bb + 32 * ks), acc);
                    const int kc = 16 * ni + r16; const float gk = gcs[kc];
                    f32x4 lv4;
#pragma unroll
                    for (int j = 0; j < 4; ++j) { const int c = 16 * mi + 4 * q + j; lv4[j] = (c > kc) ? gcs[64 + c] * acc[j] * __expf(fminf(gcs[c] - gk, 0.f)) : 0.f; }
                    *(LAS f32x4*)(Lm + kc * 64 + 16 * mi + 4 * q) = lv4;
                }
            } else {
#pragma unroll
                for (int ni = 0; ni < 4; ++ni) {
                    f32x4 acc = {0.f, 0.f, 0.f, 0.f}; const int c = 16 * ni + r16;
                    if (ni >= mi) {
                        const LAS bf16_t* Bb = Qb + (16 * ni + r16) * 136 + 8 * q;
#pragma unroll
                        for (int ks = 0; ks < 4; ++ks) acc = MFMA16(af[ks], *(const LAS bf16x8*)(Bb + 32 * ks), acc);
                        const float gcc = gcs[c];
#pragma unroll
                        for (int j = 0; j < 4; ++j) { const int kc = 16 * mi + 4 * q + j; acc[j] = (c >= kc) ? acc[j] * __expf(fminf(gcc - gcs[kc], 0.f)) : 0.f; }
                    }
                    u32x2 w; w.x = pk2(acc[0], acc[1]); w.y = pk2(acc[2], acc[3]);
                    *(u32x2*)(AI + (size_t)it * 4096 + c * 64 + 32 * (mi >> 1) + 8 * q + 4 * (mi & 1)) = w;
                }
            }
        }
        lds_barrier();
        { const int itn = (it + (int)gridDim.x < NITEM) ? it + (int)gridDim.x : it; CH_LOAD(itn); }
        if (tid < 256) {
            const LAS float* Lz = Lm + __builtin_amdgcn_mbcnt_lo(0u, 0u);
            f32x2_t r2[32];
#pragma unroll
            for (int i = 0; i < 32; ++i) r2[i] = (f32x2_t){RHS[(2 * i) * 256 + tid], RHS[(2 * i + 1) * 256 + tid]};
            f32x4 ha[8], hb[8];
            solve_loadh<0, 0>(ha, Lz);
            solve_steps<0>(r2, ha, hb, Lz);
#pragma unroll
            for (int i = 0; i < 32; ++i) { RHS[(2 * i) * 256 + tid] = r2[i][0]; RHS[(2 * i + 1) * 256 + tid] = r2[i][1]; }
        }
        lds_barrier();
        {
            const int dv = tid >> 2, tq = tid & 3; u32x4 w0, w1; float e[16];
#pragma unroll
            for (int i = 0; i < 16; ++i) e[i] = RHS[(tq * 16 + i) * 256 + dv];
            w0.x = pk2(e[0], e[1]); w0.y = pk2(e[2], e[3]); w0.z = pk2(e[4], e[5]); w0.w = pk2(e[6], e[7]);
            w1.x = pk2(e[8], e[9]); w1.y = pk2(e[10], e[11]); w1.z = pk2(e[12], e[13]); w1.w = pk2(e[14], e[15]);
            bf16_t* up = UT + (size_t)it * 8192 + dv * 64 + tq * 16; *(u32x4*)up = w0; *(u32x4*)(up + 8) = w1;
            bf16_t* wp = WP + (size_t)(t0 + t) * 768 + h * 128 + 32 * (part >> 1) + 4 * (part & 1);
#pragma unroll
            for (int q4 = 0; q4 < 4; ++q4) { const f32x4 xv = *(const LAS f32x4*)(RHS + t * 256 + 128 + part * 16 + q4 * 4); u32x2 o; o.x = pk2(xv[0], xv[1]); o.y = pk2(xv[2], xv[3]); *(u32x2*)(wp + 8 * q4) = o; }
        }
        lds_barrier();
    }
#undef CH_LOAD
}

constexpr int SCAN_NBLK = 96, SCAN_BUF = 62464;
DI void scan_step(const LAS unsigned char* cur, f32x4 (&S)[8], const u32x2 (&uu)[4], float gl, bf16_t* op, int r16, int q) {
    bf16x8 Sb[4];
#pragma unroll
    for (int ks = 0; ks < 4; ++ks) Sb[ks] = pack8(S[2 * ks], S[2 * ks + 1]);
    const LAS unsigned char* bw = cur + r16 * 272 + 16 * q;
    const LAS unsigned char* ba = cur + 34816 + r16 * 144 + 16 * q;
#define FADDR(i) ((i) < 16 ? bw + ((i) % 4) * (16 * 272) + ((i) / 4) * 64 : (i) < 32 ? bw + 17408 + (((i) - 16) % 4) * (16 * 272) + (((i) - 16) / 4) * 64 : \
                  (i) < 40 ? ba + (((i) - 32) % 4) * (16 * 144) + (((i) - 32) / 4) * 64 : ba + 9216 + (((i) - 40) % 8) * (16 * 144) + (((i) - 40) / 8) * 64)
    constexpr int RING = 16; bf16x8 fr[RING]; f32x4 a1[4], o[4]; bf16x8 vb[2];
#pragma unroll
    for (int i = 0; i < 4; ++i) { a1[i] = (f32x4){0.f, 0.f, 0.f, 0.f}; o[i] = (f32x4){0.f, 0.f, 0.f, 0.f}; }
    vb[0] = Sb[0]; vb[1] = Sb[0];
#pragma unroll
    for (int i = 0; i < RING; ++i) fr[i] = *(const LAS bf16x8*)FADDR(i);
#pragma unroll
    for (int i = 0; i < 56; ++i) {
        const bf16x8 f = fr[i % RING];
        if (i + RING < 56) fr[i % RING] = *(const LAS bf16x8*)FADDR(i + RING);
        if (i < 16) a1[i % 4] = MFMA16(f, Sb[i / 4], a1[i % 4]);
        else if (i < 32) o[(i - 16) % 4] = MFMA16(f, Sb[(i - 16) / 4], o[(i - 16) % 4]);
        else if (i < 40) o[(i - 32) % 4] = MFMA16(f, vb[(i - 32) / 4], o[(i - 32) % 4]);
        else { const int dt = (i - 40) % 8, k2 = (i - 40) / 8; if (k2 == 0) S[dt] = S[dt] * gl; S[dt] = MFMA16(f, vb[k2], S[dt]); }
        if (i == 15) {
            f32x4 vn[4];
#pragma unroll
            for (int mt = 0; mt < 4; ++mt) vn[mt] = (f32x4){bflo(uu[mt].x), bfhi(uu[mt].x), bflo(uu[mt].y), bfhi(uu[mt].y)} - a1[mt];
            vb[0] = pack8(vn[0], vn[1]); vb[1] = pack8(vn[2], vn[3]);
        }
        __builtin_amdgcn_sched_barrier(0);
    }
#undef FADDR
#pragma unroll
    for (int mt = 0; mt < 4; ++mt) { u32x2 w; w.x = pk2(o[mt][0], o[mt][1]); w.y = pk2(o[mt][2], o[mt][3]); *(u32x2*)(op + 16 * mt) = w; }
}
DI void gdn_scan_phase(LAS unsigned char* lds, PRef p) {
    if (bidx() >= SCAN_NBLK) return;
    const bf16_t* QG = (const bf16_t*)(uni(p.ws) + WS_QG); const bf16_t* WP = (const bf16_t*)(uni(p.ws) + WS_WP); const bf16_t* KGT = (const bf16_t*)(uni(p.ws) + WS_KGT);
    const bf16_t* UT = (const bf16_t*)(uni(p.ws) + WS_UT); const bf16_t* AI = (const bf16_t*)(uni(p.ws) + WS_AI); const float* GL = (const float*)(uni(p.ws) + WS_GL);
    bf16_t* OT = (bf16_t*)(uni(p.ws) + WS_OT);
    const int tid = tidx(), lane = tid & 63, wave = __builtin_amdgcn_readfirstlane(tid >> 6), r16 = lane & 15, q = lane >> 4;
    const int xcd = bidx() & 7, kx = bidx() >> 3, hg = xcd * 3 + (kx >> 2), bh = hg >> 1, b = bh / 6, h = bh % 6, dv0 = ((hg & 1) * 4 + (kx & 3)) * 16;
    const size_t it0 = (size_t)(b * 256) * 6 + h, tok0 = (size_t)(b * 256) * 64;
    if (wave == 0) {
        f32x4 S[8];
#pragma unroll
        for (int i = 0; i < 8; ++i) S[i] = (f32x4){0.f, 0.f, 0.f, 0.f};
        u32x2 ua[4], ub[4], uc[4], ud[4]; float gla, glb, glc, gld;
        const bf16_t* up = UT + it0 * 8192 + (size_t)(dv0 + r16) * 64 + 4 * q;
        bf16_t* op = OT + it0 * 8192 + (size_t)(dv0 + r16) * 64 + 4 * q;
        const float* glp = GL + it0; const int zdiv = tidx() >> 20;
#define SCAN_LOADU(u, g, nn) do { const size_t o_ = (size_t)min((nn), 255) * (6 * 8192); \
        u[0] = *(const u32x2*)(up + o_); u[1] = *(const u32x2*)(up + o_ + 16); u[2] = *(const u32x2*)(up + o_ + 32); u[3] = *(const u32x2*)(up + o_ + 48); g = glp[min((nn), 255) * 6 + zdiv]; } while (0)
        SCAN_LOADU(ua, gla, 0); SCAN_LOADU(ub, glb, 1); SCAN_LOADU(uc, glc, 2); SCAN_LOADU(ud, gld, 3);
        lds_barrier();
#pragma unroll 1
        for (int n = 0; n < 256; n += 4) {
            scan_step(lds, S, ua, gla, op + (size_t)n * (6 * 8192), r16, q);
            SCAN_LOADU(ua, gla, n + 4);
            lds_barrier();
            scan_step(lds + SCAN_BUF, S, ub, glb, op + (size_t)(n + 1) * (6 * 8192), r16, q);
            SCAN_LOADU(ub, glb, n + 5);
            lds_barrier();
            scan_step(lds, S, uc, glc, op + (size_t)(n + 2) * (6 * 8192), r16, q);
            SCAN_LOADU(uc, glc, n + 6);
            lds_barrier();
            scan_step(lds + SCAN_BUF, S, ud, gld, op + (size_t)(n + 3) * (6 * 8192), r16, q);
            SCAN_LOADU(ud, gld, n + 7);
            lds_barrier();
        }
#undef SCAN_LOADU
    } else {
        const bf16_t* src; size_t sstride; int jsrc, dst, jdst;
        if (wave <= 4) { const int t2 = (tid - 64) & 127, row = t2 >> 4, pc = t2 & 15; const bool isq = wave >= 3;
            src = (isq ? QG : WP) + (tok0 + row) * 768 + h * 128 + pc * 8; sstride = 64 * 768; jsrc = 8 * 768; dst = (isq ? 17408 : 0) + row * 272 + pc * 16; jdst = 8 * 272; }
        else if (wave == 5) { const int t2 = lane; src = AI + it0 * 4096 + t2 * 8; sstride = 6 * 4096; jsrc = 512; dst = 34816 + (t2 >> 3) * 144 + (t2 & 7) * 16; jdst = 8 * 144; }
        else { const int t2 = (tid - 384) & 127; src = KGT + it0 * 8192 + t2 * 8; sstride = 6 * 8192; jsrc = 1024; dst = 44032 + (t2 >> 3) * 144 + (t2 & 7) * 16; jdst = 16 * 144; }
        u32x4 r0[8], r1[8], r2[8], r3[8];
#define SCAN_LOAD(r, nn) do { const bf16_t* s_ = src + (size_t)min((nn), 255) * sstride; \
        _Pragma("unroll") for (int j = 0; j < 8; ++j) r[j] = *(const u32x4*)(s_ + (size_t)j * jsrc); } while (0)
#define SCAN_STORE(r, bufp) do { LAS unsigned char* b_ = (bufp) + dst; \
        _Pragma("unroll") for (int j = 0; j < 8; ++j) *(LAS u32x4*)(b_ + j * jdst) = r[j]; } while (0)
        SCAN_LOAD(r0, 0); SCAN_LOAD(r1, 1); SCAN_LOAD(r2, 2); SCAN_LOAD(r3, 3);
        SCAN_STORE(r0, lds); SCAN_LOAD(r0, 4);
        lds_barrier();
#pragma unroll 1
        for (int n = 0; n < 256; n += 4) {
            SCAN_STORE(r1, lds + SCAN_BUF); SCAN_LOAD(r1, n + 5);
            lds_barrier();
            SCAN_STORE(r2, lds); SCAN_LOAD(r2, n + 6);
            lds_barrier();
            SCAN_STORE(r3, lds + SCAN_BUF); SCAN_LOAD(r3, n + 7);
            lds_barrier();
            SCAN_STORE(r0, lds); SCAN_LOAD(r0, n + 8);
            lds_barrier();
        }
#undef SCAN_LOAD
#undef SCAN_STORE
    }
}

DI void gdn_gate_phase(LAS unsigned char* lds, PRef p, int a) {
    const bf16_t* OT = (const bf16_t*)(uni(p.ws) + WS_OT); const bf16_t* P2 = (const bf16_t*)(uni(p.ws) + WS_P2); bf16_t* MIX = (bf16_t*)(uni(p.ws) + WS_MIX);
    const float* gn = uni(p.gdn_norm) + a * 128; LAS bf16_t* T = (LAS bf16_t*)lds;
    const int tid = tidx(), t = tid >> 3, part = tid & 7;
    for (int it = bidx(); it < NITEM; it += gridDim.x) {
        const int h = it % 6, cn = it / 6, t0 = cn * 64;
#pragma unroll
        for (int i = 0; i < 2; ++i) { const int id = tid + NT * i, row = id >> 3, pc = id & 7; *(LAS u32x4*)(T + row * 72 + pc * 8) = *(const u32x4*)(OT + (size_t)it * 8192 + row * 64 + pc * 8); }
        lds_barrier();
        float o[16]; float ss = 0.f;
#pragma unroll
        for (int e = 0; e < 16; ++e) { o[e] = bf2f(T[(part * 16 + e) * 72 + t]); ss += o[e] * o[e]; }
        ss += shx(ss, 1); ss += shx(ss, 2); ss += shx(ss, 4);
        const float rs = rsqrtf(ss * (1.f / 128.f) + 1e-6f);
        const bf16_t* zp = P2 + (size_t)(t0 + t) * 1024 + h * 128 + part * 16; const u32x4 z0 = *(const u32x4*)zp, z1 = *(const u32x4*)(zp + 8);
        float z[16] = {bflo(z0.x), bfhi(z0.x), bflo(z0.y), bfhi(z0.y), bflo(z0.z), bfhi(z0.z), bflo(z0.w), bfhi(z0.w), bflo(z1.x), bfhi(z1.x), bflo(z1.y), bfhi(z1.y), bflo(z1.z), bfhi(z1.z), bflo(z1.w), bfhi(z1.w)};
        float r[16];
#pragma unroll
        for (int e = 0; e < 16; ++e) r[e] = o[e] * rs * gn[part * 16 + e] * siluf(z[e]);
        u32x4 w0, w1; w0.x = pk2(r[0], r[1]); w0.y = pk2(r[2], r[3]); w0.z = pk2(r[4], r[5]); w0.w = pk2(r[6], r[7]);
        w1.x = pk2(r[8], r[9]); w1.y = pk2(r[10], r[11]); w1.z = pk2(r[12], r[13]); w1.w = pk2(r[14], r[15]);
        bf16_t* mp = MIX + (size_t)(t0 + t) * 1024 + h * 128 + part * 16; *(u32x4*)mp = w0; *(u32x4*)(mp + 8) = w1;
        lds_barrier();
    }
}

template <int MODE> DI void attn_phase(LAS unsigned char* lds, PRef p, int layer, int first = -1, int stride = 0) {
    LAS bf16_t* Ks = (LAS bf16_t*)lds;
    LAS bf16_t* Vt = (LAS bf16_t*)(lds + 36864);
    const bf16_t* Qb = (const bf16_t*)(uni(p.ws) + WS_P2); bf16_t* MIX = (bf16_t*)(uni(p.ws) + WS_MIX);
    const bf16_t* MKV = (const bf16_t*)(uni(p.ws) + WS_MKV); const bf16_t* KV = (const bf16_t*)(uni(p.ws) + WS_KV);
    const int tid = tidx(), lane = tid & 63, wave = tid >> 6, r16 = lane & 15, q = lane >> 4;
    const int nitems = MODE == 0 ? 256 : 512;
    if (first < 0) { first = bidx(); stride = gridDim.x; }
#pragma unroll 1
    for (int it = first; it < nitems; it += stride) {
        int b, hh, tb; size_t tok0;
        if (MODE == 0) { b = it >> 7; hh = (it >> 5) & 3; tb = it & 31; tok0 = (size_t)b * SEQ + tb * 512; }
        else { b = it >> 8; hh = (it >> 7) & 1; tb = it & 127; tok0 = (size_t)b * SEQ + tb * 128; }
#pragma unroll 1
        for (int i = 0; i < 4; ++i) {
            const int id = tid + NT * i, rr = id >> 3, pc = id & 7; u32x4 kv = {0u, 0u, 0u, 0u}, vv = {0u, 0u, 0u, 0u};
            if (MODE == 0) { const bf16_t* kp = MKV + (size_t)(b * 256 + rr) * 2048 + layer * 512 + hh * 64 + pc * 8; kv = *(const u32x4*)kp; vv = *(const u32x4*)(kp + 256); }
            else if (tb > 0 || rr >= 128) { const bf16_t* kp = KV + (tok0 - 128 + rr) * 256 + hh * 64 + pc * 8; kv = *(const u32x4*)kp; vv = *(const u32x4*)(kp + 128); }
            *(LAS u32x4*)(Ks + rr * 72 + pc * 8) = kv;
            LAS bf16_t* vp = Vt + (pc * 8) * 264 + tslot(rr);
            vp[0] = (bf16_t)(vv.x & 0xffffu); vp[264] = (bf16_t)(vv.x >> 16); vp[2 * 264] = (bf16_t)(vv.y & 0xffffu); vp[3 * 264] = (bf16_t)(vv.y >> 16);
            vp[4 * 264] = (bf16_t)(vv.z & 0xffffu); vp[5 * 264] = (bf16_t)(vv.z >> 16); vp[6 * 264] = (bf16_t)(vv.w & 0xffffu); vp[7 * 264] = (bf16_t)(vv.w >> 16);
        }
        lds_barrier();
        const int npass = MODE == 0 ? 32 : 48;
#pragma unroll 1
        for (int ps = wave; ps < npass; ps += 8) {
            int rt, colbase; float sink = 0.f;
            if (MODE == 0) { rt = ps; colbase = 768 + hh * 64; }
            else { const int hq = hh * 6 + (ps >> 3); rt = ps & 7; colbase = hq * 64; sink = uni(p.swa_sinks)[(layer - 2) * 12 + hq]; }
            const size_t tok = tok0 + 16 * rt + r16;
            const bf16_t* qp = Qb + tok * 1024 + colbase + 8 * q;
            const bf16x8 qf0 = *(const bf16x8*)qp, qf1 = *(const bf16x8*)(qp + 32);
            float m = MODE == 1 ? sink : -INFINITY, l = (MODE == 1 && q == 0) ? 1.f : 0.f;
            f32x4 ot[4];
#pragma unroll
            for (int dt = 0; dt < 4; ++dt) ot[dt] = (f32x4){0.f, 0.f, 0.f, 0.f};
            int kk0 = 0, kk1 = 7;
            if (MODE == 1) { kk0 = rt >> 1; if (tb == 0 && kk0 < 4) kk0 = 4; kk1 = (16 * rt + 143) >> 5; }
#pragma unroll 1
            for (int kk = kk0; kk <= kk1; ++kk) {
                const LAS bf16_t* kr = Ks + (32 * kk + r16) * 72 + 8 * q;
                f32x4 s0 = {0.f, 0.f, 0.f, 0.f}, s1 = {0.f, 0.f, 0.f, 0.f};
                s0 = MFMA16(*(const LAS bf16x8*)kr, qf0, s0); s0 = MFMA16(*(const LAS bf16x8*)(kr + 32), qf1, s0);
                s1 = MFMA16(*(const LAS bf16x8*)(kr + 16 * 72), qf0, s1); s1 = MFMA16(*(const LAS bf16x8*)(kr + 16 * 72 + 32), qf1, s1);
                if (MODE == 1) {
#pragma unroll
                    for (int j = 0; j < 4; ++j) { const int d0 = 16 * rt + r16 + 128 - (32 * kk + 4 * q + j), d1 = d0 - 16;
                        if (d0 < 0 || d0 >= 128) s0[j] = -INFINITY; if (d1 < 0 || d1 >= 128) s1[j] = -INFINITY; }
                }
                float gm = fmaxf(fmaxf(fmaxf(s0[0], s0[1]), fmaxf(s0[2], s0[3])), fmaxf(fmaxf(s1[0], s1[1]), fmaxf(s1[2], s1[3])));
                gm = fmaxf(gm, shx(gm, 16)); gm = fmaxf(gm, shx(gm, 32));
                const float mn = fmaxf(m, gm), sc = __expf(m - mn); m = mn; l *= sc;
#pragma unroll
                for (int dt = 0; dt < 4; ++dt) ot[dt] = ot[dt] * sc;
#pragma unroll
                for (int j = 0; j < 4; ++j) { s0[j] = __expf(s0[j] - mn); s1[j] = __expf(s1[j] - mn); l += s0[j] + s1[j]; }
                const bf16x8 pb = pack8(s0, s1);
#pragma unroll
                for (int dt = 0; dt < 4; ++dt) ot[dt] = MFMA16(*(const LAS bf16x8*)(Vt + (16 * dt + r16) * 264 + 32 * kk + 8 * q), pb, ot[dt]);
            }
            l += shx(l, 16); l += shx(l, 32);
            const float inv = 1.f / l; bf16_t* op = MIX + tok * 1024 + colbase + 4 * q;
#pragma unroll
            for (int dt = 0; dt < 4; ++dt) { u32x2 w; w.x = pk2(ot[dt][0] * inv, ot[dt][1] * inv); w.y = pk2(ot[dt][2] * inv, ot[dt][3] * inv); *(u32x2*)(op + 16 * dt) = w; }
        }
        lds_barrier();
    }
}

constexpr int PARAM_OFF = 131072;
DI unsigned xcc_id() { return (unsigned)__builtin_amdgcn_s_getreg((3 << 11) | 20) & 0xFu; }
DI void grid_bar(unsigned* bar, unsigned gen, LAS unsigned char* lds) {
    __syncthreads();
    if (threadIdx.x == 0) {
        const unsigned xcc = *(volatile LAS unsigned*)(lds + 135120), nx = *(volatile LAS unsigned*)(lds + 135124), ng = *(volatile LAS unsigned*)(lds + 135128);
        const unsigned old = __hip_atomic_fetch_add(bar + 64 + 64 * xcc, 1u, __ATOMIC_RELAXED, __HIP_MEMORY_SCOPE_AGENT);
        if (old + 1u == gen * nx) { __builtin_amdgcn_fence(__ATOMIC_RELEASE, "agent"); __hip_atomic_fetch_add(bar, 1u, __ATOMIC_RELAXED, __HIP_MEMORY_SCOPE_AGENT); }
        const unsigned target = gen * ng;
        while (__hip_atomic_load(bar, __ATOMIC_RELAXED, __HIP_MEMORY_SCOPE_AGENT) < target) __builtin_amdgcn_s_sleep(1);
        __builtin_amdgcn_fence(__ATOMIC_ACQUIRE, "agent");
    }
    __syncthreads();
}
enum { K_P0 = 0, K_GEMM, K_CHUNK, K_SCAN, K_GATE, K_ATTN, K_NORMFFN, K_POST, K_FINAL, K_NOP };

DI void gemm_step(LAS unsigned char* lds, PRef p, int gid, int layer) {
    unsigned char* ws = uni(p.ws); unsigned char* slot = ws + WS_WA0 + (size_t)(layer & 1) * WSLOT;
    const bf16_t* A = (const bf16_t*)(ws + WS_H); const bf16_t* Bt = (const bf16_t*)(slot + WO_IN); int M = MT, N = 1024, K = 1024;
    Epi E{0, 0, nullptr, nullptr, nullptr, nullptr, (const float*)(ws + WS_CS), (float*)(ws + WS_SSQ)};
    if (gid == 0) { A = (const bf16_t*)(ws + WS_MEMN); Bt = (const bf16_t*)(ws + WS_WMKV); M = 512; N = 2048; E.mode = 0; E.ldc = 2048; E.o0 = (bf16_t*)(ws + WS_MKV); }
    else if (gid == 1) { N = 3584; E.mode = 1; E.o0 = (bf16_t*)(ws + WS_P1); E.o1 = (bf16_t*)(ws + WS_P2); E.f0 = (float*)(ws + WS_AB); }
    else if (gid == 2) { E.mode = 2; E.o0 = (bf16_t*)(ws + WS_P2); }
    else if (gid == 3) { Bt = (const bf16_t*)(ws + WS_WKV); N = 256; E.mode = 3; E.o0 = (bf16_t*)(ws + WS_KV); }
    else if (gid == 4) { A = (const bf16_t*)(ws + WS_MIX); Bt = (const bf16_t*)(slot + WO_OUT); E.mode = 4; E.f0 = uni(p.out); E.base = layer == 0 ? uni(p.x) : uni(p.out); E.o0 = (bf16_t*)(ws + WS_H); }
    else if (gid == 5) { Bt = (const bf16_t*)(slot + WO_GU); N = 5632; E.mode = 5; E.o0 = (bf16_t*)(ws + WS_ACT); }
    else { A = (const bf16_t*)(ws + WS_ACT); Bt = (const bf16_t*)(slot + WO_DN); K = DFF; E.mode = 4; E.f0 = uni(p.out); E.base = uni(p.out); E.o0 = (bf16_t*)(ws + WS_H); }
    E.o0 = uni(E.o0); E.o1 = uni(E.o1); E.f0 = uni(E.f0); E.base = uni(E.base); E.cs = uni(E.cs); E.ssq = uni(E.ssq);
    run_gemm(lds, uni(A), uni(Bt), M, N, K, E);
}

__global__ void __launch_bounds__(NT, 2) yoco_fwd(Params pin) {
    extern __shared__ __attribute__((aligned(16))) unsigned char lds_raw[];
    LAS unsigned char* lds = (LAS unsigned char*)lds_raw;
    cg::grid_group grid = cg::this_grid();
    if (threadIdx.x == 0) { const unsigned xcc = xcc_id(); *(volatile LAS unsigned*)((LAS unsigned char*)lds_raw + 135120) = xcc;
        __hip_atomic_fetch_add((unsigned*)pin.ws + 1088 + xcc, 1u, __ATOMIC_RELAXED, __HIP_MEMORY_SCOPE_AGENT); }
    { const unsigned* src = (const unsigned*)&pin; if (tidx() < sizeof(Params) / 4) ((LAS unsigned*)(lds + PARAM_OFF))[tidx()] = src[tidx()]; }
    __syncthreads();
#define PP pin
    {
        PRef p = PP; unsigned char* ws = uni(p.ws);
        conv_layer_weights(lds, p, 0, ws + WS_WA0, -1, 0, 3);
        wconv(lds, uni(p.w_kv), 1024, 256, (bf16_t*)(ws + WS_WKV), 256, 3, uni(p.ln_kv));
#pragma unroll 1
        for (int l = 0; l < 4; ++l) wconv(lds, uni(p.w_mem_kv) + (size_t)l * 1024 * 512, 1024, 512, (bf16_t*)(ws + WS_WMKV) + (size_t)l * 512 * 1024, 512, 0);
        rope_table(p);
        norm_rows(uni(p.mem), uni(p.ln_mem), (bf16_t*)(ws + WS_MEMN), 512);
        xb_rows(uni(p.x), (bf16_t*)(ws + WS_H), (float*)(ws + WS_SSQ), MT);
        grid.sync();
        if (threadIdx.x == 0) { unsigned ng = 0, nx = 0; const unsigned xcc = *(volatile LAS unsigned*)(lds + 135120);
#pragma unroll 1
            for (unsigned x = 0; x < 16; ++x) { const unsigned c = __hip_atomic_load((unsigned*)pin.ws + 1088 + x, __ATOMIC_RELAXED, __HIP_MEMORY_SCOPE_AGENT); ng += c != 0u; if (x == xcc) nx = c; }
            *(volatile LAS unsigned*)(lds + 135124) = nx; *(volatile LAS unsigned*)(lds + 135128) = ng; }
    }
    constexpr int NSTEP = 14 + 10;
#pragma unroll 1
    for (int s = 0; s < NSTEP; ++s) {
        int kind, layer, gid = 0;
        if (s < 14) { const int k = s % 7; layer = s / 7;
            kind = k == 0 ? K_GEMM : k == 1 ? K_CHUNK : k == 2 ? K_SCAN : k == 3 ? K_GATE : K_GEMM;
            gid = k == 0 ? 1 : k == 4 ? 4 : k == 5 ? 5 : 6; }
        else { const int t = s - 14, k = t % 5; layer = 2 + t / 5;
            kind = k == 1 ? K_ATTN : K_GEMM;
            gid = k == 0 ? 2 : k == 2 ? 4 : k == 3 ? 5 : 6; }
        if (kind == K_GEMM) {
            int g = (s == 0) ? 0 : gid;
            for (;;) { gemm_step(lds, PP, g, layer); if (g == 0) g = gid; else if (g == 2 && layer == 2) g = 3; else break; }
        }
        else if (kind == K_CHUNK) gdn_chunk_phase(lds, PP, layer);
        else if (kind == K_SCAN) { gdn_scan_phase(lds, PP);
            if (bidx() >= SCAN_NBLK) {
                const int f = bidx() - SCAN_NBLK, st = gridDim.x - SCAN_NBLK;
                attn_phase<0>(lds, PP, layer, f, st);
                PRef p = PP;
                if (layer == 0) { conv_layer_weights(lds, p, 0, uni(p.ws) + WS_WA0, f, st, 12); conv_layer_weights(lds, p, 1, uni(p.ws) + WS_WA0 + WSLOT, f, st); }
                else conv_layer_weights(lds, p, 2, uni(p.ws) + WS_WA0, f, st); } }
        else if (kind == K_GATE) gdn_gate_phase(lds, PP, layer);
        else { attn_phase<1>(lds, PP, layer); attn_phase<0>(lds, PP, layer);
            if (layer == 2) { PRef p = PP; conv_layer_weights(lds, p, 3, uni(p.ws) + WS_WA0 + WSLOT); } }
        grid_bar((unsigned*)pin.ws, (unsigned)(s + 1), lds);
    }
    { PRef p = PP; final_norm(uni(p.out), uni(p.ln_final), MT); }
#undef PP
}

extern "C" void kernel_launch(void* const* d_in, const int* in_sizes, int n_in, void* d_out, int out_size, void* d_ws, size_t ws_size, hipStream_t stream) {
    static int grid = 0;
    if (grid == 0) {
        if (n_in != 20 || out_size != MT * DMODEL || ws_size < WS_END) { fprintf(stderr, "kernel_launch: unexpected shapes (n_in %d, out %d, ws %zu)\n", n_in, out_size, ws_size); grid = -1; return; }
        int dev = 0, cus = 0, per_cu = 0;
        (void)hipGetDevice(&dev); (void)hipDeviceGetAttribute(&cus, hipDeviceAttributeMultiprocessorCount, dev);
        if (hipFuncSetAttribute((const void*)yoco_fwd, hipFuncAttributeMaxDynamicSharedMemorySize, LDS_BYTES) != hipSuccess) { fprintf(stderr, "kernel_launch: hipFuncSetAttribute failed\n"); grid = -1; return; }
        (void)hipOccupancyMaxActiveBlocksPerMultiprocessor(&per_cu, (const void*)yoco_fwd, NT, LDS_BYTES);
        (void)hipGetLastError();
        if (per_cu < 1) fprintf(stderr, "kernel_launch: occupancy query says %d blocks/CU\n", per_cu);
        grid = cus > 0 ? cus : 256;
    }
    if (grid < 0) return;
    Params p{};
    p.x = (const float*)d_in[0]; p.mem = (const float*)d_in[1]; p.pos = (const int*)d_in[2]; p.ln_mix = (const float*)d_in[3]; p.ln_ffn = (const float*)d_in[4]; p.ln_mem = (const float*)d_in[5];
    p.w_mem_kv = (const float*)d_in[6]; p.w_out = (const float*)d_in[7]; p.w_gate_up = (const float*)d_in[8]; p.w_down = (const float*)d_in[9]; p.gdn_w_in = (const float*)d_in[10];
    p.gdn_conv = (const float*)d_in[11]; p.gdn_A_log = (const float*)d_in[12]; p.gdn_dt_bias = (const float*)d_in[13]; p.gdn_norm = (const float*)d_in[14]; p.swa_w_q = (const float*)d_in[15];
    p.swa_sinks = (const float*)d_in[16]; p.ln_kv = (const float*)d_in[17]; p.w_kv = (const float*)d_in[18]; p.ln_final = (const float*)d_in[19];
    p.out = (float*)d_out; p.ws = (unsigned char*)d_ws;
    for (int i = 0; i < 8; ++i) p.inv[i] = (float)pow(500000.0, -(double)(2 * i) / 16.0);
    (void)hipMemsetAsync(d_ws, 0, 8192, stream);
    void* args[] = {&p};
    hipError_t e = hipLaunchCooperativeKernel((const void*)yoco_fwd, dim3(grid), dim3(NT), args, LDS_BYTES, stream);
    if (e != hipSuccess) fprintf(stderr, "kernel_launch: cooperative launch failed: %s (grid %d)\n", hipGetErrorString(e), grid);
}
```
